# Optimizing an MI355X kernel written in HIP

```python
import math
import jax, jax.numpy as jnp
from jax import lax
import numpy as np

D_MODEL = 4096
BATCH = 4
SEQ = 4096
DEPTH = 2

N_MIXERS = 2
N_A_LAYERS = (DEPTH + 1) // 2
N_B_LAYERS = DEPTH // 2

A_HEADS = 32
A_DK = D_MODEL // A_HEADS
A_DV = D_MODEL // A_HEADS
A_QK_W = A_HEADS * A_DK
A_V_W = A_HEADS * A_DV
A_CONV_CH = 2 * A_QK_W + A_V_W
A_CONV = 4
A_CHUNK = 64
A_IN_W = A_CONV_CH + A_V_W + 2 * A_HEADS

B_HEADS = 16
B_DH = D_MODEL // (2 * B_HEADS)
B_Q_W = 2 * B_HEADS * B_DH
B_V_W = 2 * B_HEADS * B_DH
B_IN_W = 2 * B_Q_W + 2 * B_V_W
Q_BLOCK = 128

REL_BUCKETS = 32
REL_MAX_DIST = 128

DEEPNORM_ALPHA = (2.0 * DEPTH) ** 0.25
DEEPNORM_BETA = (8.0 * DEPTH) ** -0.25

LN_EPS = 1e-5
RMS_EPS = 1e-6
L2_EPS = 1e-6

kernel_name = "hybrid_deltanet_diffattn_deepnorm"


def layer_norm(x, g, b):
    xf = x.astype(jnp.float32)
    mu = jnp.mean(xf, axis=-1, keepdims=True)
    var = jnp.mean(jnp.square(xf - mu), axis=-1, keepdims=True)
    y = (xf - mu) * lax.rsqrt(var + LN_EPS)
    return (y * g.astype(jnp.float32) + b.astype(jnp.float32)).astype(x.dtype)


def rms_norm(x, w, eps):
    xf = x.astype(jnp.float32)
    y = xf * lax.rsqrt(jnp.mean(jnp.square(xf), axis=-1, keepdims=True) + eps)
    return y * w.astype(jnp.float32)


def l2norm(x):
    return x * lax.rsqrt(jnp.sum(jnp.square(x), axis=-1, keepdims=True) + L2_EPS)


def causal_short_conv(x, w):
    T = x.shape[1]
    K = w.shape[-1]
    xp = jnp.pad(x, ((0, 0), (K - 1, 0), (0, 0)))
    y = xp[:, 0:T, :] * w[:, 0]
    for j in range(1, K):
        y = y + xp[:, j:j + T, :] * w[:, j]
    return y


def gated_delta_rule_chunked(q, k, v, g, beta):
    Bn, H, T, dk = q.shape
    dv = v.shape[-1]
    C = A_CHUNK
    N = T // C
    q = q.reshape(Bn, H, N, C, dk)
    k = k.reshape(Bn, H, N, C, dk)
    v = v.reshape(Bn, H, N, C, dv)
    g = g.reshape(Bn, H, N, C)
    beta = beta.reshape(Bn, H, N, C)

    gc = jnp.cumsum(g, axis=-1)
    k_beta = k * beta[..., None]
    v_beta = v * beta[..., None]
    idx = jnp.arange(C)
    lower_incl = idx[:, None] >= idx[None, :]
    strict = idx[:, None] > idx[None, :]
    diff = gc[..., :, None] - gc[..., None, :]
    decay_mask = jnp.exp(jnp.where(lower_incl, diff, -jnp.inf))

    L = jnp.where(strict, jnp.einsum('bhncd,bhnsd->bhncs', k_beta, k) * decay_mask, 0.0)
    eye = jnp.eye(C, dtype=q.dtype)
    T_mat = lax.linalg.triangular_solve(eye + L, jnp.broadcast_to(eye, L.shape),
                                        left_side=True, lower=True, unit_diagonal=True)
    w = jnp.einsum('bhncs,bhnsd->bhncd', T_mat, k_beta * jnp.exp(gc)[..., None])
    u = jnp.einsum('bhncs,bhnse->bhnce', T_mat, v_beta)
    attn_intra = jnp.einsum('bhncd,bhnsd->bhncs', q, k) * decay_mask
    q_decay = q * jnp.exp(gc)[..., None]
    k_state = k * jnp.exp(gc[..., -1:] - gc)[..., None]
    chunk_decay = jnp.exp(gc[..., -1])

    xs = (jnp.moveaxis(w, 2, 0), jnp.moveaxis(u, 2, 0), jnp.moveaxis(attn_intra, 2, 0),
          jnp.moveaxis(q_decay, 2, 0), jnp.moveaxis(k_state, 2, 0), jnp.moveaxis(chunk_decay, 2, 0))

    def step(S, inp):
        w_c, u_c, a_c, qd_c, ks_c, cd_c = inp
        v_new = u_c - jnp.einsum('bhcd,bhde->bhce', w_c, S)
        o = jnp.einsum('bhcd,bhde->bhce', qd_c, S) + jnp.einsum('bhcs,bhse->bhce', a_c, v_new)
        S = S * cd_c[..., None, None] + jnp.einsum('bhcd,bhce->bhde', ks_c, v_new)
        return S, o

    S0 = jnp.zeros((Bn, H, dk, dv), dtype=q.dtype)
    _, outs = lax.scan(step, S0, xs)
    return jnp.moveaxis(outs, 0, 2).reshape(Bn, H, T, dv)


def gated_deltanet_branch(x, w_in, conv_w, a_log, dt_bias, norm_w, w_out):
    Bn, T, _ = x.shape
    h = x @ w_in
    qkv, z, a, b = jnp.split(h, [A_CONV_CH, A_CONV_CH + A_V_W, A_CONV_CH + A_V_W + A_HEADS], axis=-1)
    qkv = jax.nn.silu(causal_short_conv(qkv, conv_w)).astype(jnp.float32)
    q, k, v = jnp.split(qkv, [A_QK_W, 2 * A_QK_W], axis=-1)
    q = l2norm(q.reshape(Bn, T, A_HEADS, A_DK)) * (A_DK ** -0.5)
    k = l2norm(k.reshape(Bn, T, A_HEADS, A_DK))
    v = v.reshape(Bn, T, A_HEADS, A_DV)
    beta = jax.nn.sigmoid(b.astype(jnp.float32))
    g = -jnp.exp(a_log.astype(jnp.float32)) * jax.nn.softplus(
        a.astype(jnp.float32) + dt_bias.astype(jnp.float32))
    o = gated_delta_rule_chunked(q.transpose(0, 2, 1, 3), k.transpose(0, 2, 1, 3),
                                 v.transpose(0, 2, 1, 3), g.transpose(0, 2, 1),
                                 beta.transpose(0, 2, 1))
    o = o.transpose(0, 2, 1, 3)
    gate = jax.nn.silu(z.astype(jnp.float32)).reshape(Bn, T, A_HEADS, A_DV)
    o = rms_norm(o, norm_w, RMS_EPS) * gate
    return o.reshape(Bn, T, A_V_W).astype(x.dtype) @ w_out


def t5_causal_bucket(rel):
    n = jnp.maximum(rel, 0)
    max_exact = REL_BUCKETS // 2
    nf = jnp.maximum(n, 1).astype(jnp.float32)
    large = max_exact + (jnp.log(nf / max_exact) / math.log(REL_MAX_DIST / max_exact)
                         * (REL_BUCKETS - max_exact)).astype(jnp.int32)
    large = jnp.minimum(large, REL_BUCKETS - 1)
    return jnp.where(n < max_exact, n, large)


def lambda_init_fn(layer_idx):
    return 0.8 - 0.6 * math.exp(-0.3 * layer_idx)


def diff_attention_branch(x, w_in, lam_q1, lam_k1, lam_q2, lam_k2, subln_w, rel_bias, w_out, layer_idx):
    Bn, T, _ = x.shape
    lam_init = lambda_init_fn(layer_idx)
    h = x @ w_in
    q, k, v, z = jnp.split(h, [B_Q_W, 2 * B_Q_W, 2 * B_Q_W + B_V_W], axis=-1)
    q = q.reshape(Bn, T, B_HEADS, 2, B_DH).transpose(0, 2, 3, 1, 4)
    k = k.reshape(Bn, T, B_HEADS, 2, B_DH).transpose(0, 2, 3, 1, 4)
    v = v.reshape(Bn, T, B_HEADS, 2 * B_DH).transpose(0, 2, 1, 3)
    lam = (jnp.exp(jnp.sum(lam_q1.astype(jnp.float32) * lam_k1.astype(jnp.float32)))
           - jnp.exp(jnp.sum(lam_q2.astype(jnp.float32) * lam_k2.astype(jnp.float32))) + lam_init)
    scale = B_DH ** -0.5
    nb = T // Q_BLOCK
    q_blocks = jnp.moveaxis(q.reshape(Bn, B_HEADS, 2, nb, Q_BLOCK, B_DH), 3, 0)
    starts = jnp.arange(nb, dtype=jnp.int32) * Q_BLOCK
    kpos = jnp.arange(T, dtype=jnp.int32)

    def attend(args):
        qb, start = args
        s = jnp.einsum('bhpqd,bhpkd->bhpqk', qb, k).astype(jnp.float32) * scale
        qpos = start + jnp.arange(Q_BLOCK, dtype=jnp.int32)
        rel = qpos[:, None] - kpos[None, :]
        bias = rel_bias.astype(jnp.float32)[t5_causal_bucket(rel)]
        s = s + bias.transpose(2, 0, 1)[None, :, None]
        s = jnp.where((rel >= 0)[None, None, None], s, -jnp.inf)
        p = jax.nn.softmax(s, axis=-1)
        a = p[:, :, 0] - lam * p[:, :, 1]
        return jnp.einsum('bhqk,bhkd->bhqd', a.astype(v.dtype), v)

    o = lax.map(attend, (q_blocks, starts))
    o = o.transpose(1, 0, 3, 2, 4).reshape(Bn, T, B_HEADS, 2 * B_DH)
    gate = jax.nn.silu(z.astype(jnp.float32)).reshape(Bn, T, B_HEADS, 2 * B_DH)
    o = rms_norm(o, subln_w, 1e-5) * (1.0 - lam_init) * gate
    return o.reshape(Bn, T, B_V_W).astype(x.dtype) @ w_out


def setup_inputs(seed: int = 0) -> dict:
    key = jax.random.key(seed)
    ks = jax.random.split(key, 20)
    f32 = jnp.float32
    x = jax.random.normal(ks[0], (BATCH, SEQ, D_MODEL), f32)
    ln_g = 1.0 + 0.02 * jax.random.normal(ks[1], (DEPTH, D_MODEL), f32)
    ln_b = 0.02 * jax.random.normal(ks[2], (DEPTH, D_MODEL), f32)
    rel_bias = 0.5 * jax.random.normal(ks[3], (REL_BUCKETS, B_HEADS), f32)

    a_col_scale = jnp.ones((A_IN_W,), f32).at[2 * A_QK_W:A_CONV_CH].set(DEEPNORM_BETA)
    a_w_in = jax.random.normal(ks[4], (N_A_LAYERS, D_MODEL, A_IN_W), f32) * (D_MODEL ** -0.5) * a_col_scale
    a_conv_w = jax.random.normal(ks[5], (N_A_LAYERS, A_CONV_CH, A_CONV), f32) * (A_CONV ** -0.5)
    a_a_log = jnp.log(jax.random.uniform(ks[6], (N_A_LAYERS, A_HEADS), f32, 1.0, 16.0))
    dt = jnp.exp(jax.random.uniform(ks[7], (N_A_LAYERS, A_HEADS), f32, math.log(1e-3), math.log(1e-1)))
    a_dt_bias = dt + jnp.log(-jnp.expm1(-dt))
    a_norm_w = 1.0 + 0.02 * jax.random.normal(ks[8], (N_A_LAYERS, A_DV), f32)
    a_w_out = jax.random.normal(ks[9], (N_A_LAYERS, A_V_W, D_MODEL), f32) * (A_V_W ** -0.5) * DEEPNORM_BETA

    b_col_scale = jnp.ones((B_IN_W,), f32).at[2 * B_Q_W:2 * B_Q_W + B_V_W].set(DEEPNORM_BETA)
    b_w_in = jax.random.normal(ks[10], (N_B_LAYERS, D_MODEL, B_IN_W), f32) * (D_MODEL ** -0.5) * b_col_scale
    b_lam_q1 = 0.1 * jax.random.normal(ks[11], (N_B_LAYERS, B_DH), f32)
    b_lam_k1 = 0.1 * jax.random.normal(ks[12], (N_B_LAYERS, B_DH), f32)
    b_lam_q2 = 0.1 * jax.random.normal(ks[13], (N_B_LAYERS, B_DH), f32)
    b_lam_k2 = 0.1 * jax.random.normal(ks[14], (N_B_LAYERS, B_DH), f32)
    b_subln_w = 1.0 + 0.02 * jax.random.normal(ks[15], (N_B_LAYERS, 2 * B_DH), f32)
    b_w_out = jax.random.normal(ks[16], (N_B_LAYERS, B_V_W, D_MODEL), f32) * (B_V_W ** -0.5) * DEEPNORM_BETA
    return {"x": x, "ln_g": ln_g, "ln_b": ln_b, "rel_bias": rel_bias,
            "a_w_in": a_w_in, "a_conv_w": a_conv_w, "a_a_log": a_a_log, "a_dt_bias": a_dt_bias,
            "a_norm_w": a_norm_w, "a_w_out": a_w_out,
            "b_w_in": b_w_in, "b_lam_q1": b_lam_q1, "b_lam_k1": b_lam_k1, "b_lam_q2": b_lam_q2,
            "b_lam_k2": b_lam_k2, "b_subln_w": b_subln_w, "b_w_out": b_w_out}


def reference(x, ln_g, ln_b, rel_bias, a_w_in, a_conv_w, a_a_log, a_dt_bias, a_norm_w, a_w_out,
              b_w_in, b_lam_q1, b_lam_k1, b_lam_q2, b_lam_k2, b_subln_w, b_w_out):
    for i in range(DEPTH):
        j = i // N_MIXERS
        if i % N_MIXERS == 0:
            y = gated_deltanet_branch(x, a_w_in[j], a_conv_w[j], a_a_log[j], a_dt_bias[j],
                                      a_norm_w[j], a_w_out[j])
        else:
            y = diff_attention_branch(x, b_w_in[j], b_lam_q1[j], b_lam_k1[j], b_lam_q2[j], b_lam_k2[j],
                                      b_subln_w[j], rel_bias, b_w_out[j], i)
        x = layer_norm(DEEPNORM_ALPHA * x + y, ln_g[i], ln_b[i])
    return x
```

```cpp
#include <hip/hip_runtime.h>
#include <hip/hip_cooperative_groups.h>
#include <cstdio>
#include <cstdint>
namespace cg = cooperative_groups;
namespace pg8 {
#define PG8_LAS __attribute__((address_space(3)))
typedef unsigned short bf16_t;
typedef short bf16x8 __attribute__((ext_vector_type(8)));
typedef float f32x4 __attribute__((ext_vector_type(4)));
typedef unsigned u32x4 __attribute__((ext_vector_type(4)));
constexpr int BM = 256, BK = 64, HALF = 128, HTB = HALF * BK * 2  , STAGE_BYTES = 8 * HTB, NXCD = 8, WGM = 8;

__host__ __device__ __forceinline__ int lds_byte(int r, int c) { const int st = (r >> 4) * 2 + (c >> 5), rr = r & 15, cc = c & 31, ob = rr * 64 + cc * 2; return st * 1024 + (ob ^ (((ob >> 9) & 1) << 5)); }
__host__ __device__ __forceinline__ void stage_rc(int b, int& R, int& C) { const int st = b / 1024, sb = b % 1024, swz = sb ^ (((sb >> 9) & 1) << 5); R = (st >> 1) * 16 + swz / 64; C = (st & 1) * 32 + (swz % 64) / 2; }
__host__ __device__ __forceinline__ int perm32(int rho) { const int n = rho >> 4, i = rho & 15; return 8 * (i >> 2) + 4 * n + (i & 3); }

struct Unit { int pm, pn; };
struct Gemm { const bf16_t* A; const bf16_t* Bt; int M, N, K; };

struct StaticOrder {
    int nM, nN, nwg, G, c;
    __host__ __device__ void init(int M, int N, int G_, int c_) { nM = M / BM; nN = N / BM; nwg = nM * nN; G = G_; c = c_; }
    __host__ __device__ bool next(int i, Unit& u) const {
        const long L = (long)i * G + c; if (L >= nwg) return false;
        int wgid = (int)L; { const int q = nwg / NXCD, r = nwg % NXCD, xcd = wgid % NXCD, off = wgid / NXCD; wgid = (xcd < r ? xcd * (q + 1) : r * (q + 1) + (xcd - r) * q) + off; }
        const int nig = WGM * nN, gid = wgid / nig, fm = gid * WGM, gsz = (nM - fm) < WGM ? (nM - fm) : WGM;
        u.pm = fm + ((wgid % nig) % gsz); u.pn = (wgid % nig) / gsz; return true;
    }
    __device__ __forceinline__ void a_ready(const Unit&) const {}
    __device__ __forceinline__ void done(const Unit&) const {}
};

template <class Epi, class Sched, bool STAMP = false>
__device__ __forceinline__ void gemm_phase(PG8_LAS unsigned char* lds, const Gemm g, const Sched& S, const Epi& E, unsigned long long* stamps) {
    const int tid = threadIdx.x, wid = __builtin_amdgcn_readfirstlane(tid >> 6), lane = tid & 63, wr = wid >> 2, wc = wid & 3, fr = lane & 15, fq = lane >> 4;
    const int K = g.K, nt = K / BK;
    int ts_lo = 0, ts_hi = 0, nts = 0; const unsigned long long rt_entry = STAMP ? (unsigned long long)wall_clock64() : 0ull;
#define PG8_STAMP() do { if (STAMP && wid == 0 && nts < 64) { const unsigned long long _c = (unsigned long long)clock64(); \
        ts_lo = (lane == nts) ? (int)(unsigned)_c : ts_lo; ts_hi = (lane == nts) ? (int)(unsigned)(_c >> 32) : ts_hi; ++nts; } } while (0)
    PG8_STAMP();
    unsigned voffA[2], voffB[2];
#pragma unroll
    for (int i = 0; i < 2; ++i) { int R, C; stage_rc(tid * 16 + i * 8192, R, C); const int Rb = Epi::PERM ? ((R & ~31) + perm32(R & 31)) : R;
        voffA[i] = (unsigned)(R * K + C) * 2u; voffB[i] = (unsigned)(Rb * K + C) * 2u; }
    const size_t kstep = (size_t)(BK * 2);
    const size_t hstep = (size_t)HALF * K * 2;
    const size_t tstep = 2 * hstep;
    const unsigned ldsw = (unsigned)wid * 1024u;
    const int aoff = lds_byte(wr * 64 + fr, fq * 8), boff = lds_byte(wc * 32 + fr, fq * 8);
#define PG8_SA(b, h) (((b) * 2 + (h)) * HTB)
#define PG8_SB(b, h) ((4 + (b) * 2 + (h)) * HTB)
#define PG8_STAGE(bufoff, gbase, voff) do { _Pragma("unroll") for (int _i = 0; _i < 2; ++_i) \
        __builtin_amdgcn_global_load_lds((const unsigned*)((const char*)(gbase) + (voff)[_i]), (PG8_LAS unsigned*)(lds + (bufoff) + ldsw + _i * 8192), 16, 0, 0); } while (0)
#define PG8_LDA(dst, b, h) do { _Pragma("unroll") for (int m = 0; m < 4; ++m) _Pragma("unroll") for (int k = 0; k < 2; ++k) dst[m][k] = *(const PG8_LAS bf16x8*)(lds + PG8_SA(b, h) + aoff + m * 2048 + k * 1024); } while (0)
#define PG8_LDB(dst, b, h) do { _Pragma("unroll") for (int n = 0; n < 2; ++n) _Pragma("unroll") for (int k = 0; k < 2; ++k) dst[n][k] = *(const PG8_LAS bf16x8*)(lds + PG8_SB(b, h) + boff + n * 2048 + k * 1024); } while (0)
#define PG8_MMA(ai, bj, At, Bt) do { __builtin_amdgcn_s_setprio(1); _Pragma("unroll") for (int m = 0; m < 4; ++m) _Pragma("unroll") for (int n = 0; n < 2; ++n) _Pragma("unroll") for (int k = 0; k < 2; ++k) \
        acc[ai][bj][m][n] = __builtin_amdgcn_mfma_f32_16x16x32_bf16(Bt[n][k], At[m][k], acc[ai][bj][m][n], 0, 0, 0); __builtin_amdgcn_s_setprio(0); } while (0)
#define PG8_WAIT_V(n) asm volatile("s_waitcnt vmcnt(" #n ")" ::: "memory")
#define PG8_WAIT_L(n) asm volatile("s_waitcnt lgkmcnt(" #n ")" ::: "memory")
#define PG8_BAR __builtin_amdgcn_s_barrier()
#define PG8_SCHED __builtin_amdgcn_sched_barrier(0)
    Unit cur, nxt; int ui = 0;
    if (!S.next(0, cur)) return;
    f32x4 acc[2][2][4][2];
#pragma unroll
    for (int a = 0; a < 2; ++a)
#pragma unroll
        for (int b = 0; b < 2; ++b)
#pragma unroll
            for (int m = 0; m < 4; ++m)
#pragma unroll
                for (int n = 0; n < 2; ++n) acc[a][b][m][n] = (f32x4){0.f, 0.f, 0.f, 0.f};
    bf16x8 At[4][2], B0[2][2], B1[2][2];
    const char* cA = (const char*)g.A + (size_t)cur.pm * tstep; const char* cB = (const char*)g.Bt + (size_t)cur.pn * tstep;
    S.a_ready(cur);
    PG8_STAGE(PG8_SB(0, 0), cB, voffB); PG8_STAGE(PG8_SA(0, 0), cA, voffA); PG8_STAGE(PG8_SB(0, 1), cB + hstep, voffB); PG8_STAGE(PG8_SA(0, 1), cA + hstep, voffA);
    if (wr == 1) PG8_BAR;
    PG8_WAIT_V(4); PG8_BAR;
    PG8_STAGE(PG8_SB(1, 0), cB + kstep, voffB); PG8_STAGE(PG8_SA(1, 0), cA + kstep, voffA); PG8_STAGE(PG8_SB(1, 1), cB + hstep + kstep, voffB);
    PG8_WAIT_V(6); PG8_BAR;
    PG8_STAMP();
    for (;;) {
        const bool has_next = S.next(ui + 1, nxt);
        const char* nA = has_next ? (const char*)g.A + (size_t)nxt.pm * tstep : cA; const char* nB = has_next ? (const char*)g.Bt + (size_t)nxt.pn * tstep : cB;
        for (int t = 0; t < nt; t += 2) {
            const bool last = (t == nt - 2);
            const char* a1 = cA + (size_t)(t + 1) * kstep;
            const char* a2 = last ? nA : cA + (size_t)(t + 2) * kstep; const char* b2 = last ? nB : cB + (size_t)(t + 2) * kstep;
            const char* a3 = a2 + kstep; const char* b3 = b2 + kstep;
            if (last && has_next) S.a_ready(nxt);
            PG8_LDB(B0, 0, 0); PG8_SCHED; PG8_LDA(At, 0, 0); PG8_STAGE(PG8_SA(1, 1), a1 + hstep, voffA);
            PG8_WAIT_L(8); PG8_BAR; PG8_WAIT_L(0); PG8_MMA(0, 0, At, B0); PG8_BAR; PG8_SCHED;
            PG8_LDB(B1, 0, 1); PG8_STAGE(PG8_SB(0, 0), b2, voffB);
            PG8_BAR; PG8_WAIT_L(0); PG8_MMA(0, 1, At, B1); PG8_BAR;
            PG8_LDA(At, 0, 1); PG8_STAGE(PG8_SA(0, 0), a2, voffA);
            PG8_BAR; PG8_WAIT_L(0); PG8_MMA(1, 0, At, B0); PG8_BAR; PG8_SCHED;
            PG8_STAGE(PG8_SB(0, 1), b2 + hstep, voffB);
            PG8_WAIT_V(6); PG8_BAR; PG8_MMA(1, 1, At, B1); PG8_BAR;
            PG8_LDB(B0, 1, 0); PG8_SCHED; PG8_LDA(At, 1, 0); PG8_STAGE(PG8_SA(0, 1), a2 + hstep, voffA);
            PG8_WAIT_L(8); PG8_BAR; PG8_WAIT_L(0); PG8_MMA(0, 0, At, B0); PG8_BAR; PG8_SCHED;
            PG8_LDB(B1, 1, 1); PG8_STAGE(PG8_SB(1, 0), b3, voffB);
            PG8_BAR; PG8_WAIT_L(0); PG8_MMA(0, 1, At, B1); PG8_BAR;
            PG8_LDA(At, 1, 1); PG8_STAGE(PG8_SA(1, 0), a3, voffA);
            PG8_BAR; PG8_WAIT_L(0); PG8_MMA(1, 0, At, B0); PG8_BAR; PG8_SCHED;
            PG8_STAGE(PG8_SB(1, 1), b3 + hstep, voffB);
            PG8_WAIT_V(6); PG8_BAR; PG8_MMA(1, 1, At, B1); PG8_BAR;
        }
        PG8_STAMP();
        if constexpr (!Epi::AFTER_DRAIN) { E(acc, cur, wr, wc, fr, fq); S.done(cur); }
        PG8_STAMP();
        if (!has_next) break;
#pragma unroll
        for (int a = 0; a < 2; ++a)
#pragma unroll
            for (int b = 0; b < 2; ++b)
#pragma unroll
                for (int m = 0; m < 4; ++m)
#pragma unroll
                    for (int n = 0; n < 2; ++n) acc[a][b][m][n] = (f32x4){0.f, 0.f, 0.f, 0.f};
        cur = nxt; cA = nA; cB = nB; ++ui;
    }
    PG8_WAIT_V(0);
    if (wr == 0) PG8_BAR;
    PG8_BAR;
    if constexpr (Epi::AFTER_DRAIN) { E.fused(acc, cur, wr, wc, fr, fq, lds, wid, lane); S.done(cur); }
    PG8_STAMP();
    if (STAMP && wid == 0) { stamps[lane] = lane < nts ? (((unsigned long long)(unsigned)ts_hi << 32) | (unsigned)ts_lo) : 0ull;
        if (lane == 62) stamps[62] = rt_entry; if (lane == 63) stamps[63] = (unsigned long long)wall_clock64(); }
#undef PG8_STAMP
#undef PG8_SA
#undef PG8_SB
#undef PG8_STAGE
#undef PG8_LDA
#undef PG8_LDB
#undef PG8_MMA
#undef PG8_WAIT_V
#undef PG8_WAIT_L
#undef PG8_BAR
#undef PG8_SCHED
}
}

#define DI __device__ __forceinline__
#define LAS __attribute__((address_space(3)))
typedef unsigned short bf16_t;
typedef short bf16x8 __attribute__((ext_vector_type(8)));
typedef float f32x2 __attribute__((ext_vector_type(2)));
typedef float f32x4 __attribute__((ext_vector_type(4)));
typedef float f32x16 __attribute__((ext_vector_type(16)));
typedef unsigned u32x2 __attribute__((ext_vector_type(2)));
typedef unsigned u32x4 __attribute__((ext_vector_type(4)));
typedef __bf16 bf16v2 __attribute__((ext_vector_type(2)));
typedef LAS unsigned char* ldsp_t;

constexpr int NTOK = 16384, DM = 4096, SEQ = 4096;
constexpr float ALPHA = 1.4142135623730951f;
constexpr float LAM_INIT = 0.35550906759096926f;
constexpr float LOG2E = 1.4426950408889634f;

constexpr size_t OFF_ACT = 0;
constexpr size_t OFF_WIN = 134217728ull;
constexpr size_t OFF_WOUT = OFF_WIN + 136314880ull;
constexpr size_t OFF_H = OFF_WOUT + 33554432ull;
constexpr size_t OFF_AB = OFF_H + 536870912ull;
constexpr size_t OFF_R = OFF_AB + 4194304ull;
constexpr size_t OFF_AA = OFF_R + 134217728ull;
constexpr size_t OFF_CD = OFF_AA + 67108864ull;
constexpr size_t OFF_BT = OFF_CD + 32768ull;
constexpr size_t WS_NEED = OFF_BT + 16384ull;

constexpr int LDS_BYTES = 160 * 1024;

struct Params {
    const float* x; const float* ln_g; const float* ln_b; const float* rel_bias;
    const float* a_w_in; const float* a_conv_w; const float* a_a_log; const float* a_dt_bias; const float* a_norm_w; const float* a_w_out;
    const float* b_w_in; const float* lq1; const float* lk1; const float* lq2; const float* lk2; const float* subln_w; const float* b_w_out;
    float* out; unsigned char* ws; int ph_lo, ph_hi;
};

DI float bf2f(unsigned short b) { return __uint_as_float(((unsigned)b) << 16); }
DI unsigned pk2(float lo, float hi) { f32x2 v = {lo, hi}; bf16v2 b = __builtin_convertvector(v, bf16v2); return __builtin_bit_cast(unsigned, b); }
DI unsigned short f2bf(float f) { return (unsigned short)(pk2(f, 0.f) & 0xffffu); }
DI bf16x8 pack8(float a0, float a1, float a2, float a3, float a4, float a5, float a6, float a7) {
    u32x4 w = {pk2(a0, a1), pk2(a2, a3), pk2(a4, a5), pk2(a6, a7)}; return __builtin_bit_cast(bf16x8, w);
}
DI bf16x8 pack8v(const f32x16& x, int s) { return pack8(x[8 * s], x[8 * s + 1], x[8 * s + 2], x[8 * s + 3], x[8 * s + 4], x[8 * s + 5], x[8 * s + 6], x[8 * s + 7]); }
DI int crow(int r, int hi) { return (r & 3) + 8 * (r >> 2) + 4 * hi; }
DI float siluf(float x) { return x / (1.f + __expf(-x)); }
DI float wsum(float v) { for (int o = 32; o >= 1; o >>= 1) v += __shfl_xor(v, o); return v; }
#define MFMA32(a, b, c) __builtin_amdgcn_mfma_f32_32x32x16_bf16((a), (b), (c), 0, 0, 0)
DI bf16x8 lds8(ldsp_t p) { return *(const LAS bf16x8*)p; }
DI void wait_vm0() { asm volatile("s_waitcnt vmcnt(0)" ::: "memory"); }
DI void dma4(const void* g, ldsp_t l) { __builtin_amdgcn_global_load_lds((const unsigned*)g, (LAS unsigned*)l, 4, 0, 0); }
DI void dma16(const void* g, ldsp_t l) { __builtin_amdgcn_global_load_lds((const unsigned*)g, (LAS unsigned*)l, 16, 0, 0); }

struct EpiH {
    static constexpr bool PERM = true, AFTER_DRAIN = false;
    bf16_t* H; float* AB;
    DI void operator()(const pg8::f32x4 (&acc)[2][2][4][2], const pg8::Unit& u, int wr, int wc, int fr, int fq) const {
        const int row0 = u.pm * 256 + wr * 64 + fr;
        if (u.pn < 64) {
            const int col0 = u.pn * 256 + wc * 32 + 8 * fq;
#pragma unroll
            for (int ai = 0; ai < 2; ++ai)
#pragma unroll
                for (int m = 0; m < 4; ++m) { bf16_t* rowp = H + (size_t)(row0 + ai * 128 + m * 16) * 16384 + col0;
#pragma unroll
                    for (int bj = 0; bj < 2; ++bj) { const pg8::f32x4 v0 = acc[ai][bj][m][0], v1 = acc[ai][bj][m][1];
                        u32x4 w = {pk2(v0[0], v0[1]), pk2(v0[2], v0[3]), pk2(v1[0], v1[1]), pk2(v1[2], v1[3])};
                        *(u32x4*)(rowp + bj * 128) = w; } }
        } else if (wc < 2) {
            const int col0 = wc * 32 + 8 * fq;
#pragma unroll
            for (int ai = 0; ai < 2; ++ai)
#pragma unroll
                for (int m = 0; m < 4; ++m) { float* rowp = AB + (size_t)(row0 + ai * 128 + m * 16) * 64 + col0;
                    *(pg8::f32x4*)rowp = acc[ai][0][m][0]; *(pg8::f32x4*)(rowp + 4) = acc[ai][0][m][1]; }
        }
    }
};
struct EpiRes {
    static constexpr bool PERM = false, AFTER_DRAIN = false;
    const float* res; float* out;
    DI void operator()(const pg8::f32x4 (&acc)[2][2][4][2], const pg8::Unit& u, int wr, int wc, int fr, int fq) const {
        const int row0 = u.pm * 256 + wr * 64 + fr, col0 = u.pn * 256 + wc * 32 + 4 * fq;
#pragma unroll
        for (int ai = 0; ai < 2; ++ai)
#pragma unroll
            for (int m = 0; m < 4; ++m) { const size_t ro = (size_t)(row0 + ai * 128 + m * 16) * 4096 + col0;
#pragma unroll
                for (int bj = 0; bj < 2; ++bj)
#pragma unroll
                    for (int n = 0; n < 2; ++n) { const size_t o = ro + bj * 128 + n * 16; const pg8::f32x4 r = *(const pg8::f32x4*)(res + o);
                        *(pg8::f32x4*)(out + o) = r * ALPHA + acc[ai][bj][m][n]; } }
    }
};

DI void cvt_rows(const float* src, bf16_t* dst, size_t n8) {
    for (size_t i = (size_t)blockIdx.x * 512 + threadIdx.x; i < n8; i += (size_t)gridDim.x * 512) {
        const f32x4 a = *(const f32x4*)(src + i * 8), b = *(const f32x4*)(src + i * 8 + 4);
        *(bf16x8*)(dst + i * 8) = pack8(a[0], a[1], a[2], a[3], b[0], b[1], b[2], b[3]);
    }
}
DI void transpose_w(const float* W, int N, int Npad, bf16_t* WT, ldsp_t lds) {
    const int tid = threadIdx.x; const int ntn = Npad / 64, ntiles = 32 * ntn;
    LAS bf16_t* T = (LAS bf16_t*)lds;
    for (int tile = blockIdx.x; tile < ntiles; tile += gridDim.x) {
        const int tn = tile % ntn, tk = tile / ntn; const int n0 = tn * 64, k0 = tk * 128;
        if (n0 < N) {
#pragma unroll
            for (int ps = 0; ps < 4; ++ps) { const int kr = ps * 32 + (tid >> 4), n4 = (tid & 15) * 4;
                const f32x4 v = *(const f32x4*)(W + (size_t)(k0 + kr) * N + n0 + n4);
#pragma unroll
                for (int j = 0; j < 4; ++j) T[(n4 + j) * 136 + kr] = f2bf(v[j]); }
        }
        __syncthreads();
#pragma unroll
        for (int ps = 0; ps < 2; ++ps) { const int n = ps * 32 + (tid >> 4), kc = (tid & 15) * 8;
            bf16x8 v = {0, 0, 0, 0, 0, 0, 0, 0};
            if (n0 < N) v = *(const LAS bf16x8*)(T + n * 136 + kc);
            *(bf16x8*)(WT + (size_t)(n0 + n) * 4096 + k0 + kc) = v; }
        __syncthreads();
    }
}
DI void bias_table(const float* rel_bias, float* BT) {
    const int i = blockIdx.x * 512 + threadIdx.x;
    if (i < 4096) { const int h = i >> 8, n = i & 255; int bk;
        if (n < 16) bk = n; else { bk = 16 + (int)(log((double)n / 16.0) / log(8.0) * 16.0); if (bk > 31) bk = 31; }
        BT[i] = rel_bias[bk * 16 + h] * LOG2E; }
}

DI void ln_phase(float* io, const float* g, const float* bv, bf16_t* outb) {
    const int lane = threadIdx.x & 63, wid = threadIdx.x >> 6;
    for (int row = blockIdx.x * 8 + wid; row < NTOK; row += gridDim.x * 8) {
        float* p = io + (size_t)row * DM; f32x4 v[16]; float s = 0.f;
#pragma unroll
        for (int i = 0; i < 16; ++i) { v[i] = *(const f32x4*)(p + (i * 64 + lane) * 4); s += v[i][0] + v[i][1] + v[i][2] + v[i][3]; }
        const float mean = wsum(s) * (1.f / DM); float q = 0.f;
#pragma unroll
        for (int i = 0; i < 16; ++i) { v[i] = v[i] - mean; q += v[i][0] * v[i][0] + v[i][1] * v[i][1] + v[i][2] * v[i][2] + v[i][3] * v[i][3]; }
        const float rstd = rsqrtf(wsum(q) * (1.f / DM) + 1e-5f);
#pragma unroll
        for (int i = 0; i < 16; ++i) { const int col = (i * 64 + lane) * 4; const f32x4 gg = *(const f32x4*)(g + col), bb = *(const f32x4*)(bv + col);
            const f32x4 y = v[i] * rstd * gg + bb; *(f32x4*)(p + col) = y;
            if (outb) { u32x2 w = {pk2(y[0], y[1]), pk2(y[2], y[3])}; *(u32x2*)(outb + (size_t)row * DM + col) = w; } }
    }
}

constexpr int L_KH = 0, L_QH = 17408, L_KT = 34816, L_VT = 53248, L_LF = 71680, L_LT = 88064, L_TF = 104448, L_T1 = 120832, L_T2 = 130048, L_GC = 139264, L_BE = 139520;
DI void p2a_phase(const Params& P, ldsp_t lds) {
    const int tid = threadIdx.x, wid = __builtin_amdgcn_readfirstlane(tid >> 6), lane = tid & 63, c32 = lane & 31, hi = lane >> 5;
    const bf16_t* H = (const bf16_t*)(P.ws + OFF_H); const float* AB = (const float*)(P.ws + OFF_AB);
    bf16_t* NW = (bf16_t*)P.out; bf16_t* UU = (bf16_t*)P.out + 67108864ull; bf16_t* QD = (bf16_t*)(P.ws + OFF_WIN); bf16_t* KST = (bf16_t*)(P.ws + OFF_ACT);
    bf16_t* AA = (bf16_t*)(P.ws + OFF_AA); float* CD = (float*)(P.ws + OFF_CD);
    LAS bf16_t* KH = (LAS bf16_t*)(lds + L_KH); LAS bf16_t* QH = (LAS bf16_t*)(lds + L_QH); LAS bf16_t* KT = (LAS bf16_t*)(lds + L_KT); LAS bf16_t* VT = (LAS bf16_t*)(lds + L_VT);
    LAS float* LF = (LAS float*)(lds + L_LF); LAS float* LT = (LAS float*)(lds + L_LT); LAS float* TF = (LAS float*)(lds + L_TF); LAS bf16_t* T1 = (LAS bf16_t*)(lds + L_T1); LAS bf16_t* T2 = (LAS bf16_t*)(lds + L_T2);
    LAS float* GC = (LAS float*)(lds + L_GC); LAS float* BE = (LAS float*)(lds + L_BE);
    for (int item = blockIdx.x; item < 8192; item += gridDim.x) {
        const int bh = item >> 6, chunk = item & 63, b = bh >> 5, h = bh & 31; const size_t ci = (size_t)item;
#pragma unroll 1
        for (int i = 0; i < 6; ++i) {
            const int tensor = i >> 1, row = (i & 1) * 32 + (tid >> 4), grp = tid & 15;
            const int tseq = chunk * 64 + row, col = tensor * 4096 + h * 128 + grp * 8;
            const bf16_t* src = H + (size_t)(b * SEQ + tseq) * 16384 + col;
            const float* wp = P.a_conv_w + (size_t)col * 4;
            f32x4 w4[8];
#pragma unroll
            for (int e = 0; e < 8; ++e) w4[e] = *(const f32x4*)(wp + e * 4);
            float y[8];
#pragma unroll
            for (int e = 0; e < 8; ++e) y[e] = 0.f;
#pragma unroll
            for (int j = 0; j < 4; ++j) {
                if (tseq - 3 + j >= 0) { const bf16x8 xv = *(const bf16x8*)(src + (long)(j - 3) * 16384);
#pragma unroll
                    for (int e = 0; e < 8; ++e) y[e] += bf2f((unsigned short)xv[e]) * w4[e][j]; }
            }
#pragma unroll
            for (int e = 0; e < 8; ++e) y[e] = siluf(y[e]);
            if (tensor < 2) {
                float ss = 0.f;
#pragma unroll
                for (int e = 0; e < 8; ++e) ss += y[e] * y[e];
                ss += __shfl_xor(ss, 1); ss += __shfl_xor(ss, 2); ss += __shfl_xor(ss, 4); ss += __shfl_xor(ss, 8);
                float r = rsqrtf(ss + 1e-6f); if (tensor == 0) r *= 0.08838834764831845f;
#pragma unroll
                for (int e = 0; e < 8; ++e) y[e] *= r;
            }
            const bf16x8 pv = pack8(y[0], y[1], y[2], y[3], y[4], y[5], y[6], y[7]);
            if (tensor == 0) { *(LAS bf16x8*)(QH + row * 136 + grp * 8) = pv; }
            else if (tensor == 1) { *(LAS bf16x8*)(KH + row * 136 + grp * 8) = pv;
#pragma unroll
                for (int e = 0; e < 8; ++e) KT[(grp * 8 + e) * 72 + row] = (bf16_t)pv[e]; }
            else {
#pragma unroll
                for (int e = 0; e < 8; ++e) VT[(grp * 8 + e) * 72 + row] = (bf16_t)pv[e]; }
        }
        if (wid == 0) {
            const size_t tr = (size_t)(b * SEQ + chunk * 64 + lane) * 64;
            const float av = AB[tr + h], bvv = AB[tr + 32 + h];
            const float xs = av + P.a_dt_bias[h];
            const float sp = xs > 20.f ? xs : log1pf(__expf(xs));
            float g = -__expf(P.a_a_log[h]) * sp;
#pragma unroll
            for (int o = 1; o < 64; o <<= 1) { const float t = __shfl_up(g, o); if (lane >= o) g += t; }
            GC[lane] = g; BE[lane] = 1.f / (1.f + __expf(-bvv));
            if (lane == 63) CD[ci] = __expf(g);
        }
        __syncthreads();
        {
            int widv = wid; asm volatile("" : "+s"(widv));
            const int prod = widv >> 2, ti = (widv >> 1) & 1, tj = widv & 1;
            LAS bf16_t* Bm = prod ? QH : KH;
            f32x16 acc; for (int r = 0; r < 16; ++r) acc[r] = 0.f;
#pragma unroll
            for (int ks = 0; ks < 8; ++ks) { const bf16x8 a = *(const LAS bf16x8*)(KH + (32 * ti + c32) * 136 + 16 * ks + 8 * hi);
                const bf16x8 bq = *(const LAS bf16x8*)(Bm + (32 * tj + c32) * 136 + 16 * ks + 8 * hi); acc = MFMA32(a, bq, acc); }
            const int col = 32 * tj + c32; const float gcc = GC[col], bec = BE[col];
            if (prod == 0) {
#pragma unroll
                for (int r = 0; r < 16; ++r) { const int i = 32 * ti + crow(r, hi);
                    const float gi = GC[i]; const float v = BE[i] * acc[r] * __expf(gi - gcc); LF[i * 64 + col] = (i > col) ? v : 0.f;
                    const float vt = bec * acc[r] * __expf(gcc - gi); LT[i * 64 + col] = (col > i) ? vt : 0.f; }
            } else {
                float vals[16];
#pragma unroll
                for (int r = 0; r < 16; ++r) { const int s = 32 * ti + crow(r, hi); const float v = acc[r] * __expf(gcc - GC[s]); vals[r] = (col >= s) ? v : 0.f; }
#pragma unroll
                for (int hb = 0; hb < 2; ++hb)
                    *(bf16x8*)(AA + ci * 4096 + (size_t)((tj * 4 + 2 * ti + hb) * 64 + lane) * 8) =
                        pack8(vals[8 * hb], vals[8 * hb + 1], vals[8 * hb + 2], vals[8 * hb + 3], vals[8 * hb + 4], vals[8 * hb + 5], vals[8 * hb + 6], vals[8 * hb + 7]);
            }
        }
        __syncthreads();
        if (wid == 0) {
            const float be = BE[lane], beg = be * __expf(GC[lane]);
            int zv = 0; asm volatile("" : "+v"(zv));
            LAS float* LFz = LF + zv; LAS float* LTz = LT + zv;
#pragma unroll 1
            for (int rb = 0; rb < 4; ++rb) {
                const int r0 = 16 * rb;
                float acc[16];
#pragma unroll
                for (int ii = 0; ii < 16; ++ii) acc[ii] = (r0 + ii == lane) ? 1.f : 0.f;
                for (int j = 0; j < r0; ++j) {
                    const float t = TF[j * 64 + lane];
#pragma unroll
                    for (int q = 0; q < 4; ++q) { const f32x4 l4 = *(const LAS f32x4*)(LTz + j * 64 + r0 + 4 * q);
                        acc[4 * q] -= l4[0] * t; acc[4 * q + 1] -= l4[1] * t; acc[4 * q + 2] -= l4[2] * t; acc[4 * q + 3] -= l4[3] * t; }
                }
                float Tb[16];
#pragma unroll
                for (int ii = 0; ii < 16; ++ii) { float a = acc[ii];
#pragma unroll
                    for (int jj = 0; jj < ii; jj += 4) { const f32x4 l4 = *(const LAS f32x4*)(LFz + (r0 + ii) * 64 + r0 + jj);
                        a -= l4[0] * Tb[jj]; if (jj + 1 < ii) a -= l4[1] * Tb[jj + 1]; if (jj + 2 < ii) a -= l4[2] * Tb[jj + 2]; if (jj + 3 < ii) a -= l4[3] * Tb[jj + 3]; }
                    Tb[ii] = a; }
#pragma unroll
                for (int ii = 0; ii < 16; ++ii) { TF[(r0 + ii) * 64 + lane] = Tb[ii]; T1[(r0 + ii) * 72 + lane] = f2bf(-Tb[ii] * beg); T2[(r0 + ii) * 72 + lane] = f2bf(Tb[ii] * be); }
            }
        } else {
            const float gl = GC[63];
            for (int idx = tid - 64; idx < 2048; idx += 448) {
                if (idx < 1024) { const int f = idx, mi = f >> 9, ks = (f >> 6) & 7, l = f & 63, m = l & 31, g = l >> 5, tok = 32 * mi + m;
                    const u32x2 e0 = *(const LAS u32x2*)(QH + tok * 136 + 16 * ks + 4 * g), e1 = *(const LAS u32x2*)(QH + tok * 136 + 16 * ks + 8 + 4 * g);
                    const float sc = __expf(GC[tok]);
                    *(bf16x8*)(QD + ci * 8192 + (size_t)f * 8) = pack8(__uint_as_float(e0[0] << 16) * sc, __uint_as_float(e0[0] & 0xffff0000u) * sc, __uint_as_float(e0[1] << 16) * sc, __uint_as_float(e0[1] & 0xffff0000u) * sc,
                                                                      __uint_as_float(e1[0] << 16) * sc, __uint_as_float(e1[0] & 0xffff0000u) * sc, __uint_as_float(e1[1] << 16) * sc, __uint_as_float(e1[1] & 0xffff0000u) * sc);
                } else { const int f = idx - 1024, mt = f >> 8, ks = (f >> 6) & 3, l = f & 63, m = l & 31, g = l >> 5, dk = 32 * mt + m;
                    const int s0 = 16 * ks + 4 * g, s1 = s0 + 8;
                    const u32x2 e0 = *(const LAS u32x2*)(KT + dk * 72 + s0), e1 = *(const LAS u32x2*)(KT + dk * 72 + s1);
                    const f32x4 g0 = *(const LAS f32x4*)(GC + s0), g1 = *(const LAS f32x4*)(GC + s1);
                    *(bf16x8*)(KST + ci * 8192 + (size_t)f * 8) = pack8(__uint_as_float(e0[0] << 16) * __expf(gl - g0[0]), __uint_as_float(e0[0] & 0xffff0000u) * __expf(gl - g0[1]),
                                                                       __uint_as_float(e0[1] << 16) * __expf(gl - g0[2]), __uint_as_float(e0[1] & 0xffff0000u) * __expf(gl - g0[3]),
                                                                       __uint_as_float(e1[0] << 16) * __expf(gl - g1[0]), __uint_as_float(e1[0] & 0xffff0000u) * __expf(gl - g1[1]),
                                                                       __uint_as_float(e1[1] << 16) * __expf(gl - g1[2]), __uint_as_float(e1[1] & 0xffff0000u) * __expf(gl - g1[3]));
                }
            }
        }
        __syncthreads();
#pragma unroll 1
        for (int jj = 0; jj < 2; ++jj) {
            const int j = wid * 2 + jj;
            f32x16 acc; for (int r = 0; r < 16; ++r) acc[r] = 0.f;
            if (j < 8) { const int dt = j >> 1, mi = j & 1;
#pragma unroll
                for (int kk = 0; kk < 4; ++kk) { const bf16x8 a = *(const LAS bf16x8*)(KT + (32 * dt + c32) * 72 + 16 * kk + 8 * hi);
                    const bf16x8 bq = *(const LAS bf16x8*)(T1 + (32 * mi + c32) * 72 + 16 * kk + 8 * hi); acc = MFMA32(a, bq, acc); }
#pragma unroll
                for (int hb = 0; hb < 2; ++hb) *(bf16x8*)(NW + ci * 8192 + (size_t)((mi * 8 + 2 * dt + hb) * 64 + lane) * 8) = pack8v(acc, hb);
            } else { const int j2 = j - 8, mi = j2 >> 2, nt = j2 & 3;
#pragma unroll
                for (int kk = 0; kk < 4; ++kk) { const bf16x8 a = *(const LAS bf16x8*)(T2 + (32 * mi + c32) * 72 + 16 * kk + 8 * hi);
                    const bf16x8 bq = *(const LAS bf16x8*)(VT + (32 * nt + c32) * 72 + 16 * kk + 8 * hi); acc = MFMA32(a, bq, acc); }
                bf16_t* up = UU + ci * 8192 + (size_t)((mi * 4 + nt) * 64 + lane) * 16;
                *(bf16x8*)up = pack8v(acc, 0); *(bf16x8*)(up + 8) = pack8v(acc, 1);
            }
        }
        __syncthreads();
    }
}

DI f32x16 unpack16(const bf16x8 a, const bf16x8 b) { f32x16 r;
#pragma unroll
    for (int e = 0; e < 8; ++e) { r[e] = bf2f((unsigned short)a[e]); r[8 + e] = bf2f((unsigned short)b[e]); } return r; }
DI void scan_phase(const Params& P, ldsp_t lds) {
    if (blockIdx.x >= 128) return;
    const int tid = threadIdx.x, wid = __builtin_amdgcn_readfirstlane(tid >> 6), lane = tid & 63, c32 = lane & 31, hi = lane >> 5;
    const int bh = blockIdx.x, b = bh >> 5, h = bh & 31;
    const bf16_t* H = (const bf16_t*)(P.ws + OFF_H);
    const bf16_t* NW = (const bf16_t*)P.out; const bf16_t* UU = (const bf16_t*)P.out + 67108864ull; const bf16_t* QD = (const bf16_t*)(P.ws + OFF_WIN); const bf16_t* KST = (const bf16_t*)(P.ws + OFF_ACT);
    const bf16_t* AA = (const bf16_t*)(P.ws + OFF_AA); const float* CD = (const float*)(P.ws + OFF_CD); bf16_t* O0 = (bf16_t*)(P.ws + OFF_R);
    constexpr int OPB = 57344, L_OB = 2 * OPB, OBB = 17408;
    const bool helper = wid >= 4;
    f32x16 S[4]; bf16x8 un[4];
#pragma unroll
    for (int mt = 0; mt < 4; ++mt) for (int r = 0; r < 16; ++r) S[mt][r] = 0.f;
    auto dma_chunk = [&](int cc, int buf) {
        const size_t ci = (size_t)bh * 64 + cc; const int hw = wid - 4;
#pragma unroll 1
        for (int i = 0; i < 14; ++i) { const int piece = hw * 14 + i;
            const bf16_t* src;
            if (piece < 16) src = NW + ci * 8192 + piece * 512; else if (piece < 32) src = QD + ci * 8192 + (piece - 16) * 512;
            else if (piece < 48) src = KST + ci * 8192 + (piece - 32) * 512; else src = AA + ci * 4096 + (piece - 48) * 512;
            dma16(src + lane * 8, lds + buf * OPB + piece * 1024); }
    };
    auto load_u = [&](int cc) {
        const size_t ci = (size_t)bh * 64 + cc;
#pragma unroll
        for (int mi = 0; mi < 2; ++mi) { const bf16_t* up = UU + ci * 8192 + (size_t)((mi * 4 + wid) * 64 + lane) * 16; un[2 * mi] = *(const bf16x8*)up; un[2 * mi + 1] = *(const bf16x8*)(up + 8); }
    };
    if (helper) dma_chunk(0, 0); else load_u(0);
    wait_vm0(); __syncthreads();
#pragma unroll 1
    for (int c = 0; c <= 64; ++c) {
        if (helper) {
            if (c + 1 < 64) dma_chunk(c + 1, (c + 1) & 1);
            if (c >= 1) {
                const int cp = c - 1, ht = tid - 256; ldsp_t ob = lds + L_OB + (cp & 1) * OBB;
#pragma unroll
                for (int ps = 0; ps < 4; ++ps) { const int tok = ps * 16 + (ht >> 4), cg8 = (ht & 15) * 8;
                    const bf16x8 ov = *(const LAS bf16x8*)(ob + (tok * 136 + cg8) * 2);
                    float o[8], ss = 0.f;
#pragma unroll
                    for (int e = 0; e < 8; ++e) { o[e] = bf2f((unsigned short)ov[e]); ss += o[e] * o[e]; }
                    ss += __shfl_xor(ss, 1); ss += __shfl_xor(ss, 2); ss += __shfl_xor(ss, 4); ss += __shfl_xor(ss, 8);
                    const float rs = rsqrtf(ss * (1.f / 128.f) + 1e-6f);
                    const size_t trow = (size_t)(b * SEQ + cp * 64 + tok);
                    const bf16x8 zv = *(const bf16x8*)(H + trow * 16384 + 12288 + h * 128 + cg8);
                    const f32x4 w0 = *(const f32x4*)(P.a_norm_w + cg8), w1 = *(const f32x4*)(P.a_norm_w + cg8 + 4);
                    float r[8];
#pragma unroll
                    for (int e = 0; e < 8; ++e) r[e] = o[e] * rs * (e < 4 ? w0[e & 3] : w1[e & 3]) * siluf(bf2f((unsigned short)zv[e]));
                    *(bf16x8*)(O0 + trow * 4096 + h * 128 + cg8) = pack8(r[0], r[1], r[2], r[3], r[4], r[5], r[6], r[7]);
                }
            }
        } else if (c < 64) {
            ldsp_t op = lds + (c & 1) * OPB + lane * 16;
            const float cd = CD[(size_t)bh * 64 + c];
            f32x16 v0 = unpack16(un[0], un[1]), v1 = unpack16(un[2], un[3]);
            if (c + 1 < 64) load_u(c + 1);
            bf16x8 Sb[8];
#pragma unroll
            for (int mt = 0; mt < 4; ++mt) { Sb[2 * mt] = pack8v(S[mt], 0); Sb[2 * mt + 1] = pack8v(S[mt], 1); }
            f32x16 o0, o1; for (int r = 0; r < 16; ++r) { o0[r] = 0.f; o1[r] = 0.f; }
#define SB0 __builtin_amdgcn_sched_barrier(0)
            SB0;
#pragma unroll
            for (int g = 0; g < 4; ++g) {
#pragma unroll
                for (int k2 = 0; k2 < 2; ++k2) { const int ks = 2 * g + k2; v0 = MFMA32(lds8(op + ks * 1024), Sb[ks], v0); v1 = MFMA32(lds8(op + (8 + ks) * 1024), Sb[ks], v1); }
                SB0; }
#pragma unroll
            for (int g = 0; g < 4; ++g) {
#pragma unroll
                for (int k2 = 0; k2 < 2; ++k2) { const int ks = 2 * g + k2; o0 = MFMA32(lds8(op + 16384 + ks * 1024), Sb[ks], o0); o1 = MFMA32(lds8(op + 16384 + (8 + ks) * 1024), Sb[ks], o1); }
                SB0; }
            bf16x8 Vb[4]; Vb[0] = pack8v(v0, 0); Vb[1] = pack8v(v0, 1); Vb[2] = pack8v(v1, 0); Vb[3] = pack8v(v1, 1);
            SB0;
#pragma unroll
            for (int g = 0; g < 2; ++g) {
#pragma unroll
                for (int k2 = 0; k2 < 2; ++k2) { const int ks = 2 * g + k2; o0 = MFMA32(lds8(op + 49152 + ks * 1024), Vb[ks], o0); o1 = MFMA32(lds8(op + 49152 + (4 + ks) * 1024), Vb[ks], o1); }
                SB0; }
#pragma unroll
            for (int mt = 0; mt < 4; ++mt) { S[mt] = S[mt] * cd;
#pragma unroll
                for (int ks = 0; ks < 4; ++ks) S[mt] = MFMA32(lds8(op + 32768 + (mt * 4 + ks) * 1024), Vb[ks], S[mt]);
                SB0; }
            LAS bf16_t* ob = (LAS bf16_t*)(lds + L_OB + (c & 1) * OBB);
#pragma unroll
            for (int r = 0; r < 16; ++r) { ob[crow(r, hi) * 136 + wid * 32 + c32] = f2bf(o0[r]); ob[(32 + crow(r, hi)) * 136 + wid * 32 + c32] = f2bf(o1[r]); }
        }
        wait_vm0(); __syncthreads();
    }
}

DI void vt_phase(const Params& P, ldsp_t lds) {
    const int tid = threadIdx.x; const bf16_t* H = (const bf16_t*)(P.ws + OFF_H); bf16_t* VTg = (bf16_t*)(P.ws + OFF_R);
    LAS bf16_t* T = (LAS bf16_t*)lds;
    for (int item = blockIdx.x; item < 2048; item += gridDim.x) {
        const int bh = item >> 5, tb = item & 31, b = bh >> 4, h = bh & 15;
#pragma unroll
        for (int ps = 0; ps < 8; ++ps) { const int tok = ps * 16 + (tid >> 5), dg = (tid & 31) * 8;
            const bf16x8 v = *(const bf16x8*)(H + (size_t)(b * SEQ + tb * 128 + tok) * 16384 + 8192 + h * 256 + dg);
            const int o = tok & 15, pos = (tok & ~15) | (o & 3) | ((o & 4) << 1) | ((o & 8) >> 1);
#pragma unroll
            for (int e = 0; e < 8; ++e) T[(dg + e) * 136 + pos] = (bf16_t)v[e]; }
        __syncthreads();
#pragma unroll
        for (int ps = 0; ps < 8; ++ps) { const int dv = ps * 32 + (tid >> 4), tc = (tid & 15) * 8;
            *(bf16x8*)(VTg + ((size_t)bh * 256 + dv) * SEQ + tb * 128 + tc) = *(const LAS bf16x8*)(T + dv * 136 + tc); }
        __syncthreads();
    }
}

constexpr int AT_KBUF = 34816  , AT_VOFF = 69632, AT_VBUF = 34816  , AT_BT = 139264, AT_OF_STRIDE = 257;
DI void attn_block(const Params& P, ldsp_t lds, int bh, int qb, float lam) {
    int tid_o = threadIdx.x; asm volatile("" : "+v"(tid_o));
    const int tid = tid_o, wid = __builtin_amdgcn_readfirstlane(tid >> 6), lane = tid & 63, c32 = lane & 31, hi = lane >> 5;
    const int b = bh >> 4, h = bh & 15, q0 = qb * 128, nt = 2 * qb + 2, p = wid >> 2, wsub = wid & 3;
    const bf16_t* H = (const bf16_t*)(P.ws + OFF_H); const bf16_t* VTg = (const bf16_t*)(P.ws + OFF_R); bf16_t* O1 = (bf16_t*)(P.ws + OFF_ACT);
    const float* BTg = (const float*)(P.ws + OFF_BT);
    LAS float* BTs = (LAS float*)(lds + AT_BT);
    if (tid < 256) BTs[tid] = BTg[h * 256 + tid];
    const int qmin = q0 + 32 * wsub, qrow = qmin + c32, qmax = qmin + 31;
    bf16x8 Qf[4];
    const bf16_t* qp = H + (size_t)(b * SEQ + qrow) * 16384 + h * 256 + p * 128 + 8 * hi;
#pragma unroll
    for (int ks = 0; ks < 4; ++ks) Qf[ks] = *(const bf16x8*)(qp + 16 * ks);
    const char* kbase = (const char*)(H + (size_t)(b * SEQ) * 16384 + 4096 + h * 256);
    const char* vbase = (const char*)(VTg + (size_t)bh * 256 * SEQ);
    const unsigned kvo = (unsigned)lane * 4u, vvo = (unsigned)(lane >> 5) * (SEQ * 2) + (unsigned)(lane & 31) * 4u;
    auto load_tile = [&](int kt, int buf) {
        const int k0 = kt * 64;
#pragma unroll 1
        for (int i = 0; i < 16; ++i) { const int r = wid * 16 + i, pp = r >> 6, key = r & 63;
            dma4(kbase + ((size_t)(k0 + key) * 32768 + pp * 256) + kvo, lds + buf * AT_KBUF + pp * 17408 + key * 272); }
#pragma unroll 1
        for (int i = 0; i < 16; ++i) { const int pr = wid * 16 + i;
            dma4(vbase + ((size_t)pr * (2 * SEQ * 2) + k0 * 2) + vvo, lds + AT_VOFF + buf * AT_VBUF + pr * 272); }
    };
    f32x16 O[8];
#pragma unroll
    for (int dt = 0; dt < 8; ++dt) for (int r = 0; r < 16; ++r) O[dt][r] = 0.f;
    float mrun = -1e30f, lrun = 0.f;
    constexpr float CS = 0.08838834764831845f * LOG2E;
    load_tile(0, 0);
    wait_vm0(); __syncthreads();
#pragma unroll 1
    for (int kt = 0; kt < nt; ++kt) {
        const int buf = kt & 1, k0 = kt * 64;
        if (kt + 1 < nt) load_tile(kt + 1, buf ^ 1);
        if (k0 <= qmax) {
            ldsp_t kb = lds + buf * AT_KBUF + p * 17408 + c32 * 272 + 16 * hi;
            ldsp_t vb = lds + AT_VOFF + buf * AT_VBUF + (c32 >> 1) * 272 + (c32 & 1) * 128 + 16 * hi;
#pragma unroll
            for (int half = 0; half < 2; ++half) {
                const int kh0 = k0 + 32 * half;
                if (kh0 <= qmax) {
                    f32x16 Sx; for (int r = 0; r < 16; ++r) Sx[r] = 0.f;
                    bf16x8 Qh[4];
#pragma unroll
                    for (int ks = 0; ks < 4; ++ks) Qh[ks] = *(const bf16x8*)(qp + 64 + 16 * ks);
                    SB0;
#pragma unroll
                    for (int g = 0; g < 4; ++g) {
#pragma unroll
                        for (int k4 = 0; k4 < 2; ++k4) { const int ks = 2 * g + k4;
                            Sx = MFMA32(lds8(kb + 32 * half * 272 + 32 * ks), ks < 4 ? Qf[ks & 3] : Qh[ks & 3], Sx); }
                        SB0; }
                    const bool nearb = (qmin - (kh0 + 31)) < 128;
                    if (!nearb) { const float cb = BTs[255];
#pragma unroll
                        for (int r = 0; r < 16; ++r) Sx[r] = Sx[r] * CS + cb;
                    } else {
#pragma unroll
                        for (int r = 0; r < 16; ++r) { const int rel = qrow - (kh0 + crow(r, hi));
                            const float bb = BTs[min(max(rel, 0), 255)];
                            Sx[r] = rel >= 0 ? Sx[r] * CS + bb : -__builtin_inff();
                            if ((r & 3) == 3) SB0; }
                    }
                    float tmax = Sx[0];
#pragma unroll
                    for (int r = 1; r < 16; ++r) tmax = fmaxf(tmax, Sx[r]);
                    tmax = fmaxf(tmax, __shfl_xor(tmax, 32));
                    if (__any(tmax > mrun + 8.f)) {
                        const float mn = fmaxf(mrun, tmax), alpha = __builtin_amdgcn_exp2f(mrun - mn); mrun = mn; lrun *= alpha;
#pragma unroll
                        for (int dt = 0; dt < 8; ++dt) O[dt] = O[dt] * alpha;
                    }
                    float ls = 0.f;
#pragma unroll
                    for (int r = 0; r < 16; ++r) { Sx[r] = __builtin_amdgcn_exp2f(Sx[r] - mrun); ls += Sx[r]; }
                    lrun += ls;
                    bf16x8 Pf[2]; Pf[0] = pack8v(Sx, 0); Pf[1] = pack8v(Sx, 1);
                    SB0;
#pragma unroll
                    for (int d2 = 0; d2 < 4; ++d2) {
#pragma unroll
                        for (int dd = 0; dd < 2; ++dd) { const int dt = 2 * d2 + dd;
#pragma unroll
                            for (int hb = 0; hb < 2; ++hb)
                                O[dt] = MFMA32(lds8(vb + 16 * dt * 272 + 32 * (2 * half + hb)), Pf[hb], O[dt]); }
                        SB0; }
                }
            }
        }
        wait_vm0(); __syncthreads();
    }
    int tid_e = threadIdx.x; asm volatile("" : "+v"(tid_e));
    const int lane_e = tid_e & 63, c32e = lane_e & 31, hie = lane_e >> 5;
    LAS float* Of = (LAS float*)lds;
    const float ltot = lrun + __shfl_xor(lrun, 32), inv = 1.f / ltot;
    const int ql = 32 * wsub + c32e;
    if (p == 1) { const float sc = -lam * inv;
#pragma unroll
        for (int dt = 0; dt < 8; ++dt)
#pragma unroll
            for (int r = 0; r < 16; ++r) Of[ql * AT_OF_STRIDE + 32 * dt + crow(r, hie)] = O[dt][r] * sc; }
    __syncthreads();
    if (p == 0) { float ssq = 0.f;
#pragma unroll
        for (int dt = 0; dt < 8; ++dt)
            {
#pragma unroll
                for (int r = 0; r < 16; ++r) { const float o = O[dt][r] * inv + Of[ql * AT_OF_STRIDE + 32 * dt + crow(r, hie)]; O[dt][r] = o; ssq = __builtin_fmaf(o, o, ssq); }
                SB0; }
        ssq += __shfl_xor(ssq, 32);
        const float rstd = rsqrtf(ssq * (1.f / 256.f) + 1e-5f) * (1.f - LAM_INIT);
#pragma unroll
        for (int dt = 0; dt < 8; ++dt)
#pragma unroll
            for (int r = 0; r < 16; ++r) Of[ql * AT_OF_STRIDE + 32 * dt + crow(r, hie)] = O[dt][r] * rstd; }
    __syncthreads();
#pragma unroll 1
    for (int i = 0; i < 8; ++i) { const int id = tid_e + 512 * i, q = id >> 5, dg = (id & 31) * 8; const size_t trow = (size_t)(b * SEQ + q0 + q);
        const bf16x8 zv = *(const bf16x8*)(H + trow * 16384 + 12288 + h * 256 + dg);
        const f32x4 w0 = *(const f32x4*)(P.subln_w + dg), w1 = *(const f32x4*)(P.subln_w + dg + 4);
        float r[8];
#pragma unroll
        for (int e = 0; e < 8; ++e) r[e] = Of[q * AT_OF_STRIDE + dg + e] * (e < 4 ? w0[e & 3] : w1[e & 3]) * siluf(bf2f((unsigned short)zv[e]));
        *(bf16x8*)(O1 + trow * 4096 + h * 256 + dg) = pack8(r[0], r[1], r[2], r[3], r[4], r[5], r[6], r[7]); }
    __syncthreads();
}
DI void attn_phase(const Params& P, ldsp_t lds) {
    const int lane = threadIdx.x & 63;
    float s1 = P.lq1[lane] * P.lk1[lane] + P.lq1[lane + 64] * P.lk1[lane + 64], s2 = P.lq2[lane] * P.lk2[lane] + P.lq2[lane + 64] * P.lk2[lane + 64];
    s1 = wsum(s1); s2 = wsum(s2);
    const float lam = __int_as_float(__builtin_amdgcn_readfirstlane(__float_as_int(expf(s1) - expf(s2) + LAM_INIT)));
    for (int idx = blockIdx.x; idx < 1024; idx += gridDim.x) { const int bh = idx >> 4, j = idx & 15;
#pragma unroll 1
        for (int sub = 0; sub < 2; ++sub) attn_block(P, lds, bh, sub ? 31 - j : j, lam); }
}

typedef const __attribute__((address_space(4))) Params* kparams_t;
DI Params kparams() { kparams_t p = (kparams_t)__builtin_amdgcn_kernarg_segment_ptr(); asm volatile("" : "+s"(p)); const Params* g = (const Params*)p; return *g; }
__global__ void __launch_bounds__(512) fwd_megakernel(Params P) {
    extern __shared__ __attribute__((aligned(16))) unsigned char shm[];
    ldsp_t lds = (ldsp_t)shm;
    cg::grid_group grid = cg::this_grid();
    const int ph_lo = P.ph_lo, ph_hi = P.ph_hi;
#ifndef PH_MASK
#define PH_MASK 0x7ff
#endif
#define PH_ON(n) (((PH_MASK) >> (n)) & 1)
    if (PH_ON(0) && ph_lo <= 0 && 0 < ph_hi) { if (0 > ph_lo) grid.sync();
        const Params Pl = kparams(); unsigned char* ws = Pl.ws;
        {
            cvt_rows(Pl.x, (bf16_t*)(ws + OFF_ACT), (size_t)NTOK * DM / 8);
            transpose_w(Pl.a_w_in, 16448, 16640, (bf16_t*)(ws + OFF_WIN), lds);
            transpose_w(Pl.a_w_out, 4096, 4096, (bf16_t*)(ws + OFF_WOUT), lds);
            bias_table(Pl.rel_bias, (float*)(ws + OFF_BT));
        }
    }
    if (PH_ON(1) && ph_lo <= 1 && 1 < ph_hi) { if (1 > ph_lo) grid.sync();
        const Params Pl = kparams(); unsigned char* ws = Pl.ws;
        { pg8::Gemm g{(const bf16_t*)(ws + OFF_ACT), (const bf16_t*)(ws + OFF_WIN), NTOK, 16640, 4096};
            pg8::StaticOrder S; S.init(g.M, g.N, (int)gridDim.x, (int)blockIdx.x); EpiH E{(bf16_t*)(ws + OFF_H), (float*)(ws + OFF_AB)};
            pg8::gemm_phase<EpiH, pg8::StaticOrder, false>(lds, g, S, E, nullptr); }
    }
    if (PH_ON(2) && ph_lo <= 2 && 2 < ph_hi) { if (2 > ph_lo) grid.sync();
        const Params Pl = kparams(); unsigned char* ws = Pl.ws;
        p2a_phase(Pl, lds);
    }
    if (PH_ON(3) && ph_lo <= 3 && 3 < ph_hi) { if (3 > ph_lo) grid.sync();
        const Params Pl = kparams(); unsigned char* ws = Pl.ws;
        scan_phase(Pl, lds);
    }
    if (PH_ON(4) && ph_lo <= 4 && 4 < ph_hi) { if (4 > ph_lo) grid.sync();
        const Params Pl = kparams(); unsigned char* ws = Pl.ws;
        { pg8::Gemm g{(const bf16_t*)(ws + OFF_R), (const bf16_t*)(ws + OFF_WOUT), NTOK, 4096, 4096};
            pg8::StaticOrder S; S.init(g.M, g.N, (int)gridDim.x, (int)blockIdx.x); EpiRes E{Pl.x, Pl.out};
            pg8::gemm_phase<EpiRes, pg8::StaticOrder, false>(lds, g, S, E, nullptr); }
    }
    if (PH_ON(5) && ph_lo <= 5 && 5 < ph_hi) { if (5 > ph_lo) grid.sync();
        const Params Pl = kparams(); unsigned char* ws = Pl.ws;
        {
            ln_phase(Pl.out, Pl.ln_g, Pl.ln_b, (bf16_t*)(ws + OFF_ACT));
            transpose_w(Pl.b_w_in, 16384, 16384, (bf16_t*)(ws + OFF_WIN), lds);
            transpose_w(Pl.b_w_out, 4096, 4096, (bf16_t*)(ws + OFF_WOUT), lds);
        }
    }
    if (PH_ON(6) && ph_lo <= 6 && 6 < ph_hi) { if (6 > ph_lo) grid.sync();
        const Params Pl = kparams(); unsigned char* ws = Pl.ws;
        { pg8::Gemm g{(const bf16_t*)(ws + OFF_ACT), (const bf16_t*)(ws + OFF_WIN), NTOK, 16384, 4096};
            pg8::StaticOrder S; S.init(g.M, g.N, (int)gridDim.x, (int)blockIdx.x); EpiH E{(bf16_t*)(ws + OFF_H), (float*)(ws + OFF_AB)};
            pg8::gemm_phase<EpiH, pg8::StaticOrder, false>(lds, g, S, E, nullptr); }
    }
    if (PH_ON(7) && ph_lo <= 7 && 7 < ph_hi) { if (7 > ph_lo) grid.sync();
        const Params Pl = kparams(); unsigned char* ws = Pl.ws;
        vt_phase(Pl, lds);
    }
    if (PH_ON(8) && ph_lo <= 8 && 8 < ph_hi) { if (8 > ph_lo) grid.sync();
        const Params Pl = kparams(); unsigned char* ws = Pl.ws;
        attn_phase(Pl, lds);
    }
    if (PH_ON(9) && ph_lo <= 9 && 9 < ph_hi) { if (9 > ph_lo) grid.sync();
        const Params Pl = kparams(); unsigned char* ws = Pl.ws;
        { pg8::Gemm g{(const bf16_t*)(ws + OFF_ACT), (const bf16_t*)(ws + OFF_WOUT), NTOK, 4096, 4096};
            pg8::StaticOrder S; S.init(g.M, g.N, (int)gridDim.x, (int)blockIdx.x); EpiRes E{Pl.out, Pl.out};
            pg8::gemm_phase<EpiRes, pg8::StaticOrder, false>(lds, g, S, E, nullptr); }
    }
    if (PH_ON(10) && ph_lo <= 10 && 10 < ph_hi) { if (10 > ph_lo) grid.sync();
        const Params Pl = kparams(); unsigned char* ws = Pl.ws;
        ln_phase(Pl.out, Pl.ln_g + DM, Pl.ln_b + DM, nullptr);
    }
}

#ifndef N_LAUNCH_MODE
#define N_LAUNCH_MODE 0
#endif
extern "C" void kernel_launch(void* const* d_in, const int* in_sizes, int n_in, void* d_out, int out_size, void* d_ws, size_t ws_size, hipStream_t stream) {
    static int grid_blocks = 0;
    if (!grid_blocks) {
        int dev = 0, cus = 0, per_cu = 0;
        hipGetDevice(&dev);
        hipDeviceGetAttribute(&cus, hipDeviceAttributeMultiprocessorCount, dev);
        hipFuncSetAttribute((const void*)fwd_megakernel, hipFuncAttributeMaxDynamicSharedMemorySize, LDS_BYTES);
        hipOccupancyMaxActiveBlocksPerMultiprocessor(&per_cu, fwd_megakernel, 512, LDS_BYTES);
        if (per_cu < 1) per_cu = 1;
        grid_blocks = cus * per_cu; if (grid_blocks > 256) grid_blocks = 256;
    }
    if (ws_size < WS_NEED) { fprintf(stderr, "workspace too small: %zu < %zu\n", ws_size, (size_t)WS_NEED); return; }
    Params p{};
    p.x = (const float*)d_in[0]; p.ln_g = (const float*)d_in[1]; p.ln_b = (const float*)d_in[2]; p.rel_bias = (const float*)d_in[3];
    p.a_w_in = (const float*)d_in[4]; p.a_conv_w = (const float*)d_in[5]; p.a_a_log = (const float*)d_in[6]; p.a_dt_bias = (const float*)d_in[7];
    p.a_norm_w = (const float*)d_in[8]; p.a_w_out = (const float*)d_in[9]; p.b_w_in = (const float*)d_in[10];
    p.lq1 = (const float*)d_in[11]; p.lk1 = (const float*)d_in[12]; p.lq2 = (const float*)d_in[13]; p.lk2 = (const float*)d_in[14];
    p.subln_w = (const float*)d_in[15]; p.b_w_out = (const float*)d_in[16];
    p.out = (float*)d_out; p.ws = (unsigned char*)d_ws;
#if N_LAUNCH_MODE == 0
    p.ph_lo = 0; p.ph_hi = 11;
    void* args[] = {&p};
    hipError_t e = hipLaunchCooperativeKernel((const void*)fwd_megakernel, dim3(grid_blocks), dim3(512), args, LDS_BYTES, stream);
    if (e != hipSuccess) fprintf(stderr, "cooperative launch failed: %s (grid %d)\n", hipGetErrorString(e), grid_blocks);
#else
    for (int ph = 0; ph < 11; ++ph) { p.ph_lo = ph; p.ph_hi = ph + 1;
        hipLaunchKernelGGL(fwd_megakernel, dim3(grid_blocks), dim3(512), LDS_BYTES, stream, p); }
#endif
}
```

```cpp
#include <hip/hip_runtime.h>
#include <hip/hip_cooperative_groups.h>
#include <cstdio>
#include <cstdint>
namespace cg = cooperative_groups;
namespace pg8 {
#define PG8_LAS __attribute__((address_space(3)))
typedef unsigned short bf16_t;
typedef short bf16x8 __attribute__((ext_vector_type(8)));
typedef float f32x4 __attribute__((ext_vector_type(4)));
typedef unsigned u32x4 __attribute__((ext_vector_type(4)));
constexpr int BM = 256, BK = 64, HALF = 128, HTB = HALF * BK * 2  , STAGE_BYTES = 8 * HTB, NXCD = 8, WGM = 8;

__host__ __device__ __forceinline__ int lds_byte(int r, int c) { const int st = (r >> 4) * 2 + (c >> 5), rr = r & 15, cc = c & 31, ob = rr * 64 + cc * 2; return st * 1024 + (ob ^ (((ob >> 9) & 1) << 5)); }
__host__ __device__ __forceinline__ void stage_rc(int b, int& R, int& C) { const int st = b / 1024, sb = b % 1024, swz = sb ^ (((sb >> 9) & 1) << 5); R = (st >> 1) * 16 + swz / 64; C = (st & 1) * 32 + (swz % 64) / 2; }
__host__ __device__ __forceinline__ int perm32(int rho) { const int n = rho >> 4, i = rho & 15; return 8 * (i >> 2) + 4 * n + (i & 3); }

struct Unit { int pm, pn; };
struct Gemm { const bf16_t* A; const bf16_t* Bt; int M, N, K; };

struct StaticOrder {
    int nM, nN, nwg, G, c;
    __host__ __device__ void init(int M, int N, int G_, int c_) { nM = M / BM; nN = N / BM; nwg = nM * nN; G = G_; c = c_; }
    __host__ __device__ bool next(int i, Unit& u) const {
        const long L = (long)i * G + c; if (L >= nwg) return false;
        int wgid = (int)L; { const int q = nwg / NXCD, r = nwg % NXCD, xcd = wgid % NXCD, off = wgid / NXCD; wgid = (xcd < r ? xcd * (q + 1) : r * (q + 1) + (xcd - r) * q) + off; }
        const int nig = WGM * nN, gid = wgid / nig, fm = gid * WGM, gsz = (nM - fm) < WGM ? (nM - fm) : WGM;
        u.pm = fm + ((wgid % nig) % gsz); u.pn = (wgid % nig) / gsz; return true;
    }
    __device__ __forceinline__ void a_ready(const Unit&) const {}
    __device__ __forceinline__ void done(const Unit&) const {}
};

template <class Epi, class Sched, bool STAMP = false>
__device__ __forceinline__ void gemm_phase(PG8_LAS unsigned char* lds, const Gemm g, const Sched& S, const Epi& E, unsigned long long* stamps) {
    const int tid = threadIdx.x, wid = __builtin_amdgcn_readfirstlane(tid >> 6), lane = tid & 63, wr = wid >> 2, wc = wid & 3, fr = lane & 15, fq = lane >> 4;
    const int K = g.K, nt = K / BK;
    int ts_lo = 0, ts_hi = 0, nts = 0; const unsigned long long rt_entry = STAMP ? (unsigned long long)wall_clock64() : 0ull;
#define PG8_STAMP() do { if (STAMP && wid == 0 && nts < 64) { const unsigned long long _c = (unsigned long long)clock64(); \
        ts_lo = (lane == nts) ? (int)(unsigned)_c : ts_lo; ts_hi = (lane == nts) ? (int)(unsigned)(_c >> 32) : ts_hi; ++nts; } } while (0)
    PG8_STAMP();
    unsigned voffA[2], voffB[2];
#pragma unroll
    for (int i = 0; i < 2; ++i) { int R, C; stage_rc(tid * 16 + i * 8192, R, C); const int Rb = Epi::PERM ? ((R & ~31) + perm32(R & 31)) : R;
        voffA[i] = (unsigned)(R * K + C) * 2u; voffB[i] = (unsigned)(Rb * K + C) * 2u; }
    const size_t kstep = (size_t)(BK * 2);
    const size_t hstep = (size_t)HALF * K * 2;
    const size_t tstep = 2 * hstep;
    const unsigned ldsw = (unsigned)wid * 1024u;
    const int aoff = lds_byte(wr * 64 + fr, fq * 8), boff = lds_byte(wc * 32 + fr, fq * 8);
#define PG8_SA(b, h) (((b) * 2 + (h)) * HTB)
#define PG8_SB(b, h) ((4 + (b) * 2 + (h)) * HTB)
#define PG8_STAGE(bufoff, gbase, voff) do { _Pragma("unroll") for (int _i = 0; _i < 2; ++_i) \
        __builtin_amdgcn_global_load_lds((const unsigned*)((const char*)(gbase) + (voff)[_i]), (PG8_LAS unsigned*)(lds + (bufoff) + ldsw + _i * 8192), 16, 0, 0); } while (0)
#define PG8_LDA(dst, b, h) do { _Pragma("unroll") for (int m = 0; m < 4; ++m) _Pragma("unroll") for (int k = 0; k < 2; ++k) dst[m][k] = *(const PG8_LAS bf16x8*)(lds + PG8_SA(b, h) + aoff + m * 2048 + k * 1024); } while (0)
#define PG8_LDB(dst, b, h) do { _Pragma("unroll") for (int n = 0; n < 2; ++n) _Pragma("unroll") for (int k = 0; k < 2; ++k) dst[n][k] = *(const PG8_LAS bf16x8*)(lds + PG8_SB(b, h) + boff + n * 2048 + k * 1024); } while (0)
#define PG8_MMA(ai, bj, At, Bt) do { __builtin_amdgcn_s_setprio(1); _Pragma("unroll") for (int m = 0; m < 4; ++m) _Pragma("unroll") for (int n = 0; n < 2; ++n) _Pragma("unroll") for (int k = 0; k < 2; ++k) \
        acc[ai][bj][m][n] = __builtin_amdgcn_mfma_f32_16x16x32_bf16(Bt[n][k], At[m][k], acc[ai][bj][m][n], 0, 0, 0); __builtin_amdgcn_s_setprio(0); } while (0)
#define PG8_WAIT_V(n) asm volatile("s_waitcnt vmcnt(" #n ")" ::: "memory")
#define PG8_WAIT_L(n) asm volatile("s_waitcnt lgkmcnt(" #n ")" ::: "memory")
#define PG8_BAR __builtin_amdgcn_s_barrier()
#define PG8_SCHED __builtin_amdgcn_sched_barrier(0)
    Unit cur, nxt; int ui = 0;
    if (!S.next(0, cur)) return;
    f32x4 acc[2][2][4][2];
#pragma unroll
    for (int a = 0; a < 2; ++a)
#pragma unroll
        for (int b = 0; b < 2; ++b)
#pragma unroll
            for (int m = 0; m < 4; ++m)
#pragma unroll
                for (int n = 0; n < 2; ++n) acc[a][b][m][n] = (f32x4){0.f, 0.f, 0.f, 0.f};
    bf16x8 At[4][2], B0[2][2], B1[2][2];
    const char* cA = (const char*)g.A + (size_t)cur.pm * tstep; const char* cB = (const char*)g.Bt + (size_t)cur.pn * tstep;
    S.a_ready(cur);
    PG8_STAGE(PG8_SB(0, 0), cB, voffB); PG8_STAGE(PG8_SA(0, 0), cA, voffA); PG8_STAGE(PG8_SB(0, 1), cB + hstep, voffB); PG8_STAGE(PG8_SA(0, 1), cA + hstep, voffA);
    if (wr == 1) PG8_BAR;
    PG8_WAIT_V(4); PG8_BAR;
    PG8_STAGE(PG8_SB(1, 0), cB + kstep, voffB); PG8_STAGE(PG8_SA(1, 0), cA + kstep, voffA); PG8_STAGE(PG8_SB(1, 1), cB + hstep + kstep, voffB);
    PG8_WAIT_V(6); PG8_BAR;
    PG8_STAMP();
    for (;;) {
        const bool has_next = S.next(ui + 1, nxt);
        const char* nA = has_next ? (const char*)g.A + (size_t)nxt.pm * tstep : cA; const char* nB = has_next ? (const char*)g.Bt + (size_t)nxt.pn * tstep : cB;
        for (int t = 0; t < nt; t += 2) {
            const bool last = (t == nt - 2);
            const char* a1 = cA + (size_t)(t + 1) * kstep;
            const char* a2 = last ? nA : cA + (size_t)(t + 2) * kstep; const char* b2 = last ? nB : cB + (size_t)(t + 2) * kstep;
            const char* a3 = a2 + kstep; const char* b3 = b2 + kstep;
            if (last && has_next) S.a_ready(nxt);
            PG8_LDB(B0, 0, 0); PG8_SCHED; PG8_LDA(At, 0, 0); PG8_STAGE(PG8_SA(1, 1), a1 + hstep, voffA);
            PG8_WAIT_L(8); PG8_BAR; PG8_WAIT_L(0); PG8_MMA(0, 0, At, B0); PG8_BAR; PG8_SCHED;
            PG8_LDB(B1, 0, 1); PG8_STAGE(PG8_SB(0, 0), b2, voffB);
            PG8_BAR; PG8_WAIT_L(0); PG8_MMA(0, 1, At, B1); PG8_BAR;
            PG8_LDA(At, 0, 1); PG8_STAGE(PG8_SA(0, 0), a2, voffA);
            PG8_BAR; PG8_WAIT_L(0); PG8_MMA(1, 0, At, B0); PG8_BAR; PG8_SCHED;
            PG8_STAGE(PG8_SB(0, 1), b2 + hstep, voffB);
            PG8_WAIT_V(6); PG8_BAR; PG8_MMA(1, 1, At, B1); PG8_BAR;
            PG8_LDB(B0, 1, 0); PG8_SCHED; PG8_LDA(At, 1, 0); PG8_STAGE(PG8_SA(0, 1), a2 + hstep, voffA);
            PG8_WAIT_L(8); PG8_BAR; PG8_WAIT_L(0); PG8_MMA(0, 0, At, B0); PG8_BAR; PG8_SCHED;
            PG8_LDB(B1, 1, 1); PG8_STAGE(PG8_SB(1, 0), b3, voffB);
            PG8_BAR; PG8_WAIT_L(0); PG8_MMA(0, 1, At, B1); PG8_BAR;
            PG8_LDA(At, 1, 1); PG8_STAGE(PG8_SA(1, 0), a3, voffA);
            PG8_BAR; PG8_WAIT_L(0); PG8_MMA(1, 0, At, B0); PG8_BAR; PG8_SCHED;
            PG8_STAGE(PG8_SB(1, 1), b3 + hstep, voffB);
            PG8_WAIT_V(6); PG8_BAR; PG8_MMA(1, 1, At, B1); PG8_BAR;
        }
        PG8_STAMP();
        if constexpr (!Epi::AFTER_DRAIN) { E(acc, cur, wr, wc, fr, fq); S.done(cur); }
        PG8_STAMP();
        if (!has_next) break;
#pragma unroll
        for (int a = 0; a < 2; ++a)
#pragma unroll
            for (int b = 0; b < 2; ++b)
#pragma unroll
                for (int m = 0; m < 4; ++m)
#pragma unroll
                    for (int n = 0; n < 2; ++n) acc[a][b][m][n] = (f32x4){0.f, 0.f, 0.f, 0.f};
        cur = nxt; cA = nA; cB = nB; ++ui;
    }
    PG8_WAIT_V(0);
    if (wr == 0) PG8_BAR;
    PG8_BAR;
    if constexpr (Epi::AFTER_DRAIN) { E.fused(acc, cur, wr, wc, fr, fq, lds, wid, lane); S.done(cur); }
    PG8_STAMP();
    if (STAMP && wid == 0) { stamps[lane] = lane < nts ? (((unsigned long long)(unsigned)ts_hi << 32) | (unsigned)ts_lo) : 0ull;
        if (lane == 62) stamps[62] = rt_entry; if (lane == 63) stamps[63] = (unsigned long long)wall_clock64(); }
#undef PG8_STAMP
#undef PG8_SA
#undef PG8_SB
#undef PG8_STAGE
#undef PG8_LDA
#undef PG8_LDB
#undef PG8_MMA
#undef PG8_WAIT_V
#undef PG8_WAIT_L
#undef PG8_BAR
#undef PG8_SCHED
}
}

#define DI __device__ __forceinline__
#define LAS __attribute__((address_space(3)))
typedef unsigned short bf16_t;
typedef short bf16x8 __attribute__((ext_vector_type(8)));
typedef float f32x2 __attribute__((ext_vector_type(2)));
typedef float f32x4 __attribute__((ext_vector_type(4)));
typedef float f32x16 __attribute__((ext_vector_type(16)));
typedef unsigned u32x2 __attribute__((ext_vector_type(2)));
typedef unsigned u32x4 __attribute__((ext_vector_type(4)));
typedef __bf16 bf16v2 __attribute__((ext_vector_type(2)));
typedef LAS unsigned char* ldsp_t;

constexpr int NTOK = 16384, DM = 4096, SEQ = 4096;
constexpr float ALPHA = 1.4142135623730951f;
constexpr float LAM_INIT = 0.35550906759096926f;
constexpr float LOG2E = 1.4426950408889634f;

constexpr size_t OFF_ACT = 0;
constexpr size_t OFF_WIN = 134217728ull;
constexpr size_t OFF_WOUT = OFF_WIN + 136314880ull;
constexpr size_t OFF_H = OFF_WOUT + 33554432ull;
constexpr size_t OFF_AB = OFF_H + 536870912ull;
constexpr size_t OFF_R = OFF_AB + 4194304ull;
constexpr size_t OFF_AA = OFF_R + 134217728ull;
constexpr size_t OFF_CD = OFF_AA + 67108864ull;
constexpr size_t OFF_BT = OFF_CD + 32768ull;
constexpr size_t OFF_BAR = OFF_BT + 16384ull;
constexpr size_t WS_NEED = OFF_BAR + 256ull;

constexpr int LDS_BYTES = 160 * 1024;

struct Params {
    const float* x; const float* ln_g; const float* ln_b; const float* rel_bias;
    const float* a_w_in; const float* a_conv_w; const float* a_a_log; const float* a_dt_bias; const float* a_norm_w; const float* a_w_out;
    const float* b_w_in; const float* lq1; const float* lk1; const float* lq2; const float* lk2; const float* subln_w; const float* b_w_out;
    float* out; unsigned char* ws; int ph_lo, ph_hi;
};

DI float bf2f(unsigned short b) { return __uint_as_float(((unsigned)b) << 16); }
DI unsigned pk2(float lo, float hi) { f32x2 v = {lo, hi}; bf16v2 b = __builtin_convertvector(v, bf16v2); return __builtin_bit_cast(unsigned, b); }
DI unsigned short f2bf(float f) { return (unsigned short)(pk2(f, 0.f) & 0xffffu); }
DI bf16x8 pack8(float a0, float a1, float a2, float a3, float a4, float a5, float a6, float a7) {
    u32x4 w = {pk2(a0, a1), pk2(a2, a3), pk2(a4, a5), pk2(a6, a7)}; return __builtin_bit_cast(bf16x8, w);
}
DI bf16x8 pack8v(const f32x16& x, int s) { return pack8(x[8 * s], x[8 * s + 1], x[8 * s + 2], x[8 * s + 3], x[8 * s + 4], x[8 * s + 5], x[8 * s + 6], x[8 * s + 7]); }
DI int crow(int r, int hi) { return (r & 3) + 8 * (r >> 2) + 4 * hi; }
DI float siluf(float x) { return x * __builtin_amdgcn_rcpf(1.f + __builtin_amdgcn_exp2f(x * -1.4426950408889634f)); }
DI float dpp_add(float v, const int ctrl) { return v; }
#define DPP_ADD(v, ctrl) ((v) + __int_as_float(__builtin_amdgcn_update_dpp(0, __float_as_int(v), (ctrl), 0xf, 0xf, true)))
DI float sum16(float v) {
    v = DPP_ADD(v, 0xB1); v = DPP_ADD(v, 0x4E); v = DPP_ADD(v, 0x141); v = DPP_ADD(v, 0x140); return v; }
DI float wsum(float v) { for (int o = 32; o >= 1; o >>= 1) v += __shfl_xor(v, o); return v; }
#define MFMA32(a, b, c) __builtin_amdgcn_mfma_f32_32x32x16_bf16((a), (b), (c), 0, 0, 0)
DI bf16x8 lds8(ldsp_t p) { return *(const LAS bf16x8*)p; }
DI void wait_vm0() { asm volatile("s_waitcnt vmcnt(0)" ::: "memory"); }
DI void dma4(const void* g, ldsp_t l) { __builtin_amdgcn_global_load_lds((const unsigned*)g, (LAS unsigned*)l, 4, 0, 0); }
DI void dma16(const void* g, ldsp_t l) { __builtin_amdgcn_global_load_lds((const unsigned*)g, (LAS unsigned*)l, 16, 0, 0); }

struct EpiH {
    static constexpr bool PERM = true, AFTER_DRAIN = false;
    bf16_t* H; float* AB;
    DI void operator()(const pg8::f32x4 (&acc)[2][2][4][2], const pg8::Unit& u, int wr, int wc, int fr, int fq) const {
        const int row0 = u.pm * 256 + wr * 64 + fr;
        if (u.pn < 64) {
            const int col0 = u.pn * 256 + wc * 32 + 8 * fq;
#pragma unroll
            for (int ai = 0; ai < 2; ++ai)
#pragma unroll
                for (int m = 0; m < 4; ++m) { bf16_t* rowp = H + (size_t)(row0 + ai * 128 + m * 16) * 16384 + col0;
#pragma unroll
                    for (int bj = 0; bj < 2; ++bj) { pg8::f32x4 v0 = acc[ai][bj][m][0], v1 = acc[ai][bj][m][1];
                        if (u.pn >= 48) {
#pragma unroll
                            for (int e = 0; e < 4; ++e) { v0[e] = siluf(v0[e]); v1[e] = siluf(v1[e]); } }
                        u32x4 w = {pk2(v0[0], v0[1]), pk2(v0[2], v0[3]), pk2(v1[0], v1[1]), pk2(v1[2], v1[3])};
                        __builtin_nontemporal_store(w, (u32x4*)(rowp + bj * 128)); } }
        } else if (wc < 2) {
            const int col0 = wc * 32 + 8 * fq;
#pragma unroll
            for (int ai = 0; ai < 2; ++ai)
#pragma unroll
                for (int m = 0; m < 4; ++m) { float* rowp = AB + (size_t)(row0 + ai * 128 + m * 16) * 64 + col0;
                    *(pg8::f32x4*)rowp = acc[ai][0][m][0]; *(pg8::f32x4*)(rowp + 4) = acc[ai][0][m][1]; }
        }
    }
};
struct EpiRes {
    static constexpr bool PERM = false, AFTER_DRAIN = false;
    const float* res; float* out;
    DI void operator()(const pg8::f32x4 (&acc)[2][2][4][2], const pg8::Unit& u, int wr, int wc, int fr, int fq) const {
        const int row0 = u.pm * 256 + wr * 64 + fr, col0 = u.pn * 256 + wc * 32 + 4 * fq;
#pragma unroll
        for (int ai = 0; ai < 2; ++ai)
#pragma unroll
            for (int m = 0; m < 4; ++m) { const size_t ro = (size_t)(row0 + ai * 128 + m * 16) * 4096 + col0;
#pragma unroll
                for (int bj = 0; bj < 2; ++bj)
#pragma unroll
                    for (int n = 0; n < 2; ++n) { const size_t o = ro + bj * 128 + n * 16; const pg8::f32x4 r = *(const pg8::f32x4*)(res + o);
                        *(pg8::f32x4*)(out + o) = r * ALPHA + acc[ai][bj][m][n]; } }
    }
};

DI void cvt_rows(const float* src, bf16_t* dst, size_t n8) {
    for (size_t i = (size_t)blockIdx.x * 512 + threadIdx.x; i < n8; i += (size_t)gridDim.x * 512) {
        const f32x4 a = *(const f32x4*)(src + i * 8), b = *(const f32x4*)(src + i * 8 + 4);
        *(bf16x8*)(dst + i * 8) = pack8(a[0], a[1], a[2], a[3], b[0], b[1], b[2], b[3]);
    }
}
DI void transpose_w(const float* W, int N, int Npad, bf16_t* WT, ldsp_t lds) {
    const int tid = threadIdx.x; const int ntn = Npad / 64, ntiles = 32 * ntn;
    LAS bf16_t* T = (LAS bf16_t*)lds;
    const int kr0 = tid >> 4, n4 = (tid & 15) * 4;
    f32x4 v[4];
    auto load_tile = [&](int tile) { const int tn = tile % ntn, tk = tile / ntn; const int n0 = tn * 64, k0 = tk * 128;
#pragma unroll
        for (int ps = 0; ps < 4; ++ps) { const f32x4 z4 = {0.f, 0.f, 0.f, 0.f};
            v[ps] = (n0 < N) ? *(const f32x4*)(W + (size_t)(k0 + ps * 32 + kr0) * N + n0 + n4) : z4; } };
    int tile = blockIdx.x;
    if (tile < ntiles) load_tile(tile);
    for (; tile < ntiles; tile += gridDim.x) {
        const int tn = tile % ntn, tk = tile / ntn; const int n0 = tn * 64, k0 = tk * 128;
#pragma unroll
        for (int ps = 0; ps < 4; ++ps) { const int kr = ps * 32 + kr0;
#pragma unroll
            for (int j = 0; j < 4; ++j) T[(n4 + j) * 136 + ((((kr >> 3) ^ (tid & 15)) << 3) | (kr & 7))] = f2bf(v[ps][j]); }
        if (tile + (int)gridDim.x < ntiles) load_tile(tile + (int)gridDim.x);
        __syncthreads();
#pragma unroll
        for (int ps = 0; ps < 2; ++ps) { const int n = ps * 32 + (tid >> 4), kc = (tid & 15) * 8;
            *(bf16x8*)(WT + (size_t)(n0 + n) * 4096 + k0 + kc) = *(const LAS bf16x8*)(T + n * 136 + ((((kc >> 3) ^ ((n >> 2) & 15))) << 3)); }
        __syncthreads();
    }
}
DI void bias_table(const float* rel_bias, float* BT) {
    const int i = blockIdx.x * 512 + threadIdx.x;
    if (i < 4096) { const int h = i >> 8, n = i & 255; int bk;
        if (n < 16) bk = n; else { bk = 16 + (int)(log((double)n / 16.0) / log(8.0) * 16.0); if (bk > 31) bk = 31; }
        BT[i] = rel_bias[bk * 16 + h] * LOG2E; }
}

DI void ln_phase(float* io, const float* g, const float* bv, bf16_t* outb) {
    const int lane = threadIdx.x & 63, wid = threadIdx.x >> 6;
    for (int row = blockIdx.x * 8 + wid; row < NTOK; row += gridDim.x * 8) {
        float* p = io + (size_t)row * DM; f32x4 v[16]; float s = 0.f;
#pragma unroll
        for (int i = 0; i < 16; ++i) { v[i] = *(const f32x4*)(p + (i * 64 + lane) * 4); s += v[i][0] + v[i][1] + v[i][2] + v[i][3]; }
        const float mean = wsum(s) * (1.f / DM); float q = 0.f;
#pragma unroll
        for (int i = 0; i < 16; ++i) { v[i] = v[i] - mean; q += v[i][0] * v[i][0] + v[i][1] * v[i][1] + v[i][2] * v[i][2] + v[i][3] * v[i][3]; }
        const float rstd = rsqrtf(wsum(q) * (1.f / DM) + 1e-5f);
#pragma unroll
        for (int i = 0; i < 16; ++i) { const int col = (i * 64 + lane) * 4; const f32x4 gg = *(const f32x4*)(g + col), bb = *(const f32x4*)(bv + col);
            const f32x4 y = v[i] * rstd * gg + bb; *(f32x4*)(p + col) = y;
            if (outb) { u32x2 w = {pk2(y[0], y[1]), pk2(y[2], y[3])}; *(u32x2*)(outb + (size_t)row * DM + col) = w; } }
    }
}

constexpr int L_KH = 0, L_QH = 17408, L_KT = 34816, L_VT = 53248, L_LF = 71680, L_LT = 88064, L_TF = 104448, L_T1 = 120832, L_T2 = 130048, L_GC = 139264, L_BE = 139520, L_CW = 139776;
DI void p2a_phase(const Params& P, ldsp_t lds) {
    const int tid = threadIdx.x, wid = __builtin_amdgcn_readfirstlane(tid >> 6), lane = tid & 63, c32 = lane & 31, hi = lane >> 5;
    const bf16_t* H = (const bf16_t*)(P.ws + OFF_H); const float* AB = (const float*)(P.ws + OFF_AB);
    bf16_t* NW = (bf16_t*)P.out; bf16_t* UU = (bf16_t*)P.out + 67108864ull; bf16_t* QD = (bf16_t*)(P.ws + OFF_WIN); bf16_t* KST = (bf16_t*)(P.ws + OFF_ACT);
    bf16_t* AA = (bf16_t*)(P.ws + OFF_AA); float* CD = (float*)(P.ws + OFF_CD);
    LAS bf16_t* KH = (LAS bf16_t*)(lds + L_KH); LAS bf16_t* QH = (LAS bf16_t*)(lds + L_QH); LAS bf16_t* KT = (LAS bf16_t*)(lds + L_KT); LAS bf16_t* VT = (LAS bf16_t*)(lds + L_VT);
    LAS float* LF = (LAS float*)(lds + L_LF); LAS float* LT = (LAS float*)(lds + L_LT); LAS float* TF = (LAS float*)(lds + L_TF); LAS bf16_t* T1 = (LAS bf16_t*)(lds + L_T1); LAS bf16_t* T2 = (LAS bf16_t*)(lds + L_T2);
    LAS float* GC = (LAS float*)(lds + L_GC); LAS float* BE = (LAS float*)(lds + L_BE);
    LAS f32x4* CW = (LAS f32x4*)(lds + L_CW);
    int hprev = -1;
    for (int item = blockIdx.x; item < 8192; item += gridDim.x) {
        const int h = item & 31, bc = item >> 5, b = bc >> 6, chunk = bc & 63; const size_t ci = (size_t)((b * 32 + h) * 64 + chunk);
        if (h != hprev) {
            if (tid < 384) CW[tid] = *(const f32x4*)(P.a_conv_w + (size_t)((tid >> 7) * 4096 + h * 128 + (tid & 127)) * 4);
            hprev = h; __syncthreads();
        }
        {
            const int grp = tid & 15, rlo = tid >> 4;
            bf16x8 xv[6][4];
#pragma unroll
            for (int i = 0; i < 6; ++i) {
                const int tensor = i >> 1, row = (i & 1) * 32 + rlo, tseq = chunk * 64 + row;
                const bf16_t* src = H + (size_t)(b * SEQ + tseq) * 16384 + tensor * 4096 + h * 128 + grp * 8;
#pragma unroll
                for (int j = 0; j < 4; ++j) { const bf16x8 z8 = {0, 0, 0, 0, 0, 0, 0, 0};
                    xv[i][j] = (tseq - 3 + j >= 0) ? *(const bf16x8*)(src + (long)(j - 3) * 16384) : z8; }
            }
#pragma unroll
            for (int i = 0; i < 6; ++i) {
                const int tensor = i >> 1, row = (i & 1) * 32 + rlo;
                float y[8];
#pragma unroll
                for (int e = 0; e < 8; ++e) { const f32x4 w4 = CW[tensor * 128 + grp * 8 + e];
                    y[e] = bf2f((unsigned short)xv[i][0][e]) * w4[0] + bf2f((unsigned short)xv[i][1][e]) * w4[1] + bf2f((unsigned short)xv[i][2][e]) * w4[2] + bf2f((unsigned short)xv[i][3][e]) * w4[3]; }
#pragma unroll
                for (int e = 0; e < 8; ++e) y[e] = siluf(y[e]);
                if (tensor < 2) {
                    float ss = 0.f;
#pragma unroll
                    for (int e = 0; e < 8; ++e) ss += y[e] * y[e];
                    ss = sum16(ss);
                    float r = rsqrtf(ss + 1e-6f); if (tensor == 0) r *= 0.08838834764831845f;
#pragma unroll
                    for (int e = 0; e < 8; ++e) y[e] *= r;
                }
                const bf16x8 pv = pack8(y[0], y[1], y[2], y[3], y[4], y[5], y[6], y[7]);
                if (tensor == 0) { *(LAS bf16x8*)(QH + row * 136 + grp * 8) = pv; }
                else if (tensor == 1) { *(LAS bf16x8*)(KH + row * 136 + grp * 8) = pv;
#pragma unroll
                    for (int e = 0; e < 8; ++e) KT[(grp * 8 + e) * 72 + ((((row >> 3) ^ (grp & 7)) << 3) | (row & 7))] = (bf16_t)pv[e]; }
                else {
#pragma unroll
                    for (int e = 0; e < 8; ++e) VT[(grp * 8 + e) * 72 + ((((row >> 3) ^ (grp & 7)) << 3) | (row & 7))] = (bf16_t)pv[e]; }
            }
        }
        if (wid == 0) {
            const size_t tr = (size_t)(b * SEQ + chunk * 64 + lane) * 64;
            const float av = AB[tr + h], bvv = AB[tr + 32 + h];
            const float xs = av + P.a_dt_bias[h];
            const float sp = xs > 20.f ? xs : log1pf(__expf(xs));
            float g = -__expf(P.a_a_log[h]) * sp;
#pragma unroll
            for (int o = 1; o < 64; o <<= 1) { const float t = __shfl_up(g, o); if (lane >= o) g += t; }
            GC[lane] = g; BE[lane] = 1.f / (1.f + __expf(-bvv));
            if (lane == 63) CD[ci] = __expf(g);
        }
        __syncthreads();
        {
            int widv = wid; asm volatile("" : "+s"(widv));
            const int prod = widv >> 2, ti = (widv >> 1) & 1, tj = widv & 1;
            LAS bf16_t* Bm = prod ? QH : KH;
            f32x16 acc; for (int r = 0; r < 16; ++r) acc[r] = 0.f;
#pragma unroll
            for (int ks = 0; ks < 8; ++ks) { const bf16x8 a = *(const LAS bf16x8*)(KH + (32 * ti + c32) * 136 + 16 * ks + 8 * hi);
                const bf16x8 bq = *(const LAS bf16x8*)(Bm + (32 * tj + c32) * 136 + 16 * ks + 8 * hi); acc = MFMA32(a, bq, acc); }
            const int col = 32 * tj + c32; const float gcc = GC[col], bec = BE[col];
            if (prod == 0) {
#pragma unroll
                for (int r = 0; r < 16; ++r) { const int i = 32 * ti + crow(r, hi);
                    const float gi = GC[i]; const float v = BE[i] * acc[r] * __expf(gi - gcc); LF[i * 64 + col] = (i > col) ? v : 0.f;
                    const float vt = bec * acc[r] * __expf(gcc - gi); LT[i * 64 + col] = (col > i) ? vt : 0.f; }
            } else {
                float vals[16];
#pragma unroll
                for (int r = 0; r < 16; ++r) { const int s = 32 * ti + crow(r, hi); const float v = acc[r] * __expf(gcc - GC[s]); vals[r] = (col >= s) ? v : 0.f; }
#pragma unroll
                for (int hb = 0; hb < 2; ++hb)
                    *(bf16x8*)(AA + ci * 4096 + (size_t)((tj * 4 + 2 * ti + hb) * 64 + lane) * 8) =
                        pack8(vals[8 * hb], vals[8 * hb + 1], vals[8 * hb + 2], vals[8 * hb + 3], vals[8 * hb + 4], vals[8 * hb + 5], vals[8 * hb + 6], vals[8 * hb + 7]);
            }
        }
        __syncthreads();
        if (wid < 2) {
            int wid3 = wid, c32o = c32; asm volatile("" : "+s"(wid3)); asm volatile("" : "+v"(c32o));
            const int base = 32 * wid3, c = base + c32o;
            const float be = BE[c], beg = be * __expf(GC[c]);
            int zv = 0; asm volatile("" : "+v"(zv));
            LAS float* LFz = LF + zv; LAS float* LTz = LT + zv;
#pragma unroll 1
            for (int rbl = 0; rbl < 2; ++rbl) {
                const int r0 = base + 16 * rbl;
                float acc[16];
#pragma unroll
                for (int ii = 0; ii < 16; ++ii) acc[ii] = (r0 + ii == c) ? 1.f : 0.f;
#pragma unroll 1
                for (int j = base; j < r0; j += 4) {
                    float t[4]; f32x4 l4[4][4];
#pragma unroll
                    for (int u = 0; u < 4; ++u) { t[u] = TF[(j + u) * 64 + c];
#pragma unroll
                        for (int q = 0; q < 4; ++q) l4[u][q] = *(const LAS f32x4*)(LTz + (j + u) * 64 + r0 + 4 * q); }
#pragma unroll
                    for (int u = 0; u < 4; ++u)
#pragma unroll
                        for (int q = 0; q < 4; ++q) { acc[4 * q] -= l4[u][q][0] * t[u]; acc[4 * q + 1] -= l4[u][q][1] * t[u]; acc[4 * q + 2] -= l4[u][q][2] * t[u]; acc[4 * q + 3] -= l4[u][q][3] * t[u]; }
                }
                f32x4 Lb[16][4];
#pragma unroll
                for (int ii = 1; ii < 16; ++ii)
#pragma unroll
                    for (int q = 0; 4 * q < ii; ++q) Lb[ii][q] = *(const LAS f32x4*)(LFz + (r0 + ii) * 64 + r0 + 4 * q);
                float Tb[16];
#pragma unroll
                for (int ii = 0; ii < 16; ++ii) { float a = acc[ii];
#pragma unroll
                    for (int jj = 0; jj < ii; jj += 4) { const f32x4 l4 = Lb[ii][jj >> 2];
                        a -= l4[0] * Tb[jj]; if (jj + 1 < ii) a -= l4[1] * Tb[jj + 1]; if (jj + 2 < ii) a -= l4[2] * Tb[jj + 2]; if (jj + 3 < ii) a -= l4[3] * Tb[jj + 3]; }
                    Tb[ii] = a; }
#pragma unroll
                for (int ii = 0; ii < 16; ++ii) { TF[(r0 + ii) * 64 + c] = Tb[ii]; T1[(r0 + ii) * 72 + c] = f2bf(-Tb[ii] * beg); T2[(r0 + ii) * 72 + c] = f2bf(Tb[ii] * be); }
            }
            if (wid == 0) {
                LAS bf16_t* z1 = T1 + 32 + c32o; LAS bf16_t* z2 = T2 + 32 + c32o;
#pragma unroll 8
                for (int ii = 0; ii < 32; ++ii) { z1[ii * 72] = 0; z2[ii * 72] = 0; }
            }
        } else {
            const float gl = GC[63];
            int tid3 = tid; asm volatile("" : "+v"(tid3));
            for (int idx = tid3 - 128; idx < 2048; idx += 384) {
                if (idx < 1024) { const int f = idx, mi = f >> 9, ks = (f >> 6) & 7, l = f & 63, m = l & 31, g = l >> 5, tok = 32 * mi + m;
                    const u32x2 e0 = *(const LAS u32x2*)(QH + tok * 136 + 16 * ks + 4 * g), e1 = *(const LAS u32x2*)(QH + tok * 136 + 16 * ks + 8 + 4 * g);
                    const float sc = __expf(GC[tok]);
                    *(bf16x8*)(QD + ci * 8192 + (size_t)f * 8) = pack8(__uint_as_float(e0[0] << 16) * sc, __uint_as_float(e0[0] & 0xffff0000u) * sc, __uint_as_float(e0[1] << 16) * sc, __uint_as_float(e0[1] & 0xffff0000u) * sc,
                                                                      __uint_as_float(e1[0] << 16) * sc, __uint_as_float(e1[0] & 0xffff0000u) * sc, __uint_as_float(e1[1] << 16) * sc, __uint_as_float(e1[1] & 0xffff0000u) * sc);
                } else { const int f = idx - 1024, mt = f >> 8, ks = (f >> 6) & 3, l = f & 63, m = l & 31, g = l >> 5, dk = 32 * mt + m;
                    const int s0 = 16 * ks + 4 * g, s1 = s0 + 8;
                    const int sw = (dk >> 3) & 7;
                    const u32x2 e0 = *(const LAS u32x2*)(KT + dk * 72 + ((((s0 >> 3) ^ sw) << 3) | (s0 & 7))), e1 = *(const LAS u32x2*)(KT + dk * 72 + ((((s1 >> 3) ^ sw) << 3) | (s1 & 7)));
                    const f32x4 g0 = *(const LAS f32x4*)(GC + s0), g1 = *(const LAS f32x4*)(GC + s1);
                    *(bf16x8*)(KST + ci * 8192 + (size_t)f * 8) = pack8(__uint_as_float(e0[0] << 16) * __expf(gl - g0[0]), __uint_as_float(e0[0] & 0xffff0000u) * __expf(gl - g0[1]),
                                                                       __uint_as_float(e0[1] << 16) * __expf(gl - g0[2]), __uint_as_float(e0[1] & 0xffff0000u) * __expf(gl - g0[3]),
                                                                       __uint_as_float(e1[0] << 16) * __expf(gl - g1[0]), __uint_as_float(e1[0] & 0xffff0000u) * __expf(gl - g1[1]),
                                                                       __uint_as_float(e1[1] << 16) * __expf(gl - g1[2]), __uint_as_float(e1[1] & 0xffff0000u) * __expf(gl - g1[3]));
                }
            }
        }
        __syncthreads();
        if (wid == 0) {
            f32x16 X, Y; for (int r = 0; r < 16; ++r) { X[r] = 0.f; Y[r] = 0.f; }
#pragma unroll
            for (int kk = 0; kk < 2; ++kk) { float av[8], bv[8];
#pragma unroll
                for (int e = 0; e < 8; ++e) { const int j = 16 * kk + 8 * hi + e; av[e] = LT[j * 64 + 32 + c32]; bv[e] = TF[j * 64 + c32]; }
                X = MFMA32(pack8(av[0], av[1], av[2], av[3], av[4], av[5], av[6], av[7]), pack8(bv[0], bv[1], bv[2], bv[3], bv[4], bv[5], bv[6], bv[7]), X); }
#pragma unroll
            for (int sx = 0; sx < 2; ++sx) {
                const f32x4 b0 = *(const LAS f32x4*)(TF + (32 + c32) * 64 + 32 + 16 * sx + 4 * hi), b1 = *(const LAS f32x4*)(TF + (32 + c32) * 64 + 32 + 16 * sx + 8 + 4 * hi);
                Y = MFMA32(pack8(b0[0], b0[1], b0[2], b0[3], b1[0], b1[1], b1[2], b1[3]), pack8v(X, sx), Y); }
            const float be = BE[c32], beg = be * __expf(GC[c32]);
#pragma unroll
            for (int r = 0; r < 16; ++r) { const int i = 32 + crow(r, hi); T1[i * 72 + c32] = f2bf(Y[r] * beg); T2[i * 72 + c32] = f2bf(-Y[r] * be); }
        }
        __syncthreads();
#pragma unroll 1
        for (int jj = 0; jj < 2; ++jj) {
            const int j = wid * 2 + jj;
            f32x16 acc; for (int r = 0; r < 16; ++r) acc[r] = 0.f;
            if (j < 8) { const int dt = j >> 1, mi = j & 1;
#pragma unroll
                for (int kk = 0; kk < 4; ++kk) { const bf16x8 a = *(const LAS bf16x8*)(KT + (32 * dt + c32) * 72 + (((2 * kk + hi) ^ (((32 * dt + c32) >> 3) & 7)) << 3));
                    const bf16x8 bq = *(const LAS bf16x8*)(T1 + (32 * mi + c32) * 72 + 16 * kk + 8 * hi); acc = MFMA32(a, bq, acc); }
#pragma unroll
                for (int hb = 0; hb < 2; ++hb) *(bf16x8*)(NW + ci * 8192 + (size_t)((mi * 8 + 2 * dt + hb) * 64 + lane) * 8) = pack8v(acc, hb);
            } else { const int j2 = j - 8, mi = j2 >> 2, nt = j2 & 3;
#pragma unroll
                for (int kk = 0; kk < 4; ++kk) { const bf16x8 a = *(const LAS bf16x8*)(T2 + (32 * mi + c32) * 72 + 16 * kk + 8 * hi);
                    const bf16x8 bq = *(const LAS bf16x8*)(VT + (32 * nt + c32) * 72 + (((2 * kk + hi) ^ (((32 * nt + c32) >> 3) & 7)) << 3)); acc = MFMA32(a, bq, acc); }
                bf16_t* up = UU + ci * 8192 + (size_t)((mi * 4 + nt) * 64 + lane) * 16;
                *(bf16x8*)up = pack8v(acc, 0); *(bf16x8*)(up + 8) = pack8v(acc, 1);
            }
        }
        __syncthreads();
    }
}

DI f32x16 unpack16(const bf16x8 a, const bf16x8 b) { f32x16 r;
#pragma unroll
    for (int e = 0; e < 8; ++e) { r[e] = bf2f((unsigned short)a[e]); r[8 + e] = bf2f((unsigned short)b[e]); } return r; }
DI void scan_phase(const Params& P, ldsp_t lds) {
    if (blockIdx.x >= 128) return;
    const int tid = threadIdx.x, wid = __builtin_amdgcn_readfirstlane(tid >> 6), lane = tid & 63, c32 = lane & 31, hi = lane >> 5;
    const int bh = blockIdx.x, b = bh >> 5, h = bh & 31;
    const bf16_t* H = (const bf16_t*)(P.ws + OFF_H);
    const bf16_t* NW = (const bf16_t*)P.out; const bf16_t* UU = (const bf16_t*)P.out + 67108864ull; const bf16_t* QD = (const bf16_t*)(P.ws + OFF_WIN); const bf16_t* KST = (const bf16_t*)(P.ws + OFF_ACT);
    const bf16_t* AA = (const bf16_t*)(P.ws + OFF_AA); const float* CD = (const float*)(P.ws + OFF_CD); bf16_t* O0 = (bf16_t*)(P.ws + OFF_R);
    constexpr int OPB = 57344, L_OB = 2 * OPB, OBB = 17408;
    const bool helper = wid >= 4;
    f32x16 S[4]; bf16x8 un[4];
#pragma unroll
    for (int mt = 0; mt < 4; ++mt) for (int r = 0; r < 16; ++r) S[mt][r] = 0.f;
    auto dma_chunk = [&](int cc, int buf) {
        const size_t ci = (size_t)bh * 64 + cc; const int hw = wid - 4;
#pragma unroll 1
        for (int i = 0; i < 14; ++i) { const int piece = hw * 14 + i;
            const bf16_t* src;
            if (piece < 16) src = NW + ci * 8192 + piece * 512; else if (piece < 32) src = QD + ci * 8192 + (piece - 16) * 512;
            else if (piece < 48) src = KST + ci * 8192 + (piece - 32) * 512; else src = AA + ci * 4096 + (piece - 48) * 512;
            dma16(src + lane * 8, lds + buf * OPB + piece * 1024); }
    };
    auto load_u = [&](int cc) {
        const size_t ci = (size_t)bh * 64 + cc;
#pragma unroll
        for (int mi = 0; mi < 2; ++mi) { const bf16_t* up = UU + ci * 8192 + (size_t)((mi * 4 + wid) * 64 + lane) * 16; un[2 * mi] = *(const bf16x8*)up; un[2 * mi + 1] = *(const bf16x8*)(up + 8); }
    };
    const bool dma_w = (wid == 4 || wid == 5), fin_w = wid >= 6;
    auto dma_chunk2 = [&](int cc, int buf) {
        const size_t ci = (size_t)bh * 64 + cc; ldsp_t dst = lds + buf * OPB;
        const bf16_t* s0 = NW + ci * 8192 + lane * 8; const bf16_t* s1 = QD + ci * 8192 + lane * 8; const bf16_t* s2 = KST + ci * 8192 + lane * 8; const bf16_t* s3 = AA + ci * 4096 + lane * 8;
        if (wid == 4) {
#pragma unroll 4
            for (int i = 0; i < 16; ++i) dma16(s0 + i * 512, dst + i * 1024);
#pragma unroll 4
            for (int i = 0; i < 12; ++i) dma16(s1 + i * 512, dst + 16384 + i * 1024);
        } else {
#pragma unroll 4
            for (int i = 12; i < 16; ++i) dma16(s1 + i * 512, dst + 16384 + i * 1024);
#pragma unroll 4
            for (int i = 0; i < 16; ++i) dma16(s2 + i * 512, dst + 32768 + i * 1024);
#pragma unroll 4
            for (int i = 0; i < 8; ++i) dma16(s3 + i * 512, dst + 49152 + i * 1024);
        }
    };
    const int ft = tid - 384;
    bf16x8 zreg[8];
    auto load_z = [&](int cc) {
#pragma unroll
        for (int ps = 0; ps < 8; ++ps) { const int unit = ps * 128 + ft, tok = unit >> 4, cg8 = (unit & 15) * 8;
            zreg[ps] = *(const bf16x8*)(H + (size_t)(b * SEQ + cc * 64 + tok) * 16384 + 12288 + h * 128 + cg8); }
    };
    float cdn = 0.f;
    if (dma_w) dma_chunk2(0, 0); else if (!fin_w) { load_u(0); cdn = CD[(size_t)bh * 64]; } else load_z(0);
    wait_vm0(); __syncthreads();
    if (dma_w) {
#pragma unroll 1
      for (int c = 0; c <= 64; ++c) {

            if (c + 1 < 64) dma_chunk2(c + 1, (c + 1) & 1);
            wait_vm0();
        asm volatile("s_waitcnt lgkmcnt(0)" ::: "memory"); __builtin_amdgcn_s_barrier(); asm volatile("" ::: "memory");
      }
    } else if (fin_w) {
#pragma unroll 1
      for (int c = 0; c <= 64; ++c) {

            if (c >= 1) {
                const int cp = c - 1; ldsp_t ob = lds + L_OB + (cp & 1) * OBB;
                const int cg8 = (ft & 15) * 8;
                const f32x4 w0 = *(const f32x4*)(P.a_norm_w + cg8), w1 = *(const f32x4*)(P.a_norm_w + cg8 + 4);
#pragma unroll
                for (int ps = 0; ps < 8; ++ps) { const int unit = ps * 128 + ft, tok = unit >> 4;
                  {
                    const bf16x8 ov = *(const LAS bf16x8*)(ob + (tok * 136 + cg8) * 2);
                    float o[8], ss = 0.f;
#pragma unroll
                    for (int e = 0; e < 8; ++e) { o[e] = bf2f((unsigned short)ov[e]); ss += o[e] * o[e]; }
                    ss = sum16(ss);
                    const float rs = rsqrtf(ss * (1.f / 128.f) + 1e-6f);
                    const size_t trow = (size_t)(b * SEQ + cp * 64 + tok);
                    const bf16x8 zv = zreg[ps];
                    float r[8];
#pragma unroll
                    for (int e = 0; e < 8; ++e) r[e] = o[e] * rs * (e < 4 ? w0[e & 3] : w1[e & 3]) * bf2f((unsigned short)zv[e]);
                    *(bf16x8*)(O0 + trow * 4096 + h * 128 + cg8) = pack8(r[0], r[1], r[2], r[3], r[4], r[5], r[6], r[7]);
                  }
                }
            }
            if (c < 64) load_z(c);
        asm volatile("s_waitcnt lgkmcnt(0)" ::: "memory"); __builtin_amdgcn_s_barrier(); asm volatile("" ::: "memory");
      }
    } else {
#pragma unroll 1
      for (int c = 0; c <= 64; ++c) {
        if (c < 64) {

            ldsp_t op = lds + (c & 1) * OPB + lane * 16;
            const float cd = cdn;
            f32x16 v0 = unpack16(un[0], un[1]), v1 = unpack16(un[2], un[3]);
            bf16x8 Sb[8];
#pragma unroll
            for (int mt = 0; mt < 4; ++mt) { Sb[2 * mt] = pack8v(S[mt], 0); Sb[2 * mt + 1] = pack8v(S[mt], 1); }
            f32x16 o0, o1; for (int r = 0; r < 16; ++r) { o0[r] = 0.f; o1[r] = 0.f; }
#define SB0 __builtin_amdgcn_sched_barrier(0)
            SB0;
#pragma unroll
            for (int g = 0; g < 8; ++g) {
#pragma unroll
                for (int k2 = 0; k2 < 1; ++k2) { const int ks = g;
                    v0 = MFMA32(lds8(op + ks * 1024), Sb[ks], v0); v1 = MFMA32(lds8(op + (8 + ks) * 1024), Sb[ks], v1);
                    o0 = MFMA32(lds8(op + 16384 + ks * 1024), Sb[ks], o0); o1 = MFMA32(lds8(op + 16384 + (8 + ks) * 1024), Sb[ks], o1); }
                SB0; }
            bf16x8 Vb[4]; Vb[0] = pack8v(v0, 0); Vb[1] = pack8v(v0, 1); Vb[2] = pack8v(v1, 0); Vb[3] = pack8v(v1, 1);
            SB0;
            if (c + 1 < 64) { load_u(c + 1); cdn = CD[(size_t)bh * 64 + c + 1]; }
#pragma unroll
            for (int mt = 0; mt < 4; ++mt) S[mt] = S[mt] * cd;
#pragma unroll
            for (int g = 0; g < 4; ++g) {
#pragma unroll
                for (int k2 = 0; k2 < 1; ++k2) { const int ks = g;
                    o0 = MFMA32(lds8(op + 49152 + ks * 1024), Vb[ks], o0); o1 = MFMA32(lds8(op + 49152 + (4 + ks) * 1024), Vb[ks], o1);
#pragma unroll
                    for (int mt = 0; mt < 4; ++mt) S[mt] = MFMA32(lds8(op + 32768 + (mt * 4 + ks) * 1024), Vb[ks], S[mt]); }
                SB0; }
            LAS bf16_t* ob = (LAS bf16_t*)(lds + L_OB + (c & 1) * OBB);
#pragma unroll
            for (int r = 0; r < 16; ++r) { ob[crow(r, hi) * 136 + wid * 32 + c32] = f2bf(o0[r]); ob[(32 + crow(r, hi)) * 136 + wid * 32 + c32] = f2bf(o1[r]); }
                }
        asm volatile("s_waitcnt lgkmcnt(0)" ::: "memory"); __builtin_amdgcn_s_barrier(); asm volatile("" ::: "memory");
      }
    }
}

DI void vt_phase(const Params& P, ldsp_t lds) {
    const int tid = threadIdx.x; const bf16_t* H = (const bf16_t*)(P.ws + OFF_H); bf16_t* VTg = (bf16_t*)(P.ws + OFF_R);
    LAS bf16_t* T = (LAS bf16_t*)lds;
    for (int item = blockIdx.x; item < 2048; item += gridDim.x) {
        const int bh = item >> 5, tb = item & 31, b = bh >> 4, h = bh & 15;
#pragma unroll
        for (int ps = 0; ps < 8; ++ps) { const int tok = ps * 16 + (tid >> 5), dg = (tid & 31) * 8;
            const bf16x8 v = *(const bf16x8*)(H + (size_t)(b * SEQ + tb * 128 + tok) * 16384 + 8192 + h * 256 + dg);
            const int o = tok & 15, pos = (tok & ~15) | (o & 3) | ((o & 4) << 1) | ((o & 8) >> 1);
#pragma unroll
            for (int e = 0; e < 8; ++e) T[(dg + e) * 136 + (pos ^ ((tid & 15) << 3))] = (bf16_t)v[e]; }
        __syncthreads();
#pragma unroll
        for (int ps = 0; ps < 8; ++ps) { const int dv = ps * 32 + (tid >> 4), tc = (tid & 15) * 8;
            *(bf16x8*)(VTg + ((size_t)bh * 256 + dv) * SEQ + tb * 128 + tc) = *(const LAS bf16x8*)(T + dv * 136 + (tc ^ (((dv >> 3) & 15) << 3))); }
        __syncthreads();
    }
}

constexpr int AT_KBUF = 32768  , AT_VOFF = 65536, AT_VBUF = 32768  , AT_BT = 131072, AT_OF_STRIDE = 257;
DI void attn_block(const Params& P, ldsp_t lds, int bh, int qb, float lam) {
    int tid_o = threadIdx.x; asm volatile("" : "+v"(tid_o));
    const int tid = tid_o, wid = __builtin_amdgcn_readfirstlane(tid >> 6), lane = tid & 63, c32 = lane & 31, hi = lane >> 5;
    const int b = bh >> 4, h = bh & 15, q0 = qb * 128, nt = 2 * qb + 2, p = wid >> 2, wsub = wid & 3;
    const bf16_t* H = (const bf16_t*)(P.ws + OFF_H); const bf16_t* VTg = (const bf16_t*)(P.ws + OFF_R); bf16_t* O1 = (bf16_t*)(P.ws + OFF_ACT);
    const float* BTg = (const float*)(P.ws + OFF_BT);
    LAS float* BTs = (LAS float*)(lds + AT_BT);
    if (tid < 256) BTs[tid] = BTg[h * 256 + tid];
    const int qmin = q0 + 32 * wsub, qrow = qmin + c32, qmax = qmin + 31;
    bf16x8 Qf[8];
    { const bf16_t* qp = H + (size_t)(b * SEQ + qrow) * 16384 + h * 256 + p * 128 + 8 * hi;
#pragma unroll
      for (int ks = 0; ks < 8; ++ks) Qf[ks] = *(const bf16x8*)(qp + 16 * ks); }
    const char* kbase = (const char*)(H + (size_t)(b * SEQ) * 16384 + 4096 + h * 256);
    const char* vbase = (const char*)(VTg + (size_t)bh * 256 * SEQ);
    const unsigned kvo = (unsigned)(lane >> 4) * 32768u + (unsigned)(((lane & 15) ^ (lane >> 4)) * 16);
    const unsigned vvo = (unsigned)(lane >> 3) * (SEQ * 2) + (unsigned)(((lane & 7) ^ ((lane >> 3) & 7)) * 16);
    auto load_tile = [&](int kt, int buf) {
        const int k0 = kt * 64;
#pragma unroll
        for (int i = 0; i < 4; ++i) { const int blk = wid * 4 + i, pp = blk >> 4, key0 = 4 * (blk & 15);
            const unsigned lo = (unsigned)(lane >> 4) * 32768u + (unsigned)(((lane & 15) ^ (4 * i + (lane >> 4))) * 16);
            dma16(kbase + ((size_t)(k0 + key0) * 32768 + pp * 256) + lo, lds + buf * AT_KBUF + blk * 1024); }
#pragma unroll
        for (int i = 0; i < 4; ++i) { const int blk = wid * 4 + i;
            const unsigned vo = (unsigned)(lane >> 3) * (SEQ * 2) + (unsigned)(((lane & 7) ^ (4 * (i & 1) + (lane >> 4))) * 16);
            dma16(vbase + ((size_t)(8 * blk) * (SEQ * 2) + k0 * 2) + vo, lds + AT_VOFF + buf * AT_VBUF + blk * 1024); }
    };
    f32x16 O[8];
#pragma unroll
    for (int dt = 0; dt < 8; ++dt) for (int r = 0; r < 16; ++r) O[dt][r] = 0.f;
    float mrun = -1e30f, lrun = 0.f;
    constexpr float CS = 0.08838834764831845f * LOG2E;
    load_tile(0, 0);
    wait_vm0(); __syncthreads();
#pragma unroll 1
    for (int kt = 0; kt < nt; ++kt) {
        const int buf = kt & 1, k0 = kt * 64;
        if (kt + 1 < nt) load_tile(kt + 1, buf ^ 1);
        if (k0 <= qmax) {
            ldsp_t kb = lds + buf * AT_KBUF + p * 16384 + c32 * 256;
            ldsp_t vb = lds + AT_VOFF + buf * AT_VBUF + c32 * 128;
            const int swk = c32 & 15, swv = (c32 >> 1) & 7;
#pragma unroll
            for (int half = 0; half < 2; ++half) {
                const int kh0 = k0 + 32 * half;
                if (kh0 <= qmax) {
                    f32x16 Sx; for (int r = 0; r < 16; ++r) Sx[r] = 0.f;
                    SB0;
#pragma unroll
                    for (int g = 0; g < 2; ++g) {
#pragma unroll
                        for (int k4 = 0; k4 < 4; ++k4) { const int ks = 4 * g + k4;
                            Sx = MFMA32(lds8(kb + 32 * half * 256 + (((2 * ks + hi) ^ swk) << 4)), Qf[ks], Sx); }
                        SB0; }
                    const bool nearb = (qmin - (kh0 + 31)) < 128;
                    if (!nearb) { const float cb = BTs[255];
#pragma unroll
                        for (int r = 0; r < 16; ++r) Sx[r] = Sx[r] * CS + cb;
                    } else {
#pragma unroll
                        for (int r = 0; r < 16; ++r) { const int rel = qrow - (kh0 + crow(r, hi));
                            const float bb = BTs[min(max(rel, 0), 255)];
                            Sx[r] = rel >= 0 ? Sx[r] * CS + bb : -__builtin_inff();
                            if ((r & 3) == 3) SB0; }
                    }
                    float tmax = Sx[0];
#pragma unroll
                    for (int r = 1; r < 16; ++r) tmax = fmaxf(tmax, Sx[r]);
                    { auto rr = __builtin_amdgcn_permlane32_swap(__float_as_uint(tmax), __float_as_uint(tmax), false, false);
                      tmax = fmaxf(__uint_as_float(rr[0]), __uint_as_float(rr[1])); }
                    if (__any(tmax > mrun + 8.f)) {
                        const float mn = fmaxf(mrun, tmax), alpha = __builtin_amdgcn_exp2f(mrun - mn); mrun = mn; lrun *= alpha;
#pragma unroll
                        for (int dt = 0; dt < 8; ++dt) O[dt] = O[dt] * alpha;
                    }
                    float ls = 0.f;
#pragma unroll
                    for (int r = 0; r < 16; ++r) { Sx[r] = __builtin_amdgcn_exp2f(Sx[r] - mrun); ls += Sx[r]; }
                    lrun += ls;
                    bf16x8 Pf[2]; Pf[0] = pack8v(Sx, 0); Pf[1] = pack8v(Sx, 1);
                    SB0;
#pragma unroll
                    for (int d2 = 0; d2 < 2; ++d2) {
#pragma unroll
                        for (int dd = 0; dd < 4; ++dd) { const int dt = 4 * d2 + dd;
#pragma unroll
                            for (int hb = 0; hb < 2; ++hb)
                                O[dt] = MFMA32(lds8(vb + 32 * dt * 128 + (((2 * (2 * half + hb) + hi) ^ swv) << 4)), Pf[hb], O[dt]); }
                        SB0; }
                }
            }
        }
        wait_vm0(); __syncthreads();
    }
    int tid_e = threadIdx.x; asm volatile("" : "+v"(tid_e));
    const int lane_e = tid_e & 63, c32e = lane_e & 31, hie = lane_e >> 5;
    LAS float* Of = (LAS float*)lds;
    const float ltot = lrun + __shfl_xor(lrun, 32), inv = 1.f / ltot;
    const int ql = 32 * wsub + c32e;
    if (p == 1) { const float sc = -lam * inv;
#pragma unroll
        for (int dt = 0; dt < 8; ++dt)
#pragma unroll
            for (int r = 0; r < 16; ++r) Of[ql * AT_OF_STRIDE + 32 * dt + crow(r, hie)] = O[dt][r] * sc; }
    __syncthreads();
    if (p == 0) { float ssq = 0.f;
#pragma unroll
        for (int dt = 0; dt < 8; ++dt)
            {
#pragma unroll
                for (int r = 0; r < 16; ++r) { const float o = O[dt][r] * inv + Of[ql * AT_OF_STRIDE + 32 * dt + crow(r, hie)]; O[dt][r] = o; ssq = __builtin_fmaf(o, o, ssq); }
                SB0; }
        ssq += __shfl_xor(ssq, 32);
        const float rstd = rsqrtf(ssq * (1.f / 256.f) + 1e-5f) * (1.f - LAM_INIT);
#pragma unroll
        for (int dt = 0; dt < 8; ++dt)
#pragma unroll
            for (int r = 0; r < 16; ++r) Of[ql * AT_OF_STRIDE + 32 * dt + crow(r, hie)] = O[dt][r] * rstd; }
    __syncthreads();
#pragma unroll 1
    for (int i = 0; i < 8; ++i) { const int id = tid_e + 512 * i, q = id >> 5, dg = (id & 31) * 8; const size_t trow = (size_t)(b * SEQ + q0 + q);
        const bf16x8 zv = *(const bf16x8*)(H + trow * 16384 + 12288 + h * 256 + dg);
        const f32x4 w0 = *(const f32x4*)(P.subln_w + dg), w1 = *(const f32x4*)(P.subln_w + dg + 4);
        float r[8];
#pragma unroll
        for (int e = 0; e < 8; ++e) r[e] = Of[q * AT_OF_STRIDE + dg + e] * (e < 4 ? w0[e & 3] : w1[e & 3]) * bf2f((unsigned short)zv[e]);
        *(bf16x8*)(O1 + trow * 4096 + h * 256 + dg) = pack8(r[0], r[1], r[2], r[3], r[4], r[5], r[6], r[7]); }
    __syncthreads();
}
DI void attn_phase(const Params& P, ldsp_t lds) {
    const int lane = threadIdx.x & 63;
    float s1 = P.lq1[lane] * P.lk1[lane] + P.lq1[lane + 64] * P.lk1[lane + 64], s2 = P.lq2[lane] * P.lk2[lane] + P.lq2[lane + 64] * P.lk2[lane + 64];
    s1 = wsum(s1); s2 = wsum(s2);
    const float lam = __int_as_float(__builtin_amdgcn_readfirstlane(__float_as_int(expf(s1) - expf(s2) + LAM_INIT)));
    for (int idx = blockIdx.x; idx < 1024; idx += gridDim.x) { const int bh = idx >> 4, j = idx & 15;
#pragma unroll 1
        for (int sub = 0; sub < 2; ++sub) attn_block(P, lds, bh, sub ? 31 - j : j, lam); }
}

typedef const __attribute__((address_space(4))) Params* kparams_t;
DI Params kparams() { kparams_t p = (kparams_t)__builtin_amdgcn_kernarg_segment_ptr(); asm volatile("" : "+s"(p)); const Params* g = (const Params*)p; return *g; }
DI void gbar(unsigned* ctr, unsigned target) {
    __syncthreads();
    if (threadIdx.x == 0) {
        __builtin_amdgcn_fence(__ATOMIC_RELEASE, "agent");
        __hip_atomic_fetch_add(ctr, 1u, __ATOMIC_RELAXED, __HIP_MEMORY_SCOPE_AGENT);
        while (__hip_atomic_load(ctr, __ATOMIC_RELAXED, __HIP_MEMORY_SCOPE_AGENT) < target) __builtin_amdgcn_s_sleep(1);
    }
    __syncthreads();
    __builtin_amdgcn_fence(__ATOMIC_ACQUIRE, "agent");
    asm volatile("s_waitcnt vmcnt(0)" ::: "memory");
}
__global__ void __launch_bounds__(512) fwd_megakernel(Params P) {
    extern __shared__ __attribute__((aligned(16))) unsigned char shm[];
    ldsp_t lds = (ldsp_t)shm;
    cg::grid_group grid = cg::this_grid();
    const int ph_lo = P.ph_lo, ph_hi = P.ph_hi;
    unsigned* bar = (unsigned*)(P.ws + OFF_BAR); int nbar = 0;
#ifdef EXTRA_SYNC
    for (int es = 0; es < EXTRA_SYNC; ++es) grid.sync();
#endif
#ifndef PH_MASK
#define PH_MASK 0x7ff
#endif
#define PH_ON(n) (((PH_MASK) >> (n)) & 1)
#ifndef REP_MASK
#define REP_MASK 0
#endif
#define REP_N(n) ((((REP_MASK) >> (n)) & 1) ? 2 : 1)
    if (PH_ON(0) && ph_lo <= 0 && 0 < ph_hi) { if (0 > ph_lo) gbar(bar, (unsigned)(++nbar) * gridDim.x);
        const Params Pl = kparams(); unsigned char* ws = Pl.ws;
        for (int rep = 0; rep < REP_N(0); ++rep)
        {
            cvt_rows(Pl.x, (bf16_t*)(ws + OFF_ACT), (size_t)NTOK * DM / 8);
            transpose_w(Pl.a_w_in, 16448, 16640, (bf16_t*)(ws + OFF_WIN), lds);
            transpose_w(Pl.a_w_out, 4096, 4096, (bf16_t*)(ws + OFF_WOUT), lds);
            bias_table(Pl.rel_bias, (float*)(ws + OFF_BT));
        }
    }
    if (PH_ON(1) && ph_lo <= 1 && 1 < ph_hi) { if (1 > ph_lo) grid.sync();
        const Params Pl = kparams(); unsigned char* ws = Pl.ws;
        for (int rep = 0; rep < REP_N(1); ++rep)
        { pg8::Gemm g{(const bf16_t*)(ws + OFF_ACT), (const bf16_t*)(ws + OFF_WIN), NTOK, 16640, 4096};
            pg8::StaticOrder S; S.init(g.M, g.N, (int)gridDim.x, (int)blockIdx.x); EpiH E{(bf16_t*)(ws + OFF_H), (float*)(ws + OFF_AB)};
            pg8::gemm_phase<EpiH, pg8::StaticOrder, false>(lds, g, S, E, nullptr); }
    }
    if (PH_ON(2) && ph_lo <= 2 && 2 < ph_hi) { if (2 > ph_lo) gbar(bar, (unsigned)(++nbar) * gridDim.x);
        const Params Pl = kparams(); unsigned char* ws = Pl.ws;
        for (int rep = 0; rep < REP_N(2); ++rep)
        p2a_phase(Pl, lds);
    }
    if (PH_ON(3) && ph_lo <= 3 && 3 < ph_hi) { if (3 > ph_lo) gbar(bar, (unsigned)(++nbar) * gridDim.x);
        const Params Pl = kparams(); unsigned char* ws = Pl.ws;
        for (int rep = 0; rep < REP_N(3); ++rep)
        scan_phase(Pl, lds);
    }
    if (PH_ON(4) && ph_lo <= 4 && 4 < ph_hi) { if (4 > ph_lo) gbar(bar, (unsigned)(++nbar) * gridDim.x);
        const Params Pl = kparams(); unsigned char* ws = Pl.ws;
        for (int rep = 0; rep < REP_N(4); ++rep)
        { pg8::Gemm g{(const bf16_t*)(ws + OFF_R), (const bf16_t*)(ws + OFF_WOUT), NTOK, 4096, 4096};
            pg8::StaticOrder S; S.init(g.M, g.N, (int)gridDim.x, (int)blockIdx.x); EpiRes E{Pl.x, Pl.out};
            pg8::gemm_phase<EpiRes, pg8::StaticOrder, false>(lds, g, S, E, nullptr); }
    }
    if (PH_ON(5) && ph_lo <= 5 && 5 < ph_hi) { if (5 > ph_lo) gbar(bar, (unsigned)(++nbar) * gridDim.x);
        const Params Pl = kparams(); unsigned char* ws = Pl.ws;
        for (int rep = 0; rep < REP_N(5); ++rep)
        {
            ln_phase(Pl.out, Pl.ln_g, Pl.ln_b, (bf16_t*)(ws + OFF_ACT));
            transpose_w(Pl.b_w_in, 16384, 16384, (bf16_t*)(ws + OFF_WIN), lds);
            transpose_w(Pl.b_w_out, 4096, 4096, (bf16_t*)(ws + OFF_WOUT), lds);
        }
    }
    if (PH_ON(6) && ph_lo <= 6 && 6 < ph_hi) { if (6 > ph_lo) gbar(bar, (unsigned)(++nbar) * gridDim.x);
        const Params Pl = kparams(); unsigned char* ws = Pl.ws;
        for (int rep = 0; rep < REP_N(6); ++rep)
        { pg8::Gemm g{(const bf16_t*)(ws + OFF_ACT), (const bf16_t*)(ws + OFF_WIN), NTOK, 16384, 4096};
            pg8::StaticOrder S; S.init(g.M, g.N, (int)gridDim.x, (int)blockIdx.x); EpiH E{(bf16_t*)(ws + OFF_H), (float*)(ws + OFF_AB)};
            pg8::gemm_phase<EpiH, pg8::StaticOrder, false>(lds, g, S, E, nullptr); }
    }
    if (PH_ON(7) && ph_lo <= 7 && 7 < ph_hi) { if (7 > ph_lo) gbar(bar, (unsigned)(++nbar) * gridDim.x);
        const Params Pl = kparams(); unsigned char* ws = Pl.ws;
        for (int rep = 0; rep < REP_N(7); ++rep)
        vt_phase(Pl, lds);
    }
    if (PH_ON(8) && ph_lo <= 8 && 8 < ph_hi) { if (8 > ph_lo) gbar(bar, (unsigned)(++nbar) * gridDim.x);
        const Params Pl = kparams(); unsigned char* ws = Pl.ws;
        for (int rep = 0; rep < REP_N(8); ++rep)
        attn_phase(Pl, lds);
    }
    if (PH_ON(9) && ph_lo <= 9 && 9 < ph_hi) { if (9 > ph_lo) gbar(bar, (unsigned)(++nbar) * gridDim.x);
        const Params Pl = kparams(); unsigned char* ws = Pl.ws;
        for (int rep = 0; rep < REP_N(9); ++rep)
        { pg8::Gemm g{(const bf16_t*)(ws + OFF_ACT), (const bf16_t*)(ws + OFF_WOUT), NTOK, 4096, 4096};
            pg8::StaticOrder S; S.init(g.M, g.N, (int)gridDim.x, (int)blockIdx.x); EpiRes E{Pl.out, Pl.out};
            pg8::gemm_phase<EpiRes, pg8::StaticOrder, false>(lds, g, S, E, nullptr); }
    }
    if (PH_ON(10) && ph_lo <= 10 && 10 < ph_hi) { if (10 > ph_lo) gbar(bar, (unsigned)(++nbar) * gridDim.x);
        const Params Pl = kparams(); unsigned char* ws = Pl.ws;
        for (int rep = 0; rep < REP_N(10); ++rep)
        ln_phase(Pl.out, Pl.ln_g + DM, Pl.ln_b + DM, nullptr);
    }
}

#ifndef N_LAUNCH_MODE
#define N_LAUNCH_MODE 0
#endif
extern "C" void kernel_launch(void* const* d_in, const int* in_sizes, int n_in, void* d_out, int out_size, void* d_ws, size_t ws_size, hipStream_t stream) {
    static int grid_blocks = 0;
    if (!grid_blocks) {
        int dev = 0, cus = 0, per_cu = 0;
        hipGetDevice(&dev);
        hipDeviceGetAttribute(&cus, hipDeviceAttributeMultiprocessorCount, dev);
        hipFuncSetAttribute((const void*)fwd_megakernel, hipFuncAttributeMaxDynamicSharedMemorySize, LDS_BYTES);
        hipOccupancyMaxActiveBlocksPerMultiprocessor(&per_cu, fwd_megakernel, 512, LDS_BYTES);
        if (per_cu < 1) per_cu = 1;
        grid_blocks = cus * per_cu; if (grid_blocks > 256) grid_blocks = 256;
    }
    if (ws_size < WS_NEED) { fprintf(stderr, "workspace too small: %zu < %zu\n", ws_size, (size_t)WS_NEED); return; }
    Params p{};
    p.x = (const float*)d_in[0]; p.ln_g = (const float*)d_in[1]; p.ln_b = (const float*)d_in[2]; p.rel_bias = (const float*)d_in[3];
    p.a_w_in = (const float*)d_in[4]; p.a_conv_w = (const float*)d_in[5]; p.a_a_log = (const float*)d_in[6]; p.a_dt_bias = (const float*)d_in[7];
    p.a_norm_w = (const float*)d_in[8]; p.a_w_out = (const float*)d_in[9]; p.b_w_in = (const float*)d_in[10];
    p.lq1 = (const float*)d_in[11]; p.lk1 = (const float*)d_in[12]; p.lq2 = (const float*)d_in[13]; p.lk2 = (const float*)d_in[14];
    p.subln_w = (const float*)d_in[15]; p.b_w_out = (const float*)d_in[16];
    p.out = (float*)d_out; p.ws = (unsigned char*)d_ws;
#if N_LAUNCH_MODE == 0
    p.ph_lo = 0; p.ph_hi = 11;
    hipMemsetAsync((unsigned char*)d_ws + OFF_BAR, 0, 256, stream);
    void* args[] = {&p};
    hipError_t e = hipLaunchCooperativeKernel((const void*)fwd_megakernel, dim3(grid_blocks), dim3(512), args, LDS_BYTES, stream);
    if (e != hipSuccess) fprintf(stderr, "cooperative launch failed: %s (grid %d)\n", hipGetErrorString(e), grid_blocks);
#else
    for (int ph = 0; ph < 11; ++ph) { p.ph_lo = ph; p.ph_hi = ph + 1;
        hipLaunchKernelGGL(fwd_megakernel, dim3(grid_blocks), dim3(512), LDS_BYTES, stream, p); }
#endif
}
```

```cpp
#include <hip/hip_runtime.h>
#include <hip/hip_cooperative_groups.h>
#include <cstdio>
#include <cstdint>
namespace cg = cooperative_groups;
namespace pg8 {
#define PG8_LAS __attribute__((address_space(3)))
typedef unsigned short bf16_t;
typedef short bf16x8 __attribute__((ext_vector_type(8)));
typedef float f32x4 __attribute__((ext_vector_type(4)));
typedef unsigned u32x4 __attribute__((ext_vector_type(4)));
constexpr int BM = 256, BK = 64, HALF = 128, HTB = HALF * BK * 2  , STAGE_BYTES = 8 * HTB, NXCD = 8, WGM = 8;

__host__ __device__ __forceinline__ int lds_byte(int r, int c) { const int st = (r >> 4) * 2 + (c >> 5), rr = r & 15, cc = c & 31, ob = rr * 64 + cc * 2; return st * 1024 + (ob ^ (((ob >> 9) & 1) << 5)); }
__host__ __device__ __forceinline__ void stage_rc(int b, int& R, int& C) { const int st = b / 1024, sb = b % 1024, swz = sb ^ (((sb >> 9) & 1) << 5); R = (st >> 1) * 16 + swz / 64; C = (st & 1) * 32 + (swz % 64) / 2; }
__host__ __device__ __forceinline__ int perm32(int rho) { const int n = rho >> 4, i = rho & 15; return 8 * (i >> 2) + 4 * n + (i & 3); }

struct Unit { int pm, pn; };
struct Gemm { const bf16_t* A; const bf16_t* Bt; int M, N, K; };

struct StaticOrder {
    int nM, nN, nwg, G, c;
    __host__ __device__ void init(int M, int N, int G_, int c_) { nM = M / BM; nN = N / BM; nwg = nM * nN; G = G_; c = c_; }
    __host__ __device__ bool next(int i, Unit& u) const {
        const long L = (long)i * G + c; if (L >= nwg) return false;
        int wgid = (int)L; { const int q = nwg / NXCD, r = nwg % NXCD, xcd = wgid % NXCD, off = wgid / NXCD; wgid = (xcd < r ? xcd * (q + 1) : r * (q + 1) + (xcd - r) * q) + off; }
        const int nig = WGM * nN, gid = wgid / nig, fm = gid * WGM, gsz = (nM - fm) < WGM ? (nM - fm) : WGM;
        u.pm = fm + ((wgid % nig) % gsz); u.pn = (wgid % nig) / gsz; return true;
    }
    __device__ __forceinline__ void a_ready(const Unit&) const {}
    __device__ __forceinline__ void done(const Unit&) const {}
};

template <class Epi, class Sched, bool STAMP = false>
__device__ __forceinline__ void gemm_phase(PG8_LAS unsigned char* lds, const Gemm g, const Sched& S, const Epi& E, unsigned long long* stamps) {
    const int tid = threadIdx.x, wid = __builtin_amdgcn_readfirstlane(tid >> 6), lane = tid & 63, wr = wid >> 2, wc = wid & 3, fr = lane & 15, fq = lane >> 4;
    const int K = g.K, nt = K / BK;
    int ts_lo = 0, ts_hi = 0, nts = 0; const unsigned long long rt_entry = STAMP ? (unsigned long long)wall_clock64() : 0ull;
#define PG8_STAMP() do { if (STAMP && wid == 0 && nts < 64) { const unsigned long long _c = (unsigned long long)clock64(); \
        ts_lo = (lane == nts) ? (int)(unsigned)_c : ts_lo; ts_hi = (lane == nts) ? (int)(unsigned)(_c >> 32) : ts_hi; ++nts; } } while (0)
    PG8_STAMP();
    unsigned voffA[2], voffB[2];
#pragma unroll
    for (int i = 0; i < 2; ++i) { int R, C; stage_rc(tid * 16 + i * 8192, R, C); const int Rb = Epi::PERM ? ((R & ~31) + perm32(R & 31)) : R;
        voffA[i] = (unsigned)(R * K + C) * 2u; voffB[i] = (unsigned)(Rb * K + C) * 2u; }
    const size_t kstep = (size_t)(BK * 2);
    const size_t hstep = (size_t)HALF * K * 2;
    const size_t tstep = 2 * hstep;
    const unsigned ldsw = (unsigned)wid * 1024u;
    const int aoff = lds_byte(wr * 64 + fr, fq * 8), boff = lds_byte(wc * 32 + fr, fq * 8);
#define PG8_SA(b, h) (((b) * 2 + (h)) * HTB)
#define PG8_SB(b, h) ((4 + (b) * 2 + (h)) * HTB)
#define PG8_STAGE(bufoff, gbase, voff) do { _Pragma("unroll") for (int _i = 0; _i < 2; ++_i) \
        __builtin_amdgcn_global_load_lds((const unsigned*)((const char*)(gbase) + (voff)[_i]), (PG8_LAS unsigned*)(lds + (bufoff) + ldsw + _i * 8192), 16, 0, 0); } while (0)
#define PG8_LDA(dst, b, h) do { _Pragma("unroll") for (int m = 0; m < 4; ++m) _Pragma("unroll") for (int k = 0; k < 2; ++k) dst[m][k] = *(const PG8_LAS bf16x8*)(lds + PG8_SA(b, h) + aoff + m * 2048 + k * 1024); } while (0)
#define PG8_LDB(dst, b, h) do { _Pragma("unroll") for (int n = 0; n < 2; ++n) _Pragma("unroll") for (int k = 0; k < 2; ++k) dst[n][k] = *(const PG8_LAS bf16x8*)(lds + PG8_SB(b, h) + boff + n * 2048 + k * 1024); } while (0)
#define PG8_MMA(ai, bj, At, Bt) do { __builtin_amdgcn_s_setprio(1); _Pragma("unroll") for (int m = 0; m < 4; ++m) _Pragma("unroll") for (int n = 0; n < 2; ++n) _Pragma("unroll") for (int k = 0; k < 2; ++k) \
        acc[ai][bj][m][n] = __builtin_amdgcn_mfma_f32_16x16x32_bf16(Bt[n][k], At[m][k], acc[ai][bj][m][n], 0, 0, 0); __builtin_amdgcn_s_setprio(0); } while (0)
#define PG8_WAIT_V(n) asm volatile("s_waitcnt vmcnt(" #n ")" ::: "memory")
#define PG8_WAIT_L(n) asm volatile("s_waitcnt lgkmcnt(" #n ")" ::: "memory")
#define PG8_BAR __builtin_amdgcn_s_barrier()
#define PG8_SCHED __builtin_amdgcn_sched_barrier(0)
    Unit cur, nxt; int ui = 0;
    if (!S.next(0, cur)) return;
    f32x4 acc[2][2][4][2];
#pragma unroll
    for (int a = 0; a < 2; ++a)
#pragma unroll
        for (int b = 0; b < 2; ++b)
#pragma unroll
            for (int m = 0; m < 4; ++m)
#pragma unroll
                for (int n = 0; n < 2; ++n) acc[a][b][m][n] = (f32x4){0.f, 0.f, 0.f, 0.f};
    bf16x8 At[4][2], B0[2][2], B1[2][2];
    const char* cA = (const char*)g.A + (size_t)cur.pm * tstep; const char* cB = (const char*)g.Bt + (size_t)cur.pn * tstep;
    S.a_ready(cur);
    PG8_STAGE(PG8_SB(0, 0), cB, voffB); PG8_STAGE(PG8_SA(0, 0), cA, voffA); PG8_STAGE(PG8_SB(0, 1), cB + hstep, voffB); PG8_STAGE(PG8_SA(0, 1), cA + hstep, voffA);
    if (wr == 1) PG8_BAR;
    PG8_WAIT_V(4); PG8_BAR;
    PG8_STAGE(PG8_SB(1, 0), cB + kstep, voffB); PG8_STAGE(PG8_SA(1, 0), cA + kstep, voffA); PG8_STAGE(PG8_SB(1, 1), cB + hstep + kstep, voffB);
    PG8_WAIT_V(6); PG8_BAR;
    PG8_STAMP();
    for (;;) {
        const bool has_next = S.next(ui + 1, nxt);
        const char* nA = has_next ? (const char*)g.A + (size_t)nxt.pm * tstep : cA; const char* nB = has_next ? (const char*)g.Bt + (size_t)nxt.pn * tstep : cB;
        for (int t = 0; t < nt; t += 2) {
            const bool last = (t == nt - 2);
            const char* a1 = cA + (size_t)(t + 1) * kstep;
            const char* a2 = last ? nA : cA + (size_t)(t + 2) * kstep; const char* b2 = last ? nB : cB + (size_t)(t + 2) * kstep;
            const char* a3 = a2 + kstep; const char* b3 = b2 + kstep;
            if (last && has_next) S.a_ready(nxt);
            PG8_LDB(B0, 0, 0); PG8_SCHED; PG8_LDA(At, 0, 0); PG8_STAGE(PG8_SA(1, 1), a1 + hstep, voffA);
            PG8_WAIT_L(8); PG8_BAR; PG8_WAIT_L(0); PG8_MMA(0, 0, At, B0); PG8_BAR; PG8_SCHED;
            PG8_LDB(B1, 0, 1); PG8_STAGE(PG8_SB(0, 0), b2, voffB);
            PG8_BAR; PG8_WAIT_L(0); PG8_MMA(0, 1, At, B1); PG8_BAR;
            PG8_LDA(At, 0, 1); PG8_STAGE(PG8_SA(0, 0), a2, voffA);
            PG8_BAR; PG8_WAIT_L(0); PG8_MMA(1, 0, At, B0); PG8_BAR; PG8_SCHED;
            PG8_STAGE(PG8_SB(0, 1), b2 + hstep, voffB);
            PG8_WAIT_V(6); PG8_BAR; PG8_MMA(1, 1, At, B1); PG8_BAR;
            PG8_LDB(B0, 1, 0); PG8_SCHED; PG8_LDA(At, 1, 0); PG8_STAGE(PG8_SA(0, 1), a2 + hstep, voffA);
            PG8_WAIT_L(8); PG8_BAR; PG8_WAIT_L(0); PG8_MMA(0, 0, At, B0); PG8_BAR; PG8_SCHED;
            PG8_LDB(B1, 1, 1); PG8_STAGE(PG8_SB(1, 0), b3, voffB);
            PG8_BAR; PG8_WAIT_L(0); PG8_MMA(0, 1, At, B1); PG8_BAR;
            PG8_LDA(At, 1, 1); PG8_STAGE(PG8_SA(1, 0), a3, voffA);
            PG8_BAR; PG8_WAIT_L(0); PG8_MMA(1, 0, At, B0); PG8_BAR; PG8_SCHED;
            PG8_STAGE(PG8_SB(1, 1), b3 + hstep, voffB);
            PG8_WAIT_V(6); PG8_BAR; PG8_MMA(1, 1, At, B1); PG8_BAR;
        }
        PG8_STAMP();
        if constexpr (!Epi::AFTER_DRAIN) { E(acc, cur, wr, wc, fr, fq); S.done(cur); }
        PG8_STAMP();
        if (!has_next) break;
#pragma unroll
        for (int a = 0; a < 2; ++a)
#pragma unroll
            for (int b = 0; b < 2; ++b)
#pragma unroll
                for (int m = 0; m < 4; ++m)
#pragma unroll
                    for (int n = 0; n < 2; ++n) acc[a][b][m][n] = (f32x4){0.f, 0.f, 0.f, 0.f};
        cur = nxt; cA = nA; cB = nB; ++ui;
    }
    PG8_WAIT_V(0);
    if (wr == 0) PG8_BAR;
    PG8_BAR;
    if constexpr (Epi::AFTER_DRAIN) { E.fused(acc, cur, wr, wc, fr, fq, lds, wid, lane); S.done(cur); }
    PG8_STAMP();
    if (STAMP && wid == 0) { stamps[lane] = lane < nts ? (((unsigned long long)(unsigned)ts_hi << 32) | (unsigned)ts_lo) : 0ull;
        if (lane == 62) stamps[62] = rt_entry; if (lane == 63) stamps[63] = (unsigned long long)wall_clock64(); }
#undef PG8_STAMP
#undef PG8_SA
#undef PG8_SB
#undef PG8_STAGE
#undef PG8_LDA
#undef PG8_LDB
#undef PG8_MMA
#undef PG8_WAIT_V
#undef PG8_WAIT_L
#undef PG8_BAR
#undef PG8_SCHED
}
}

#define DI __device__ __forceinline__
#define LAS __attribute__((address_space(3)))
typedef unsigned short bf16_t;
typedef short bf16x8 __attribute__((ext_vector_type(8)));
typedef float f32x2 __attribute__((ext_vector_type(2)));
typedef float f32x4 __attribute__((ext_vector_type(4)));
typedef float f32x16 __attribute__((ext_vector_type(16)));
typedef unsigned u32x2 __attribute__((ext_vector_type(2)));
typedef unsigned u32x4 __attribute__((ext_vector_type(4)));
typedef __bf16 bf16v2 __attribute__((ext_vector_type(2)));
typedef LAS unsigned char* ldsp_t;

constexpr int NTOK = 16384, DM = 4096, SEQ = 4096;
constexpr float ALPHA = 1.4142135623730951f;
constexpr float LAM_INIT = 0.35550906759096926f;
constexpr float LOG2E = 1.4426950408889634f;

constexpr size_t OFF_ACT = 0;
constexpr size_t OFF_WIN = 134217728ull;
constexpr size_t OFF_WOUT = OFF_WIN + 136314880ull;
constexpr size_t OFF_H = OFF_WOUT + 33554432ull;
constexpr size_t OFF_AB = OFF_H + 536870912ull;
constexpr size_t OFF_R = OFF_AB + 4194304ull;
constexpr size_t OFF_AA = OFF_R + 134217728ull;
constexpr size_t OFF_CD = OFF_AA + 67108864ull;
constexpr size_t OFF_BT = OFF_CD + 32768ull;
constexpr size_t OFF_BAR = OFF_BT + 16384ull;
constexpr size_t WS_NEED = OFF_BAR + 256ull;

constexpr int LDS_BYTES = 160 * 1024;

struct Params {
    const float* x; const float* ln_g; const float* ln_b; const float* rel_bias;
    const float* a_w_in; const float* a_conv_w; const float* a_a_log; const float* a_dt_bias; const float* a_norm_w; const float* a_w_out;
    const float* b_w_in; const float* lq1; const float* lk1; const float* lq2; const float* lk2; const float* subln_w; const float* b_w_out;
    float* out; unsigned char* ws; int ph_lo, ph_hi;
};

DI float bf2f(unsigned short b) { return __uint_as_float(((unsigned)b) << 16); }
DI unsigned pk2(float lo, float hi) { f32x2 v = {lo, hi}; bf16v2 b = __builtin_convertvector(v, bf16v2); return __builtin_bit_cast(unsigned, b); }
DI unsigned short f2bf(float f) { return (unsigned short)(pk2(f, 0.f) & 0xffffu); }
DI bf16x8 pack8(float a0, float a1, float a2, float a3, float a4, float a5, float a6, float a7) {
    u32x4 w = {pk2(a0, a1), pk2(a2, a3), pk2(a4, a5), pk2(a6, a7)}; return __builtin_bit_cast(bf16x8, w);
}
DI bf16x8 pack8v(const f32x16& x, int s) { return pack8(x[8 * s], x[8 * s + 1], x[8 * s + 2], x[8 * s + 3], x[8 * s + 4], x[8 * s + 5], x[8 * s + 6], x[8 * s + 7]); }
DI int crow(int r, int hi) { return (r & 3) + 8 * (r >> 2) + 4 * hi; }
DI float siluf(float x) { return x * __builtin_amdgcn_rcpf(1.f + __builtin_amdgcn_exp2f(x * -1.4426950408889634f)); }
DI float dpp_add(float v, const int ctrl) { return v; }
#define DPP_ADD(v, ctrl) ((v) + __int_as_float(__builtin_amdgcn_update_dpp(0, __float_as_int(v), (ctrl), 0xf, 0xf, true)))
DI float sum16(float v) {
    v = DPP_ADD(v, 0xB1); v = DPP_ADD(v, 0x4E); v = DPP_ADD(v, 0x141); v = DPP_ADD(v, 0x140); return v; }
DI float wsum(float v) { for (int o = 32; o >= 1; o >>= 1) v += __shfl_xor(v, o); return v; }
#define MFMA32(a, b, c) __builtin_amdgcn_mfma_f32_32x32x16_bf16((a), (b), (c), 0, 0, 0)
DI bf16x8 lds8(ldsp_t p) { return *(const LAS bf16x8*)p; }
DI void wait_vm0() { asm volatile("s_waitcnt vmcnt(0)" ::: "memory"); }
DI void dma4(const void* g, ldsp_t l) { __builtin_amdgcn_global_load_lds((const unsigned*)g, (LAS unsigned*)l, 4, 0, 0); }
DI void dma16(const void* g, ldsp_t l) { __builtin_amdgcn_global_load_lds((const unsigned*)g, (LAS unsigned*)l, 16, 0, 0); }

struct EpiH {
    static constexpr bool PERM = true, AFTER_DRAIN = false;
    bf16_t* H; float* AB;
    DI void operator()(const pg8::f32x4 (&acc)[2][2][4][2], const pg8::Unit& u, int wr, int wc, int fr, int fq) const {
        const int row0 = u.pm * 256 + wr * 64 + fr;
        if (u.pn < 64) {
            const int col0 = u.pn * 256 + wc * 32 + 8 * fq;
#pragma unroll
            for (int ai = 0; ai < 2; ++ai)
#pragma unroll
                for (int m = 0; m < 4; ++m) { bf16_t* rowp = H + (size_t)(row0 + ai * 128 + m * 16) * 16384 + col0;
#pragma unroll
                    for (int bj = 0; bj < 2; ++bj) { pg8::f32x4 v0 = acc[ai][bj][m][0], v1 = acc[ai][bj][m][1];
                        if (u.pn >= 48) {
#pragma unroll
                            for (int e = 0; e < 4; ++e) { v0[e] = siluf(v0[e]); v1[e] = siluf(v1[e]); } }
                        u32x4 w = {pk2(v0[0], v0[1]), pk2(v0[2], v0[3]), pk2(v1[0], v1[1]), pk2(v1[2], v1[3])};
                        *(u32x4*)(rowp + bj * 128) = w; } }
        } else if (wc < 2) {
            const int col0 = wc * 32 + 8 * fq;
#pragma unroll
            for (int ai = 0; ai < 2; ++ai)
#pragma unroll
                for (int m = 0; m < 4; ++m) { float* rowp = AB + (size_t)(row0 + ai * 128 + m * 16) * 64 + col0;
                    *(pg8::f32x4*)rowp = acc[ai][0][m][0]; *(pg8::f32x4*)(rowp + 4) = acc[ai][0][m][1]; }
        }
    }
};
struct EpiRes {
    static constexpr bool PERM = false, AFTER_DRAIN = false;
    const float* res; float* out;
    DI void operator()(const pg8::f32x4 (&acc)[2][2][4][2], const pg8::Unit& u, int wr, int wc, int fr, int fq) const {
        const int row0 = u.pm * 256 + wr * 64 + fr, col0 = u.pn * 256 + wc * 32 + 4 * fq;
#pragma unroll
        for (int ai = 0; ai < 2; ++ai)
#pragma unroll
            for (int m = 0; m < 4; ++m) { const size_t ro = (size_t)(row0 + ai * 128 + m * 16) * 4096 + col0;
#pragma unroll
                for (int bj = 0; bj < 2; ++bj)
#pragma unroll
                    for (int n = 0; n < 2; ++n) { const size_t o = ro + bj * 128 + n * 16; const pg8::f32x4 r = *(const pg8::f32x4*)(res + o);
                        *(pg8::f32x4*)(out + o) = r * ALPHA + acc[ai][bj][m][n]; } }
    }
};

DI void cvt_rows(const float* src, bf16_t* dst, size_t n8) {
    for (size_t i = (size_t)blockIdx.x * 512 + threadIdx.x; i < n8; i += (size_t)gridDim.x * 512) {
        const f32x4 a = *(const f32x4*)(src + i * 8), b = *(const f32x4*)(src + i * 8 + 4);
        *(bf16x8*)(dst + i * 8) = pack8(a[0], a[1], a[2], a[3], b[0], b[1], b[2], b[3]);
    }
}
DI void transpose_w(const float* W, int N, int Npad, bf16_t* WT, ldsp_t lds) {
    const int tid = threadIdx.x; const int ntn = Npad / 64, ntiles = 32 * ntn;
    LAS bf16_t* T = (LAS bf16_t*)lds;
    const int kr0 = tid >> 4, n4 = (tid & 15) * 4;
    f32x4 v[4];
    auto load_tile = [&](int tile) { const int tn = tile % ntn, tk = tile / ntn; const int n0 = tn * 64, k0 = tk * 128;
#pragma unroll
        for (int ps = 0; ps < 4; ++ps) { const f32x4 z4 = {0.f, 0.f, 0.f, 0.f};
            v[ps] = (n0 < N) ? *(const f32x4*)(W + (size_t)(k0 + ps * 32 + kr0) * N + n0 + n4) : z4; } };
    int tile = blockIdx.x;
    if (tile < ntiles) load_tile(tile);
    for (; tile < ntiles; tile += gridDim.x) {
        const int tn = tile % ntn, tk = tile / ntn; const int n0 = tn * 64, k0 = tk * 128;
#pragma unroll
        for (int ps = 0; ps < 4; ++ps) { const int kr = ps * 32 + kr0;
#pragma unroll
            for (int j = 0; j < 4; ++j) T[(n4 + j) * 136 + ((((kr >> 3) ^ (tid & 15)) << 3) | (kr & 7))] = f2bf(v[ps][j]); }
        if (tile + (int)gridDim.x < ntiles) load_tile(tile + (int)gridDim.x);
        __syncthreads();
#pragma unroll
        for (int ps = 0; ps < 2; ++ps) { const int n = ps * 32 + (tid >> 4), kc = (tid & 15) * 8;
            *(bf16x8*)(WT + (size_t)(n0 + n) * 4096 + k0 + kc) = *(const LAS bf16x8*)(T + n * 136 + ((((kc >> 3) ^ ((n >> 2) & 15))) << 3)); }
        __syncthreads();
    }
}
DI void bias_table(const float* rel_bias, float* BT) {
    const int i = blockIdx.x * 512 + threadIdx.x;
    if (i < 4096) { const int h = i >> 8, n = i & 255; int bk;
        if (n < 16) bk = n; else { bk = 16 + (int)(log((double)n / 16.0) / log(8.0) * 16.0); if (bk > 31) bk = 31; }
        BT[i] = rel_bias[bk * 16 + h] * LOG2E; }
}

DI void ln_phase(float* io, const float* g, const float* bv, bf16_t* outb) {
    const int lane = threadIdx.x & 63, wid = threadIdx.x >> 6;
    for (int row = blockIdx.x * 8 + wid; row < NTOK; row += gridDim.x * 8) {
        float* p = io + (size_t)row * DM; f32x4 v[16]; float s = 0.f;
#pragma unroll
        for (int i = 0; i < 16; ++i) { v[i] = *(const f32x4*)(p + (i * 64 + lane) * 4); s += v[i][0] + v[i][1] + v[i][2] + v[i][3]; }
        const float mean = wsum(s) * (1.f / DM); float q = 0.f;
#pragma unroll
        for (int i = 0; i < 16; ++i) { v[i] = v[i] - mean; q += v[i][0] * v[i][0] + v[i][1] * v[i][1] + v[i][2] * v[i][2] + v[i][3] * v[i][3]; }
        const float rstd = rsqrtf(wsum(q) * (1.f / DM) + 1e-5f);
#pragma unroll
        for (int i = 0; i < 16; ++i) { const int col = (i * 64 + lane) * 4; const f32x4 gg = *(const f32x4*)(g + col), bb = *(const f32x4*)(bv + col);
            const f32x4 y = v[i] * rstd * gg + bb; *(f32x4*)(p + col) = y;
            if (outb) { u32x2 w = {pk2(y[0], y[1]), pk2(y[2], y[3])}; *(u32x2*)(outb + (size_t)row * DM + col) = w; } }
    }
}

constexpr int L_KH = 0, L_QH = 17408, L_KT = 34816, L_VT = 53248, L_LF = 71680, L_LT = 88064, L_TF = 104448, L_T1 = 120832, L_T2 = 130048, L_GC = 139264, L_BE = 139520, L_CW = 139776;
DI void p2a_phase(const Params& P, ldsp_t lds) {
    const int tid = threadIdx.x, wid = __builtin_amdgcn_readfirstlane(tid >> 6), lane = tid & 63, c32 = lane & 31, hi = lane >> 5;
    const bf16_t* H = (const bf16_t*)(P.ws + OFF_H); const float* AB = (const float*)(P.ws + OFF_AB);
    bf16_t* NW = (bf16_t*)P.out; bf16_t* UU = (bf16_t*)P.out + 67108864ull; bf16_t* QD = (bf16_t*)(P.ws + OFF_WIN); bf16_t* KST = (bf16_t*)(P.ws + OFF_ACT);
    bf16_t* AA = (bf16_t*)(P.ws + OFF_AA); float* CD = (float*)(P.ws + OFF_CD);
    LAS bf16_t* KH = (LAS bf16_t*)(lds + L_KH); LAS bf16_t* QH = (LAS bf16_t*)(lds + L_QH); LAS bf16_t* KT = (LAS bf16_t*)(lds + L_KT); LAS bf16_t* VT = (LAS bf16_t*)(lds + L_VT);
    LAS float* LF = (LAS float*)(lds + L_LF); LAS float* LT = (LAS float*)(lds + L_LT); LAS float* TF = (LAS float*)(lds + L_TF); LAS bf16_t* T1 = (LAS bf16_t*)(lds + L_T1); LAS bf16_t* T2 = (LAS bf16_t*)(lds + L_T2);
    LAS float* GC = (LAS float*)(lds + L_GC); LAS float* BE = (LAS float*)(lds + L_BE);
    LAS f32x4* CW = (LAS f32x4*)(lds + L_CW);
    int hprev = -1;
    for (int item = blockIdx.x; item < 8192; item += gridDim.x) {
        const int h = item & 31, bc = item >> 5, b = bc >> 6, chunk = bc & 63; const size_t ci = (size_t)((b * 32 + h) * 64 + chunk);
        if (h != hprev) {
            if (tid < 384) CW[tid] = *(const f32x4*)(P.a_conv_w + (size_t)((tid >> 7) * 4096 + h * 128 + (tid & 127)) * 4);
            hprev = h; __syncthreads();
        }
        {
            const int grp = tid & 15, rlo = tid >> 4;
            bf16x8 xv[6][4];
#pragma unroll
            for (int i = 0; i < 6; ++i) {
                const int tensor = i >> 1, row = (i & 1) * 32 + rlo, tseq = chunk * 64 + row;
                const bf16_t* src = H + (size_t)(b * SEQ + tseq) * 16384 + tensor * 4096 + h * 128 + grp * 8;
#pragma unroll
                for (int j = 0; j < 4; ++j) { const bf16x8 z8 = {0, 0, 0, 0, 0, 0, 0, 0};
                    xv[i][j] = (tseq - 3 + j >= 0) ? *(const bf16x8*)(src + (long)(j - 3) * 16384) : z8; }
            }
#pragma unroll
            for (int i = 0; i < 6; ++i) {
                const int tensor = i >> 1, row = (i & 1) * 32 + rlo;
                float y[8];
#pragma unroll
                for (int e = 0; e < 8; ++e) { const f32x4 w4 = CW[tensor * 128 + grp * 8 + e];
                    y[e] = bf2f((unsigned short)xv[i][0][e]) * w4[0] + bf2f((unsigned short)xv[i][1][e]) * w4[1] + bf2f((unsigned short)xv[i][2][e]) * w4[2] + bf2f((unsigned short)xv[i][3][e]) * w4[3]; }
#pragma unroll
                for (int e = 0; e < 8; ++e) y[e] = siluf(y[e]);
                if (tensor < 2) {
                    float ss = 0.f;
#pragma unroll
                    for (int e = 0; e < 8; ++e) ss += y[e] * y[e];
                    ss = sum16(ss);
                    float r = rsqrtf(ss + 1e-6f); if (tensor == 0) r *= 0.08838834764831845f;
#pragma unroll
                    for (int e = 0; e < 8; ++e) y[e] *= r;
                }
                const bf16x8 pv = pack8(y[0], y[1], y[2], y[3], y[4], y[5], y[6], y[7]);
                if (tensor == 0) { *(LAS bf16x8*)(QH + row * 136 + grp * 8) = pv; }
                else if (tensor == 1) { *(LAS bf16x8*)(KH + row * 136 + grp * 8) = pv;
#pragma unroll
                    for (int e = 0; e < 8; ++e) KT[(grp * 8 + e) * 72 + ((((row >> 3) ^ (grp & 7)) << 3) | (row & 7))] = (bf16_t)pv[e]; }
                else {
#pragma unroll
                    for (int e = 0; e < 8; ++e) VT[(grp * 8 + e) * 72 + ((((row >> 3) ^ (grp & 7)) << 3) | (row & 7))] = (bf16_t)pv[e]; }
            }
        }
        if (wid == 0) {
            const size_t tr = (size_t)(b * SEQ + chunk * 64 + lane) * 64;
            const float av = AB[tr + h], bvv = AB[tr + 32 + h];
            const float xs = av + P.a_dt_bias[h];
            const float sp = xs > 20.f ? xs : log1pf(__expf(xs));
            float g = -__expf(P.a_a_log[h]) * sp;
#pragma unroll
            for (int o = 1; o < 64; o <<= 1) { const float t = __shfl_up(g, o); if (lane >= o) g += t; }
            GC[lane] = g; BE[lane] = 1.f / (1.f + __expf(-bvv));
            if (lane == 63) CD[ci] = __expf(g);
        }
        __syncthreads();
        {
            int widv = wid; asm volatile("" : "+s"(widv));
            const int prod = widv >> 2, ti = (widv >> 1) & 1, tj = widv & 1;
            LAS bf16_t* Bm = prod ? QH : KH;
            f32x16 acc; for (int r = 0; r < 16; ++r) acc[r] = 0.f;
#pragma unroll
            for (int ks = 0; ks < 8; ++ks) { const bf16x8 a = *(const LAS bf16x8*)(KH + (32 * ti + c32) * 136 + 16 * ks + 8 * hi);
                const bf16x8 bq = *(const LAS bf16x8*)(Bm + (32 * tj + c32) * 136 + 16 * ks + 8 * hi); acc = MFMA32(a, bq, acc); }
            const int col = 32 * tj + c32; const float gcc = GC[col], bec = BE[col];
            if (prod == 0) {
#pragma unroll
                for (int r = 0; r < 16; ++r) { const int i = 32 * ti + crow(r, hi);
                    const float gi = GC[i]; const float v = BE[i] * acc[r] * __expf(gi - gcc); LF[i * 64 + col] = (i > col) ? v : 0.f;
                    const float vt = bec * acc[r] * __expf(gcc - gi); LT[i * 64 + col] = (col > i) ? vt : 0.f; }
            } else {
                float vals[16];
#pragma unroll
                for (int r = 0; r < 16; ++r) { const int s = 32 * ti + crow(r, hi); const float v = acc[r] * __expf(gcc - GC[s]); vals[r] = (col >= s) ? v : 0.f; }
#pragma unroll
                for (int hb = 0; hb < 2; ++hb)
                    *(bf16x8*)(AA + ci * 4096 + (size_t)((tj * 4 + 2 * ti + hb) * 64 + lane) * 8) =
                        pack8(vals[8 * hb], vals[8 * hb + 1], vals[8 * hb + 2], vals[8 * hb + 3], vals[8 * hb + 4], vals[8 * hb + 5], vals[8 * hb + 6], vals[8 * hb + 7]);
            }
        }
        __syncthreads();
        if (wid < 2) {
            int wid3 = wid, c32o = c32; asm volatile("" : "+s"(wid3)); asm volatile("" : "+v"(c32o));
            const int base = 32 * wid3, c = base + c32o;
            const float be = BE[c], beg = be * __expf(GC[c]);
            int zv = 0; asm volatile("" : "+v"(zv));
            LAS float* LFz = LF + zv; LAS float* LTz = LT + zv;
#pragma unroll 1
            for (int rbl = 0; rbl < 2; ++rbl) {
                const int r0 = base + 16 * rbl;
                float acc[16];
#pragma unroll
                for (int ii = 0; ii < 16; ++ii) acc[ii] = (r0 + ii == c) ? 1.f : 0.f;
#pragma unroll 1
                for (int j = base; j < r0; j += 4) {
                    float t[4]; f32x4 l4[4][4];
#pragma unroll
                    for (int u = 0; u < 4; ++u) { t[u] = TF[(j + u) * 64 + c];
#pragma unroll
                        for (int q = 0; q < 4; ++q) l4[u][q] = *(const LAS f32x4*)(LTz + (j + u) * 64 + r0 + 4 * q); }
#pragma unroll
                    for (int u = 0; u < 4; ++u)
#pragma unroll
                        for (int q = 0; q < 4; ++q) { acc[4 * q] -= l4[u][q][0] * t[u]; acc[4 * q + 1] -= l4[u][q][1] * t[u]; acc[4 * q + 2] -= l4[u][q][2] * t[u]; acc[4 * q + 3] -= l4[u][q][3] * t[u]; }
                }
                f32x4 Lb[16][4];
#pragma unroll
                for (int ii = 1; ii < 16; ++ii)
#pragma unroll
                    for (int q = 0; 4 * q < ii; ++q) Lb[ii][q] = *(const LAS f32x4*)(LFz + (r0 + ii) * 64 + r0 + 4 * q);
                float Tb[16];
#pragma unroll
                for (int ii = 0; ii < 16; ++ii) { float a = acc[ii];
#pragma unroll
                    for (int jj = 0; jj < ii; jj += 4) { const f32x4 l4 = Lb[ii][jj >> 2];
                        a -= l4[0] * Tb[jj]; if (jj + 1 < ii) a -= l4[1] * Tb[jj + 1]; if (jj + 2 < ii) a -= l4[2] * Tb[jj + 2]; if (jj + 3 < ii) a -= l4[3] * Tb[jj + 3]; }
                    Tb[ii] = a; }
#pragma unroll
                for (int ii = 0; ii < 16; ++ii) { TF[(r0 + ii) * 64 + c] = Tb[ii]; T1[(r0 + ii) * 72 + c] = f2bf(-Tb[ii] * beg); T2[(r0 + ii) * 72 + c] = f2bf(Tb[ii] * be); }
            }
            if (wid == 0) {
                LAS bf16_t* z1 = T1 + 32 + c32o; LAS bf16_t* z2 = T2 + 32 + c32o;
#pragma unroll 8
                for (int ii = 0; ii < 32; ++ii) { z1[ii * 72] = 0; z2[ii * 72] = 0; }
            }
        } else {
            const float gl = GC[63];
            int tid3 = tid; asm volatile("" : "+v"(tid3));
            for (int idx = tid3 - 128; idx < 2048; idx += 384) {
                if (idx < 1024) { const int f = idx, mi = f >> 9, ks = (f >> 6) & 7, l = f & 63, m = l & 31, g = l >> 5, tok = 32 * mi + m;
                    const u32x2 e0 = *(const LAS u32x2*)(QH + tok * 136 + 16 * ks + 4 * g), e1 = *(const LAS u32x2*)(QH + tok * 136 + 16 * ks + 8 + 4 * g);
                    const float sc = __expf(GC[tok]);
                    *(bf16x8*)(QD + ci * 8192 + (size_t)f * 8) = pack8(__uint_as_float(e0[0] << 16) * sc, __uint_as_float(e0[0] & 0xffff0000u) * sc, __uint_as_float(e0[1] << 16) * sc, __uint_as_float(e0[1] & 0xffff0000u) * sc,
                                                                      __uint_as_float(e1[0] << 16) * sc, __uint_as_float(e1[0] & 0xffff0000u) * sc, __uint_as_float(e1[1] << 16) * sc, __uint_as_float(e1[1] & 0xffff0000u) * sc);
                } else { const int f = idx - 1024, mt = f >> 8, ks = (f >> 6) & 3, l = f & 63, m = l & 31, g = l >> 5, dk = 32 * mt + m;
                    const int s0 = 16 * ks + 4 * g, s1 = s0 + 8;
                    const int sw = (dk >> 3) & 7;
                    const u32x2 e0 = *(const LAS u32x2*)(KT + dk * 72 + ((((s0 >> 3) ^ sw) << 3) | (s0 & 7))), e1 = *(const LAS u32x2*)(KT + dk * 72 + ((((s1 >> 3) ^ sw) << 3) | (s1 & 7)));
                    const f32x4 g0 = *(const LAS f32x4*)(GC + s0), g1 = *(const LAS f32x4*)(GC + s1);
                    *(bf16x8*)(KST + ci * 8192 + (size_t)f * 8) = pack8(__uint_as_float(e0[0] << 16) * __expf(gl - g0[0]), __uint_as_float(e0[0] & 0xffff0000u) * __expf(gl - g0[1]),
                                                                       __uint_as_float(e0[1] << 16) * __expf(gl - g0[2]), __uint_as_float(e0[1] & 0xffff0000u) * __expf(gl - g0[3]),
                                                                       __uint_as_float(e1[0] << 16) * __expf(gl - g1[0]), __uint_as_float(e1[0] & 0xffff0000u) * __expf(gl - g1[1]),
                                                                       __uint_as_float(e1[1] << 16) * __expf(gl - g1[2]), __uint_as_float(e1[1] & 0xffff0000u) * __expf(gl - g1[3]));
                }
            }
        }
        __syncthreads();
        if (wid == 0) {
            f32x16 X, Y; for (int r = 0; r < 16; ++r) { X[r] = 0.f; Y[r] = 0.f; }
#pragma unroll
            for (int kk = 0; kk < 2; ++kk) { float av[8], bv[8];
#pragma unroll
                for (int e = 0; e < 8; ++e) { const int j = 16 * kk + 8 * hi + e; av[e] = LT[j * 64 + 32 + c32]; bv[e] = TF[j * 64 + c32]; }
                X = MFMA32(pack8(av[0], av[1], av[2], av[3], av[4], av[5], av[6], av[7]), pack8(bv[0], bv[1], bv[2], bv[3], bv[4], bv[5], bv[6], bv[7]), X); }
#pragma unroll
            for (int sx = 0; sx < 2; ++sx) {
                const f32x4 b0 = *(const LAS f32x4*)(TF + (32 + c32) * 64 + 32 + 16 * sx + 4 * hi), b1 = *(const LAS f32x4*)(TF + (32 + c32) * 64 + 32 + 16 * sx + 8 + 4 * hi);
                Y = MFMA32(pack8(b0[0], b0[1], b0[2], b0[3], b1[0], b1[1], b1[2], b1[3]), pack8v(X, sx), Y); }
            const float be = BE[c32], beg = be * __expf(GC[c32]);
#pragma unroll
            for (int r = 0; r < 16; ++r) { const int i = 32 + crow(r, hi); T1[i * 72 + c32] = f2bf(Y[r] * beg); T2[i * 72 + c32] = f2bf(-Y[r] * be); }
        }
        __syncthreads();
#pragma unroll 1
        for (int jj = 0; jj < 2; ++jj) {
            const int j = wid * 2 + jj;
            f32x16 acc; for (int r = 0; r < 16; ++r) acc[r] = 0.f;
            if (j < 8) { const int dt = j >> 1, mi = j & 1;
#pragma unroll
                for (int kk = 0; kk < 4; ++kk) { const bf16x8 a = *(const LAS bf16x8*)(KT + (32 * dt + c32) * 72 + (((2 * kk + hi) ^ (((32 * dt + c32) >> 3) & 7)) << 3));
                    const bf16x8 bq = *(const LAS bf16x8*)(T1 + (32 * mi + c32) * 72 + 16 * kk + 8 * hi); acc = MFMA32(a, bq, acc); }
#pragma unroll
                for (int hb = 0; hb < 2; ++hb) *(bf16x8*)(NW + ci * 8192 + (size_t)((mi * 8 + 2 * dt + hb) * 64 + lane) * 8) = pack8v(acc, hb);
            } else { const int j2 = j - 8, mi = j2 >> 2, nt = j2 & 3;
#pragma unroll
                for (int kk = 0; kk < 4; ++kk) { const bf16x8 a = *(const LAS bf16x8*)(T2 + (32 * mi + c32) * 72 + 16 * kk + 8 * hi);
                    const bf16x8 bq = *(const LAS bf16x8*)(VT + (32 * nt + c32) * 72 + (((2 * kk + hi) ^ (((32 * nt + c32) >> 3) & 7)) << 3)); acc = MFMA32(a, bq, acc); }
                bf16_t* up = UU + ci * 8192 + (size_t)((mi * 4 + nt) * 64 + lane) * 16;
                *(bf16x8*)up = pack8v(acc, 0); *(bf16x8*)(up + 8) = pack8v(acc, 1);
            }
        }
        __syncthreads();
    }
}

DI f32x16 unpack16(const bf16x8 a, const bf16x8 b) { f32x16 r;
#pragma unroll
    for (int e = 0; e < 8; ++e) { r[e] = bf2f((unsigned short)a[e]); r[8 + e] = bf2f((unsigned short)b[e]); } return r; }
DI void scan_phase(const Params& P, ldsp_t lds) {
    if (blockIdx.x >= 128) return;
    const int tid = threadIdx.x, wid = __builtin_amdgcn_readfirstlane(tid >> 6), lane = tid & 63, c32 = lane & 31, hi = lane >> 5;
    const int bh = blockIdx.x, b = bh >> 5, h = bh & 31;
    const bf16_t* H = (const bf16_t*)(P.ws + OFF_H);
    const bf16_t* NW = (const bf16_t*)P.out; const bf16_t* UU = (const bf16_t*)P.out + 67108864ull; const bf16_t* QD = (const bf16_t*)(P.ws + OFF_WIN); const bf16_t* KST = (const bf16_t*)(P.ws + OFF_ACT);
    const bf16_t* AA = (const bf16_t*)(P.ws + OFF_AA); const float* CD = (const float*)(P.ws + OFF_CD); bf16_t* O0 = (bf16_t*)(P.ws + OFF_R);
    constexpr int OPB = 57344, L_OB = 2 * OPB, OBB = 17408;
    const bool helper = wid >= 4;
    f32x16 S[4]; bf16x8 un[4];
#pragma unroll
    for (int mt = 0; mt < 4; ++mt) for (int r = 0; r < 16; ++r) S[mt][r] = 0.f;
    auto dma_chunk = [&](int cc, int buf) {
        const size_t ci = (size_t)bh * 64 + cc; const int hw = wid - 4;
#pragma unroll 1
        for (int i = 0; i < 14; ++i) { const int piece = hw * 14 + i;
            const bf16_t* src;
            if (piece < 16) src = NW + ci * 8192 + piece * 512; else if (piece < 32) src = QD + ci * 8192 + (piece - 16) * 512;
            else if (piece < 48) src = KST + ci * 8192 + (piece - 32) * 512; else src = AA + ci * 4096 + (piece - 48) * 512;
            dma16(src + lane * 8, lds + buf * OPB + piece * 1024); }
    };
    auto load_u = [&](int cc) {
        const size_t ci = (size_t)bh * 64 + cc;
#pragma unroll
        for (int mi = 0; mi < 2; ++mi) { const bf16_t* up = UU + ci * 8192 + (size_t)((mi * 4 + wid) * 64 + lane) * 16; un[2 * mi] = *(const bf16x8*)up; un[2 * mi + 1] = *(const bf16x8*)(up + 8); }
    };
    const bool dma_w = (wid == 4 || wid == 5), fin_w = wid >= 6;
    auto dma_chunk2 = [&](int cc, int buf) {
        const size_t ci = (size_t)bh * 64 + cc; ldsp_t dst = lds + buf * OPB;
        const bf16_t* s0 = NW + ci * 8192 + lane * 8; const bf16_t* s1 = QD + ci * 8192 + lane * 8; const bf16_t* s2 = KST + ci * 8192 + lane * 8; const bf16_t* s3 = AA + ci * 4096 + lane * 8;
        if (wid == 4) {
#pragma unroll 4
            for (int i = 0; i < 16; ++i) dma16(s0 + i * 512, dst + i * 1024);
#pragma unroll 4
            for (int i = 0; i < 12; ++i) dma16(s1 + i * 512, dst + 16384 + i * 1024);
        } else {
#pragma unroll 4
            for (int i = 12; i < 16; ++i) dma16(s1 + i * 512, dst + 16384 + i * 1024);
#pragma unroll 4
            for (int i = 0; i < 16; ++i) dma16(s2 + i * 512, dst + 32768 + i * 1024);
#pragma unroll 4
            for (int i = 0; i < 8; ++i) dma16(s3 + i * 512, dst + 49152 + i * 1024);
        }
    };
    const int ft = tid - 384;
    bf16x8 zreg[8];
    auto load_z = [&](int cc) {
#pragma unroll
        for (int ps = 0; ps < 8; ++ps) { const int unit = ps * 128 + ft, tok = unit >> 4, cg8 = (unit & 15) * 8;
            zreg[ps] = *(const bf16x8*)(H + (size_t)(b * SEQ + cc * 64 + tok) * 16384 + 12288 + h * 128 + cg8); }
    };
    float cdn = 0.f;
    if (dma_w) dma_chunk2(0, 0); else if (!fin_w) { load_u(0); cdn = CD[(size_t)bh * 64]; } else load_z(0);
    wait_vm0(); __syncthreads();
    if (dma_w) {
      __builtin_amdgcn_s_setprio(3);
#pragma unroll 1
      for (int c = 0; c <= 64; ++c) {

            if (c + 1 < 64) dma_chunk2(c + 1, (c + 1) & 1);
            wait_vm0();
        asm volatile("s_waitcnt lgkmcnt(0)" ::: "memory"); __builtin_amdgcn_s_barrier(); asm volatile("" ::: "memory");
      }
      __builtin_amdgcn_s_setprio(0);
    } else if (fin_w) {
#pragma unroll 1
      for (int c = 0; c <= 64; ++c) {

            if (c >= 1) {
                const int cp = c - 1; ldsp_t ob = lds + L_OB + (cp & 1) * OBB;
                const int cg8 = (ft & 15) * 8;
                const f32x4 w0 = *(const f32x4*)(P.a_norm_w + cg8), w1 = *(const f32x4*)(P.a_norm_w + cg8 + 4);
#pragma unroll
                for (int ps = 0; ps < 8; ++ps) { const int unit = ps * 128 + ft, tok = unit >> 4;
                  {
                    const bf16x8 ov = *(const LAS bf16x8*)(ob + (tok * 136 + cg8) * 2);
                    float o[8], ss = 0.f;
#pragma unroll
                    for (int e = 0; e < 8; ++e) { o[e] = bf2f((unsigned short)ov[e]); ss += o[e] * o[e]; }
                    ss = sum16(ss);
                    const float rs = rsqrtf(ss * (1.f / 128.f) + 1e-6f);
                    const size_t trow = (size_t)(b * SEQ + cp * 64 + tok);
                    const bf16x8 zv = zreg[ps];
                    float r[8];
#pragma unroll
                    for (int e = 0; e < 8; ++e) r[e] = o[e] * rs * (e < 4 ? w0[e & 3] : w1[e & 3]) * bf2f((unsigned short)zv[e]);
                    *(bf16x8*)(O0 + trow * 4096 + h * 128 + cg8) = pack8(r[0], r[1], r[2], r[3], r[4], r[5], r[6], r[7]);
                  }
                }
            }
            if (c < 64) load_z(c);
        asm volatile("s_waitcnt lgkmcnt(0)" ::: "memory"); __builtin_amdgcn_s_barrier(); asm volatile("" ::: "memory");
      }
    } else {
#pragma unroll 1
      for (int c = 0; c <= 64; ++c) {
        if (c < 64) {

            ldsp_t op = lds + (c & 1) * OPB + lane * 16;
            const float cd = cdn;
            f32x16 v0 = unpack16(un[0], un[1]), v1 = unpack16(un[2], un[3]);
            bf16x8 Sb[8];
#pragma unroll
            for (int mt = 0; mt < 4; ++mt) { Sb[2 * mt] = pack8v(S[mt], 0); Sb[2 * mt + 1] = pack8v(S[mt], 1); }
            f32x16 o0, o1; for (int r = 0; r < 16; ++r) { o0[r] = 0.f; o1[r] = 0.f; }
#define SB0 __builtin_amdgcn_sched_barrier(0)
            SB0;
#pragma unroll
            for (int g = 0; g < 8; ++g) {
#pragma unroll
                for (int k2 = 0; k2 < 1; ++k2) { const int ks = g;
                    v0 = MFMA32(lds8(op + ks * 1024), Sb[ks], v0); v1 = MFMA32(lds8(op + (8 + ks) * 1024), Sb[ks], v1);
                    o0 = MFMA32(lds8(op + 16384 + ks * 1024), Sb[ks], o0); o1 = MFMA32(lds8(op + 16384 + (8 + ks) * 1024), Sb[ks], o1); }
                SB0; }
            bf16x8 Vb[4]; Vb[0] = pack8v(v0, 0); Vb[1] = pack8v(v0, 1); Vb[2] = pack8v(v1, 0); Vb[3] = pack8v(v1, 1);
            SB0;
            if (c + 1 < 64) { load_u(c + 1); cdn = CD[(size_t)bh * 64 + c + 1]; }
#pragma unroll
            for (int mt = 0; mt < 4; ++mt) S[mt] = S[mt] * cd;
#pragma unroll
            for (int g = 0; g < 4; ++g) {
#pragma unroll
                for (int k2 = 0; k2 < 1; ++k2) { const int ks = g;
                    o0 = MFMA32(lds8(op + 49152 + ks * 1024), Vb[ks], o0); o1 = MFMA32(lds8(op + 49152 + (4 + ks) * 1024), Vb[ks], o1);
#pragma unroll
                    for (int mt = 0; mt < 4; ++mt) S[mt] = MFMA32(lds8(op + 32768 + (mt * 4 + ks) * 1024), Vb[ks], S[mt]); }
                SB0; }
            LAS bf16_t* ob = (LAS bf16_t*)(lds + L_OB + (c & 1) * OBB);
#pragma unroll
            for (int r = 0; r < 16; ++r) { ob[crow(r, hi) * 136 + wid * 32 + c32] = f2bf(o0[r]); ob[(32 + crow(r, hi)) * 136 + wid * 32 + c32] = f2bf(o1[r]); }
                }
        asm volatile("s_waitcnt lgkmcnt(0)" ::: "memory"); __builtin_amdgcn_s_barrier(); asm volatile("" ::: "memory");
      }
    }
}

DI void vt_phase(const Params& P, ldsp_t lds) {
    const int tid = threadIdx.x; const bf16_t* H = (const bf16_t*)(P.ws + OFF_H); bf16_t* VTg = (bf16_t*)(P.ws + OFF_R);
    LAS bf16_t* T = (LAS bf16_t*)lds;
    for (int item = blockIdx.x; item < 2048; item += gridDim.x) {
        const int bh = item >> 5, tb = item & 31, b = bh >> 4, h = bh & 15;
#pragma unroll
        for (int ps = 0; ps < 8; ++ps) { const int tok = ps * 16 + (tid >> 5), dg = (tid & 31) * 8;
            const bf16x8 v = *(const bf16x8*)(H + (size_t)(b * SEQ + tb * 128 + tok) * 16384 + 8192 + h * 256 + dg);
            const int o = tok & 15, pos = (tok & ~15) | (o & 3) | ((o & 4) << 1) | ((o & 8) >> 1);
#pragma unroll
            for (int e = 0; e < 8; ++e) T[(dg + e) * 136 + (pos ^ ((tid & 15) << 3))] = (bf16_t)v[e]; }
        __syncthreads();
#pragma unroll
        for (int ps = 0; ps < 8; ++ps) { const int dv = ps * 32 + (tid >> 4), tc = (tid & 15) * 8;
            *(bf16x8*)(VTg + ((size_t)bh * 256 + dv) * SEQ + tb * 128 + tc) = *(const LAS bf16x8*)(T + dv * 136 + (tc ^ (((dv >> 3) & 15) << 3))); }
        __syncthreads();
    }
}

constexpr int AT_KBUF = 32768  , AT_VOFF = 65536, AT_VBUF = 32768  , AT_BT = 131072, AT_OF_STRIDE = 257;
DI void attn_block(const Params& P, ldsp_t lds, int bh, int qb, float lam) {
    int tid_o = threadIdx.x; asm volatile("" : "+v"(tid_o));
    const int tid = tid_o, wid = __builtin_amdgcn_readfirstlane(tid >> 6), lane = tid & 63, c32 = lane & 31, hi = lane >> 5;
    const int b = bh >> 4, h = bh & 15, q0 = qb * 128, nt = 2 * qb + 2, p = wid >> 2, wsub = wid & 3;
    const bf16_t* H = (const bf16_t*)(P.ws + OFF_H); const bf16_t* VTg = (const bf16_t*)(P.ws + OFF_R); bf16_t* O1 = (bf16_t*)(P.ws + OFF_ACT);
    const float* BTg = (const float*)(P.ws + OFF_BT);
    LAS float* BTs = (LAS float*)(lds + AT_BT);
    if (tid < 256) BTs[tid] = BTg[h * 256 + tid];
    const int qmin = q0 + 32 * wsub, qrow = qmin + c32, qmax = qmin + 31;
    bf16x8 Qf[8];
    { const bf16_t* qp = H + (size_t)(b * SEQ + qrow) * 16384 + h * 256 + p * 128 + 8 * hi;
#pragma unroll
      for (int ks = 0; ks < 8; ++ks) Qf[ks] = *(const bf16x8*)(qp + 16 * ks); }
    const char* kbase = (const char*)(H + (size_t)(b * SEQ) * 16384 + 4096 + h * 256);
    const char* vbase = (const char*)(VTg + (size_t)bh * 256 * SEQ);
    const unsigned kvo = (unsigned)(lane >> 4) * 32768u + (unsigned)(((lane & 15) ^ (lane >> 4)) * 16);
    const unsigned vvo = (unsigned)(lane >> 3) * (SEQ * 2) + (unsigned)(((lane & 7) ^ ((lane >> 3) & 7)) * 16);
    auto load_tile = [&](int kt, int buf) {
        const int k0 = kt * 64;
#pragma unroll
        for (int i = 0; i < 4; ++i) { const int blk = wid * 4 + i, pp = blk >> 4, key0 = 4 * (blk & 15);
            const unsigned lo = (unsigned)(lane >> 4) * 32768u + (unsigned)(((lane & 15) ^ (4 * i + (lane >> 4))) * 16);
            dma16(kbase + ((size_t)(k0 + key0) * 32768 + pp * 256) + lo, lds + buf * AT_KBUF + blk * 1024); }
#pragma unroll
        for (int i = 0; i < 4; ++i) { const int blk = wid * 4 + i;
            const unsigned vo = (unsigned)(lane >> 3) * (SEQ * 2) + (unsigned)(((lane & 7) ^ (4 * (i & 1) + (lane >> 4))) * 16);
            dma16(vbase + ((size_t)(8 * blk) * (SEQ * 2) + k0 * 2) + vo, lds + AT_VOFF + buf * AT_VBUF + blk * 1024); }
    };
    f32x16 O[8];
#pragma unroll
    for (int dt = 0; dt < 8; ++dt) for (int r = 0; r < 16; ++r) O[dt][r] = 0.f;
    float mrun = -1e30f, lrun = 0.f;
    constexpr float CS = 0.08838834764831845f * LOG2E;
    load_tile(0, 0);
    wait_vm0(); __syncthreads();
#pragma unroll 1
    for (int kt = 0; kt < nt; ++kt) {
        const int buf = kt & 1, k0 = kt * 64;
        if (kt + 1 < nt) load_tile(kt + 1, buf ^ 1);
        if (k0 <= qmax) {
            ldsp_t kb = lds + buf * AT_KBUF + p * 16384 + c32 * 256;
            ldsp_t vb = lds + AT_VOFF + buf * AT_VBUF + c32 * 128;
            const int swk = c32 & 15, swv = (c32 >> 1) & 7;
#pragma unroll
            for (int half = 0; half < 2; ++half) {
                const int kh0 = k0 + 32 * half;
                if (kh0 <= qmax) {
                    f32x16 Sx; for (int r = 0; r < 16; ++r) Sx[r] = 0.f;
                    SB0;
#pragma unroll
                    for (int g = 0; g < 2; ++g) {
#pragma unroll
                        for (int k4 = 0; k4 < 4; ++k4) { const int ks = 4 * g + k4;
                            Sx = MFMA32(lds8(kb + 32 * half * 256 + (((2 * ks + hi) ^ swk) << 4)), Qf[ks], Sx); }
                        SB0; }
                    const bool nearb = (qmin - (kh0 + 31)) < 128;
                    if (!nearb) { const float cb = BTs[255];
#pragma unroll
                        for (int r = 0; r < 16; ++r) Sx[r] = Sx[r] * CS + cb;
                    } else {
#pragma unroll
                        for (int r = 0; r < 16; ++r) { const int rel = qrow - (kh0 + crow(r, hi));
                            const float bb = BTs[min(max(rel, 0), 255)];
                            Sx[r] = rel >= 0 ? Sx[r] * CS + bb : -__builtin_inff();
                            if ((r & 3) == 3) SB0; }
                    }
                    float tmax = Sx[0];
#pragma unroll
                    for (int r = 1; r < 16; ++r) tmax = fmaxf(tmax, Sx[r]);
                    { auto rr = __builtin_amdgcn_permlane32_swap(__float_as_uint(tmax), __float_as_uint(tmax), false, false);
                      tmax = fmaxf(__uint_as_float(rr[0]), __uint_as_float(rr[1])); }
                    if (__any(tmax > mrun + 8.f)) {
                        const float mn = fmaxf(mrun, tmax), alpha = __builtin_amdgcn_exp2f(mrun - mn); mrun = mn; lrun *= alpha;
#pragma unroll
                        for (int dt = 0; dt < 8; ++dt) O[dt] = O[dt] * alpha;
                    }
                    float ls = 0.f;
#pragma unroll
                    for (int r = 0; r < 16; ++r) { Sx[r] = __builtin_amdgcn_exp2f(Sx[r] - mrun); ls += Sx[r]; }
                    lrun += ls;
                    bf16x8 Pf[2]; Pf[0] = pack8v(Sx, 0); Pf[1] = pack8v(Sx, 1);
                    SB0;
#pragma unroll
                    for (int d2 = 0; d2 < 2; ++d2) {
#pragma unroll
                        for (int dd = 0; dd < 4; ++dd) { const int dt = 4 * d2 + dd;
#pragma unroll
                            for (int hb = 0; hb < 2; ++hb)
                                O[dt] = MFMA32(lds8(vb + 32 * dt * 128 + (((2 * (2 * half + hb) + hi) ^ swv) << 4)), Pf[hb], O[dt]); }
                        SB0; }
                }
            }
        }
        wait_vm0(); __syncthreads();
    }
    int tid_e = threadIdx.x; asm volatile("" : "+v"(tid_e));
    const int lane_e = tid_e & 63, c32e = lane_e & 31, hie = lane_e >> 5;
    LAS float* Of = (LAS float*)lds;
    const float ltot = lrun + __shfl_xor(lrun, 32), inv = 1.f / ltot;
    const int ql = 32 * wsub + c32e;
    if (p == 1) { const float sc = -lam * inv;
#pragma unroll
        for (int dt = 0; dt < 8; ++dt)
#pragma unroll
            for (int r = 0; r < 16; ++r) Of[ql * AT_OF_STRIDE + 32 * dt + crow(r, hie)] = O[dt][r] * sc; }
    __syncthreads();
    if (p == 0) { float ssq = 0.f;
#pragma unroll
        for (int dt = 0; dt < 8; ++dt)
            {
#pragma unroll
                for (int r = 0; r < 16; ++r) { const float o = O[dt][r] * inv + Of[ql * AT_OF_STRIDE + 32 * dt + crow(r, hie)]; O[dt][r] = o; ssq = __builtin_fmaf(o, o, ssq); }
                SB0; }
        ssq += __shfl_xor(ssq, 32);
        const float rstd = rsqrtf(ssq * (1.f / 256.f) + 1e-5f) * (1.f - LAM_INIT);
#pragma unroll
        for (int dt = 0; dt < 8; ++dt)
#pragma unroll
            for (int r = 0; r < 16; ++r) Of[ql * AT_OF_STRIDE + 32 * dt + crow(r, hie)] = O[dt][r] * rstd; }
    __syncthreads();
#pragma unroll 1
    for (int i = 0; i < 8; ++i) { const int id = tid_e + 512 * i, q = id >> 5, dg = (id & 31) * 8; const size_t trow = (size_t)(b * SEQ + q0 + q);
        const bf16x8 zv = *(const bf16x8*)(H + trow * 16384 + 12288 + h * 256 + dg);
        const f32x4 w0 = *(const f32x4*)(P.subln_w + dg), w1 = *(const f32x4*)(P.subln_w + dg + 4);
        float r[8];
#pragma unroll
        for (int e = 0; e < 8; ++e) r[e] = Of[q * AT_OF_STRIDE + dg + e] * (e < 4 ? w0[e & 3] : w1[e & 3]) * bf2f((unsigned short)zv[e]);
        *(bf16x8*)(O1 + trow * 4096 + h * 256 + dg) = pack8(r[0], r[1], r[2], r[3], r[4], r[5], r[6], r[7]); }
    __syncthreads();
}
DI void attn_phase(const Params& P, ldsp_t lds) {
    const int lane = threadIdx.x & 63;
    float s1 = P.lq1[lane] * P.lk1[lane] + P.lq1[lane + 64] * P.lk1[lane + 64], s2 = P.lq2[lane] * P.lk2[lane] + P.lq2[lane + 64] * P.lk2[lane + 64];
    s1 = wsum(s1); s2 = wsum(s2);
    const float lam = __int_as_float(__builtin_amdgcn_readfirstlane(__float_as_int(expf(s1) - expf(s2) + LAM_INIT)));
    for (int idx = blockIdx.x; idx < 1024; idx += gridDim.x) { const int bh = idx >> 4, j = idx & 15;
#pragma unroll 1
        for (int sub = 0; sub < 2; ++sub) attn_block(P, lds, bh, sub ? 31 - j : j, lam); }
}

typedef const __attribute__((address_space(4))) Params* kparams_t;
DI Params kparams() { kparams_t p = (kparams_t)__builtin_amdgcn_kernarg_segment_ptr(); asm volatile("" : "+s"(p)); const Params* g = (const Params*)p; return *g; }
DI void gbar(unsigned* ctr, unsigned target) {
    __syncthreads();
    if (threadIdx.x == 0) {
        __builtin_amdgcn_fence(__ATOMIC_RELEASE, "agent");
        __hip_atomic_fetch_add(ctr, 1u, __ATOMIC_RELAXED, __HIP_MEMORY_SCOPE_AGENT);
        while (__hip_atomic_load(ctr, __ATOMIC_RELAXED, __HIP_MEMORY_SCOPE_AGENT) < target) __builtin_amdgcn_s_sleep(1);
    }
    __syncthreads();
    __builtin_amdgcn_fence(__ATOMIC_ACQUIRE, "agent");
    asm volatile("s_waitcnt vmcnt(0)" ::: "memory");
}
__global__ void __launch_bounds__(512) fwd_megakernel(Params P) {
    extern __shared__ __attribute__((aligned(16))) unsigned char shm[];
    ldsp_t lds = (ldsp_t)shm;
    cg::grid_group grid = cg::this_grid();
    const int ph_lo = P.ph_lo, ph_hi = P.ph_hi;
    unsigned* bar = (unsigned*)(P.ws + OFF_BAR); int nbar = 0;
#ifdef EXTRA_SYNC
    for (int es = 0; es < EXTRA_SYNC; ++es) grid.sync();
#endif
#ifndef PH_MASK
#define PH_MASK 0x7ff
#endif
#define PH_ON(n) (((PH_MASK) >> (n)) & 1)
#ifndef REP_MASK
#define REP_MASK 0
#endif
#define REP_N(n) ((((REP_MASK) >> (n)) & 1) ? 2 : 1)
    if (PH_ON(0) && ph_lo <= 0 && 0 < ph_hi) { if (0 > ph_lo) gbar(bar, (unsigned)(++nbar) * gridDim.x);
        const Params Pl = kparams(); unsigned char* ws = Pl.ws;
        for (int rep = 0; rep < REP_N(0); ++rep)
        {
            cvt_rows(Pl.x, (bf16_t*)(ws + OFF_ACT), (size_t)NTOK * DM / 8);
            transpose_w(Pl.a_w_in, 16448, 16640, (bf16_t*)(ws + OFF_WIN), lds);
            transpose_w(Pl.a_w_out, 4096, 4096, (bf16_t*)(ws + OFF_WOUT), lds);
            bias_table(Pl.rel_bias, (float*)(ws + OFF_BT));
        }
    }
    if (PH_ON(1) && ph_lo <= 1 && 1 < ph_hi) { if (1 > ph_lo) grid.sync();
        const Params Pl = kparams(); unsigned char* ws = Pl.ws;
        for (int rep = 0; rep < REP_N(1); ++rep)
        { pg8::Gemm g{(const bf16_t*)(ws + OFF_ACT), (const bf16_t*)(ws + OFF_WIN), NTOK, 16640, 4096};
            pg8::StaticOrder S; S.init(g.M, g.N, (int)gridDim.x, (int)blockIdx.x); EpiH E{(bf16_t*)(ws + OFF_H), (float*)(ws + OFF_AB)};
            pg8::gemm_phase<EpiH, pg8::StaticOrder, false>(lds, g, S, E, nullptr); }
    }
    if (PH_ON(2) && ph_lo <= 2 && 2 < ph_hi) { if (2 > ph_lo) gbar(bar, (unsigned)(++nbar) * gridDim.x);
        const Params Pl = kparams(); unsigned char* ws = Pl.ws;
        for (int rep = 0; rep < REP_N(2); ++rep)
        p2a_phase(Pl, lds);
    }
    if (PH_ON(3) && ph_lo <= 3 && 3 < ph_hi) { if (3 > ph_lo) gbar(bar, (unsigned)(++nbar) * gridDim.x);
        const Params Pl = kparams(); unsigned char* ws = Pl.ws;
        for (int rep = 0; rep < REP_N(3); ++rep)
        scan_phase(Pl, lds);
    }
    if (PH_ON(4) && ph_lo <= 4 && 4 < ph_hi) { if (4 > ph_lo) gbar(bar, (unsigned)(++nbar) * gridDim.x);
        const Params Pl = kparams(); unsigned char* ws = Pl.ws;
        for (int rep = 0; rep < REP_N(4); ++rep)
        { pg8::Gemm g{(const bf16_t*)(ws + OFF_R), (const bf16_t*)(ws + OFF_WOUT), NTOK, 4096, 4096};
            pg8::StaticOrder S; S.init(g.M, g.N, (int)gridDim.x, (int)blockIdx.x); EpiRes E{Pl.x, Pl.out};
            pg8::gemm_phase<EpiRes, pg8::StaticOrder, false>(lds, g, S, E, nullptr); }
    }
    if (PH_ON(5) && ph_lo <= 5 && 5 < ph_hi) { if (5 > ph_lo) gbar(bar, (unsigned)(++nbar) * gridDim.x);
        const Params Pl = kparams(); unsigned char* ws = Pl.ws;
        for (int rep = 0; rep < REP_N(5); ++rep)
        {
            ln_phase(Pl.out, Pl.ln_g, Pl.ln_b, (bf16_t*)(ws + OFF_ACT));
            transpose_w(Pl.b_w_in, 16384, 16384, (bf16_t*)(ws + OFF_WIN), lds);
            transpose_w(Pl.b_w_out, 4096, 4096, (bf16_t*)(ws + OFF_WOUT), lds);
        }
    }
    if (PH_ON(6) && ph_lo <= 6 && 6 < ph_hi) { if (6 > ph_lo) gbar(bar, (unsigned)(++nbar) * gridDim.x);
        const Params Pl = kparams(); unsigned char* ws = Pl.ws;
        for (int rep = 0; rep < REP_N(6); ++rep)
        { pg8::Gemm g{(const bf16_t*)(ws + OFF_ACT), (const bf16_t*)(ws + OFF_WIN), NTOK, 16384, 4096};
            pg8::StaticOrder S; S.init(g.M, g.N, (int)gridDim.x, (int)blockIdx.x); EpiH E{(bf16_t*)(ws + OFF_H), (float*)(ws + OFF_AB)};
            pg8::gemm_phase<EpiH, pg8::StaticOrder, false>(lds, g, S, E, nullptr); }
    }
    if (PH_ON(7) && ph_lo <= 7 && 7 < ph_hi) { if (7 > ph_lo) gbar(bar, (unsigned)(++nbar) * gridDim.x);
        const Params Pl = kparams(); unsigned char* ws = Pl.ws;
        for (int rep = 0; rep < REP_N(7); ++rep)
        vt_phase(Pl, lds);
    }
    if (PH_ON(8) && ph_lo <= 8 && 8 < ph_hi) { if (8 > ph_lo) gbar(bar, (unsigned)(++nbar) * gridDim.x);
        const Params Pl = kparams(); unsigned char* ws = Pl.ws;
        for (int rep = 0; rep < REP_N(8); ++rep)
        attn_phase(Pl, lds);
    }
    if (PH_ON(9) && ph_lo <= 9 && 9 < ph_hi) { if (9 > ph_lo) gbar(bar, (unsigned)(++nbar) * gridDim.x);
        const Params Pl = kparams(); unsigned char* ws = Pl.ws;
        for (int rep = 0; rep < REP_N(9); ++rep)
        { pg8::Gemm g{(const bf16_t*)(ws + OFF_ACT), (const bf16_t*)(ws + OFF_WOUT), NTOK, 4096, 4096};
            pg8::StaticOrder S; S.init(g.M, g.N, (int)gridDim.x, (int)blockIdx.x); EpiRes E{Pl.out, Pl.out};
            pg8::gemm_phase<EpiRes, pg8::StaticOrder, false>(lds, g, S, E, nullptr); }
    }
    if (PH_ON(10) && ph_lo <= 10 && 10 < ph_hi) { if (10 > ph_lo) gbar(bar, (unsigned)(++nbar) * gridDim.x);
        const Params Pl = kparams(); unsigned char* ws = Pl.ws;
        for (int rep = 0; rep < REP_N(10); ++rep)
        ln_phase(Pl.out, Pl.ln_g + DM, Pl.ln_b + DM, nullptr);
    }
}

#ifndef N_LAUNCH_MODE
#define N_LAUNCH_MODE 0
#endif
extern "C" void kernel_launch(void* const* d_in, const int* in_sizes, int n_in, void* d_out, int out_size, void* d_ws, size_t ws_size, hipStream_t stream) {
    static int grid_blocks = 0;
    if (!grid_blocks) {
        int dev = 0, cus = 0, per_cu = 0;
        hipGetDevice(&dev);
        hipDeviceGetAttribute(&cus, hipDeviceAttributeMultiprocessorCount, dev);
        hipFuncSetAttribute((const void*)fwd_megakernel, hipFuncAttributeMaxDynamicSharedMemorySize, LDS_BYTES);
        hipOccupancyMaxActiveBlocksPerMultiprocessor(&per_cu, fwd_megakernel, 512, LDS_BYTES);
        if (per_cu < 1) per_cu = 1;
        grid_blocks = cus * per_cu; if (grid_blocks > 256) grid_blocks = 256;
    }
    if (ws_size < WS_NEED) { fprintf(stderr, "workspace too small: %zu < %zu\n", ws_size, (size_t)WS_NEED); return; }
    Params p{};
    p.x = (const float*)d_in[0]; p.ln_g = (const float*)d_in[1]; p.ln_b = (const float*)d_in[2]; p.rel_bias = (const float*)d_in[3];
    p.a_w_in = (const float*)d_in[4]; p.a_conv_w = (const float*)d_in[5]; p.a_a_log = (const float*)d_in[6]; p.a_dt_bias = (const float*)d_in[7];
    p.a_norm_w = (const float*)d_in[8]; p.a_w_out = (const float*)d_in[9]; p.b_w_in = (const float*)d_in[10];
    p.lq1 = (const float*)d_in[11]; p.lk1 = (const float*)d_in[12]; p.lq2 = (const float*)d_in[13]; p.lk2 = (const float*)d_in[14];
    p.subln_w = (const float*)d_in[15]; p.b_w_out = (const float*)d_in[16];
    p.out = (float*)d_out; p.ws = (unsigned char*)d_ws;
#if N_LAUNCH_MODE == 0
    p.ph_lo = 0; p.ph_hi = 11;
    hipMemsetAsync((unsigned char*)d_ws + OFF_BAR, 0, 256, stream);
    void* args[] = {&p};
    hipError_t e = hipLaunchCooperativeKernel((const void*)fwd_megakernel, dim3(grid_blocks), dim3(512), args, LDS_BYTES, stream);
    if (e != hipSuccess) fprintf(stderr, "cooperative launch failed: %s (grid %d)\n", hipGetErrorString(e), grid_blocks);
#else
    for (int ph = 0; ph < 11; ++ph) { p.ph_lo = ph; p.ph_hi = ph + 1;
        hipLaunchKernelGGL(fwd_megakernel, dim3(grid_blocks), dim3(512), LDS_BYTES, stream, p); }
#endif
}
```

```cpp
#include <hip/hip_runtime.h>
#include <hip/hip_cooperative_groups.h>
#include <cstdio>
#include <cstdint>
namespace cg = cooperative_groups;
namespace pg8 {
#define PG8_LAS __attribute__((address_space(3)))
typedef unsigned short bf16_t;
typedef short bf16x8 __attribute__((ext_vector_type(8)));
typedef float f32x4 __attribute__((ext_vector_type(4)));
typedef unsigned u32x4 __attribute__((ext_vector_type(4)));
constexpr int BM = 256, BK = 64, HALF = 128, HTB = HALF * BK * 2  , STAGE_BYTES = 8 * HTB, NXCD = 8, WGM = 8;

__host__ __device__ __forceinline__ int lds_byte(int r, int c) { const int st = (r >> 4) * 2 + (c >> 5), rr = r & 15, cc = c & 31, ob = rr * 64 + cc * 2; return st * 1024 + (ob ^ (((ob >> 9) & 1) << 5)); }
__host__ __device__ __forceinline__ void stage_rc(int b, int& R, int& C) { const int st = b / 1024, sb = b % 1024, swz = sb ^ (((sb >> 9) & 1) << 5); R = (st >> 1) * 16 + swz / 64; C = (st & 1) * 32 + (swz % 64) / 2; }
__host__ __device__ __forceinline__ int perm32(int rho) { const int n = rho >> 4, i = rho & 15; return 8 * (i >> 2) + 4 * n + (i & 3); }

struct Unit { int pm, pn; };
struct Gemm { const bf16_t* A; const bf16_t* Bt; int M, N, K; };

struct StaticOrder {
    int nM, nN, nwg, G, c;
    __host__ __device__ void init(int M, int N, int G_, int c_) { nM = M / BM; nN = N / BM; nwg = nM * nN; G = G_; c = c_; }
    __host__ __device__ bool next(int i, Unit& u) const {
        const long L = (long)i * G + c; if (L >= nwg) return false;
        int wgid = (int)L; { const int q = nwg / NXCD, r = nwg % NXCD, xcd = wgid % NXCD, off = wgid / NXCD; wgid = (xcd < r ? xcd * (q + 1) : r * (q + 1) + (xcd - r) * q) + off; }
        const int nig = WGM * nN, gid = wgid / nig, fm = gid * WGM, gsz = (nM - fm) < WGM ? (nM - fm) : WGM;
        u.pm = fm + ((wgid % nig) % gsz); u.pn = (wgid % nig) / gsz; return true;
    }
    __device__ __forceinline__ void a_ready(const Unit&) const {}
    __device__ __forceinline__ void done(const Unit&) const {}
};

template <class Epi, class Sched, bool STAMP = false>
__device__ __forceinline__ void gemm_phase(PG8_LAS unsigned char* lds, const Gemm g, const Sched& S, const Epi& E, unsigned long long* stamps) {
    const int tid = threadIdx.x, wid = __builtin_amdgcn_readfirstlane(tid >> 6), lane = tid & 63, wr = wid >> 2, wc = wid & 3, fr = lane & 15, fq = lane >> 4;
    const int K = g.K, nt = K / BK;
    int ts_lo = 0, ts_hi = 0, nts = 0; const unsigned long long rt_entry = STAMP ? (unsigned long long)wall_clock64() : 0ull;
#define PG8_STAMP() do { if (STAMP && wid == 0 && nts < 64) { const unsigned long long _c = (unsigned long long)clock64(); \
        ts_lo = (lane == nts) ? (int)(unsigned)_c : ts_lo; ts_hi = (lane == nts) ? (int)(unsigned)(_c >> 32) : ts_hi; ++nts; } } while (0)
    PG8_STAMP();
    unsigned voffA[2], voffB[2];
#pragma unroll
    for (int i = 0; i < 2; ++i) { int R, C; stage_rc(tid * 16 + i * 8192, R, C); const int Rb = Epi::PERM ? ((R & ~31) + perm32(R & 31)) : R;
        voffA[i] = (unsigned)(R * K + C) * 2u; voffB[i] = (unsigned)(Rb * K + C) * 2u; }
    const size_t kstep = (size_t)(BK * 2);
    const size_t hstep = (size_t)HALF * K * 2;
    const size_t tstep = 2 * hstep;
    const unsigned ldsw = (unsigned)wid * 1024u;
    const int aoff = lds_byte(wr * 64 + fr, fq * 8), boff = lds_byte(wc * 32 + fr, fq * 8);
#define PG8_SA(b, h) (((b) * 2 + (h)) * HTB)
#define PG8_SB(b, h) ((4 + (b) * 2 + (h)) * HTB)
#define PG8_STAGE(bufoff, gbase, voff) do { _Pragma("unroll") for (int _i = 0; _i < 2; ++_i) \
        __builtin_amdgcn_global_load_lds((const unsigned*)((const char*)(gbase) + (voff)[_i]), (PG8_LAS unsigned*)(lds + (bufoff) + ldsw + _i * 8192), 16, 0, 0); } while (0)
#define PG8_LDA(dst, b, h) do { _Pragma("unroll") for (int m = 0; m < 4; ++m) _Pragma("unroll") for (int k = 0; k < 2; ++k) dst[m][k] = *(const PG8_LAS bf16x8*)(lds + PG8_SA(b, h) + aoff + m * 2048 + k * 1024); } while (0)
#define PG8_LDB(dst, b, h) do { _Pragma("unroll") for (int n = 0; n < 2; ++n) _Pragma("unroll") for (int k = 0; k < 2; ++k) dst[n][k] = *(const PG8_LAS bf16x8*)(lds + PG8_SB(b, h) + boff + n * 2048 + k * 1024); } while (0)
#define PG8_MMA(ai, bj, At, Bt) do { __builtin_amdgcn_s_setprio(1); _Pragma("unroll") for (int m = 0; m < 4; ++m) _Pragma("unroll") for (int n = 0; n < 2; ++n) _Pragma("unroll") for (int k = 0; k < 2; ++k) \
        acc[ai][bj][m][n] = __builtin_amdgcn_mfma_f32_16x16x32_bf16(Bt[n][k], At[m][k], acc[ai][bj][m][n], 0, 0, 0); __builtin_amdgcn_s_setprio(0); } while (0)
#define PG8_WAIT_V(n) asm volatile("s_waitcnt vmcnt(" #n ")" ::: "memory")
#define PG8_WAIT_L(n) asm volatile("s_waitcnt lgkmcnt(" #n ")" ::: "memory")
#define PG8_BAR __builtin_amdgcn_s_barrier()
#define PG8_SCHED __builtin_amdgcn_sched_barrier(0)
    Unit cur, nxt; int ui = 0;
    if (!S.next(0, cur)) return;
    f32x4 acc[2][2][4][2];
#pragma unroll
    for (int a = 0; a < 2; ++a)
#pragma unroll
        for (int b = 0; b < 2; ++b)
#pragma unroll
            for (int m = 0; m < 4; ++m)
#pragma unroll
                for (int n = 0; n < 2; ++n) acc[a][b][m][n] = (f32x4){0.f, 0.f, 0.f, 0.f};
    bf16x8 At[4][2], B0[2][2], B1[2][2];
    const char* cA = (const char*)g.A + (size_t)cur.pm * tstep; const char* cB = (const char*)g.Bt + (size_t)cur.pn * tstep;
    S.a_ready(cur);
    PG8_STAGE(PG8_SB(0, 0), cB, voffB); PG8_STAGE(PG8_SA(0, 0), cA, voffA); PG8_STAGE(PG8_SB(0, 1), cB + hstep, voffB); PG8_STAGE(PG8_SA(0, 1), cA + hstep, voffA);
    if (wr == 1) PG8_BAR;
    PG8_WAIT_V(4); PG8_BAR;
    PG8_STAGE(PG8_SB(1, 0), cB + kstep, voffB); PG8_STAGE(PG8_SA(1, 0), cA + kstep, voffA); PG8_STAGE(PG8_SB(1, 1), cB + hstep + kstep, voffB);
    PG8_WAIT_V(6); PG8_BAR;
    PG8_STAMP();
    for (;;) {
        const bool has_next = S.next(ui + 1, nxt);
        const char* nA = has_next ? (const char*)g.A + (size_t)nxt.pm * tstep : cA; const char* nB = has_next ? (const char*)g.Bt + (size_t)nxt.pn * tstep : cB;
        for (int t = 0; t < nt; t += 2) {
            const bool last = (t == nt - 2);
            const char* a1 = cA + (size_t)(t + 1) * kstep;
            const char* a2 = last ? nA : cA + (size_t)(t + 2) * kstep; const char* b2 = last ? nB : cB + (size_t)(t + 2) * kstep;
            const char* a3 = a2 + kstep; const char* b3 = b2 + kstep;
            if (last && has_next) S.a_ready(nxt);
            PG8_LDB(B0, 0, 0); PG8_SCHED; PG8_LDA(At, 0, 0); PG8_STAGE(PG8_SA(1, 1), a1 + hstep, voffA);
            PG8_WAIT_L(8); PG8_BAR; PG8_WAIT_L(0); PG8_MMA(0, 0, At, B0); PG8_BAR; PG8_SCHED;
            PG8_LDB(B1, 0, 1); PG8_STAGE(PG8_SB(0, 0), b2, voffB);
            PG8_BAR; PG8_WAIT_L(0); PG8_MMA(0, 1, At, B1); PG8_BAR;
            PG8_LDA(At, 0, 1); PG8_STAGE(PG8_SA(0, 0), a2, voffA);
            PG8_BAR; PG8_WAIT_L(0); PG8_MMA(1, 0, At, B0); PG8_BAR; PG8_SCHED;
            PG8_STAGE(PG8_SB(0, 1), b2 + hstep, voffB);
            PG8_WAIT_V(6); PG8_BAR; PG8_MMA(1, 1, At, B1); PG8_BAR;
            PG8_LDB(B0, 1, 0); PG8_SCHED; PG8_LDA(At, 1, 0); PG8_STAGE(PG8_SA(0, 1), a2 + hstep, voffA);
            PG8_WAIT_L(8); PG8_BAR; PG8_WAIT_L(0); PG8_MMA(0, 0, At, B0); PG8_BAR; PG8_SCHED;
            PG8_LDB(B1, 1, 1); PG8_STAGE(PG8_SB(1, 0), b3, voffB);
            PG8_BAR; PG8_WAIT_L(0); PG8_MMA(0, 1, At, B1); PG8_BAR;
            PG8_LDA(At, 1, 1); PG8_STAGE(PG8_SA(1, 0), a3, voffA);
            PG8_BAR; PG8_WAIT_L(0); PG8_MMA(1, 0, At, B0); PG8_BAR; PG8_SCHED;
            PG8_STAGE(PG8_SB(1, 1), b3 + hstep, voffB);
            PG8_WAIT_V(6); PG8_BAR; PG8_MMA(1, 1, At, B1); PG8_BAR;
        }
        PG8_STAMP();
        if constexpr (!Epi::AFTER_DRAIN) { E(acc, cur, wr, wc, fr, fq); S.done(cur); }
        PG8_STAMP();
        if (!has_next) break;
#pragma unroll
        for (int a = 0; a < 2; ++a)
#pragma unroll
            for (int b = 0; b < 2; ++b)
#pragma unroll
                for (int m = 0; m < 4; ++m)
#pragma unroll
                    for (int n = 0; n < 2; ++n) acc[a][b][m][n] = (f32x4){0.f, 0.f, 0.f, 0.f};
        cur = nxt; cA = nA; cB = nB; ++ui;
    }
    PG8_WAIT_V(0);
    if (wr == 0) PG8_BAR;
    PG8_BAR;
    if constexpr (Epi::AFTER_DRAIN) { E.fused(acc, cur, wr, wc, fr, fq, lds, wid, lane); S.done(cur); }
    PG8_STAMP();
    if (STAMP && wid == 0) { stamps[lane] = lane < nts ? (((unsigned long long)(unsigned)ts_hi << 32) | (unsigned)ts_lo) : 0ull;
        if (lane == 62) stamps[62] = rt_entry; if (lane == 63) stamps[63] = (unsigned long long)wall_clock64(); }
#undef PG8_STAMP
#undef PG8_SA
#undef PG8_SB
#undef PG8_STAGE
#undef PG8_LDA
#undef PG8_LDB
#undef PG8_MMA
#undef PG8_WAIT_V
#undef PG8_WAIT_L
#undef PG8_BAR
#undef PG8_SCHED
}
}

#define DI __device__ __forceinline__
#define LAS __attribute__((address_space(3)))
typedef unsigned short bf16_t;
typedef short bf16x8 __attribute__((ext_vector_type(8)));
typedef float f32x2 __attribute__((ext_vector_type(2)));
typedef float f32x4 __attribute__((ext_vector_type(4)));
typedef float f32x16 __attribute__((ext_vector_type(16)));
typedef unsigned u32x2 __attribute__((ext_vector_type(2)));
typedef unsigned u32x4 __attribute__((ext_vector_type(4)));
typedef __bf16 bf16v2 __attribute__((ext_vector_type(2)));
typedef LAS unsigned char* ldsp_t;

constexpr int NTOK = 16384, DM = 4096, SEQ = 4096;
constexpr float ALPHA = 1.4142135623730951f;
constexpr float LAM_INIT = 0.35550906759096926f;
constexpr float LOG2E = 1.4426950408889634f;

constexpr size_t OFF_ACT = 0;
constexpr size_t OFF_WIN = 134217728ull;
constexpr size_t OFF_WOUT = OFF_WIN + 136314880ull;
constexpr size_t OFF_H = OFF_WOUT + 33554432ull;
constexpr size_t OFF_AB = OFF_H + 536870912ull;
constexpr size_t OFF_R = OFF_AB + 4194304ull;
constexpr size_t OFF_AA = OFF_R + 134217728ull;
constexpr size_t OFF_CD = OFF_AA + 67108864ull;
constexpr size_t OFF_BT = OFF_CD + 32768ull;
constexpr size_t OFF_BAR = OFF_BT + 16384ull;
constexpr size_t WS_NEED = OFF_BAR + 256ull;

constexpr int LDS_BYTES = 160 * 1024;

struct Params {
    const float* x; const float* ln_g; const float* ln_b; const float* rel_bias;
    const float* a_w_in; const float* a_conv_w; const float* a_a_log; const float* a_dt_bias; const float* a_norm_w; const float* a_w_out;
    const float* b_w_in; const float* lq1; const float* lk1; const float* lq2; const float* lk2; const float* subln_w; const float* b_w_out;
    float* out; unsigned char* ws; int ph_lo, ph_hi;
};

DI float bf2f(unsigned short b) { return __uint_as_float(((unsigned)b) << 16); }
DI unsigned pk2(float lo, float hi) { f32x2 v = {lo, hi}; bf16v2 b = __builtin_convertvector(v, bf16v2); return __builtin_bit_cast(unsigned, b); }
DI unsigned short f2bf(float f) { return (unsigned short)(pk2(f, 0.f) & 0xffffu); }
DI bf16x8 pack8(float a0, float a1, float a2, float a3, float a4, float a5, float a6, float a7) {
    u32x4 w = {pk2(a0, a1), pk2(a2, a3), pk2(a4, a5), pk2(a6, a7)}; return __builtin_bit_cast(bf16x8, w);
}
DI bf16x8 pack8v(const f32x16& x, int s) { return pack8(x[8 * s], x[8 * s + 1], x[8 * s + 2], x[8 * s + 3], x[8 * s + 4], x[8 * s + 5], x[8 * s + 6], x[8 * s + 7]); }
DI int crow(int r, int hi) { return (r & 3) + 8 * (r >> 2) + 4 * hi; }
DI float siluf(float x) { return x * __builtin_amdgcn_rcpf(1.f + __builtin_amdgcn_exp2f(x * -1.4426950408889634f)); }
DI float dpp_add(float v, const int ctrl) { return v; }
#define DPP_ADD(v, ctrl) ((v) + __int_as_float(__builtin_amdgcn_update_dpp(0, __float_as_int(v), (ctrl), 0xf, 0xf, true)))
DI float sum16(float v) {
    v = DPP_ADD(v, 0xB1); v = DPP_ADD(v, 0x4E); v = DPP_ADD(v, 0x141); v = DPP_ADD(v, 0x140); return v; }
DI float wsum(float v) { for (int o = 32; o >= 1; o >>= 1) v += __shfl_xor(v, o); return v; }
#define MFMA32(a, b, c) __builtin_amdgcn_mfma_f32_32x32x16_bf16((a), (b), (c), 0, 0, 0)
DI bf16x8 lds8(ldsp_t p) { return *(const LAS bf16x8*)p; }
DI void wait_vm0() { asm volatile("s_waitcnt vmcnt(0)" ::: "memory"); }
DI void dma4(const void* g, ldsp_t l) { __builtin_amdgcn_global_load_lds((const unsigned*)g, (LAS unsigned*)l, 4, 0, 0); }
DI void dma16(const void* g, ldsp_t l) { __builtin_amdgcn_global_load_lds((const unsigned*)g, (LAS unsigned*)l, 16, 0, 0); }

struct EpiH {
    static constexpr bool PERM = true, AFTER_DRAIN = false;
    bf16_t* H; float* AB;
    DI void operator()(const pg8::f32x4 (&acc)[2][2][4][2], const pg8::Unit& u, int wr, int wc, int fr, int fq) const {
        const int row0 = u.pm * 256 + wr * 64 + fr;
        if (u.pn < 64) {
            const int col0 = u.pn * 256 + wc * 32 + 8 * fq;
#pragma unroll
            for (int ai = 0; ai < 2; ++ai)
#pragma unroll
                for (int m = 0; m < 4; ++m) { bf16_t* rowp = H + (size_t)(row0 + ai * 128 + m * 16) * 16384 + col0;
#pragma unroll
                    for (int bj = 0; bj < 2; ++bj) { pg8::f32x4 v0 = acc[ai][bj][m][0], v1 = acc[ai][bj][m][1];
                        if (u.pn >= 48) {
#pragma unroll
                            for (int e = 0; e < 4; ++e) { v0[e] = siluf(v0[e]); v1[e] = siluf(v1[e]); } }
                        u32x4 w = {pk2(v0[0], v0[1]), pk2(v0[2], v0[3]), pk2(v1[0], v1[1]), pk2(v1[2], v1[3])};
                        *(u32x4*)(rowp + bj * 128) = w; } }
        } else if (wc < 2) {
            const int col0 = wc * 32 + 8 * fq;
#pragma unroll
            for (int ai = 0; ai < 2; ++ai)
#pragma unroll
                for (int m = 0; m < 4; ++m) { float* rowp = AB + (size_t)(row0 + ai * 128 + m * 16) * 64 + col0;
                    *(pg8::f32x4*)rowp = acc[ai][0][m][0]; *(pg8::f32x4*)(rowp + 4) = acc[ai][0][m][1]; }
        }
    }
};
struct EpiRes {
    static constexpr bool PERM = false, AFTER_DRAIN = false;
    const float* res; float* out;
    DI void operator()(const pg8::f32x4 (&acc)[2][2][4][2], const pg8::Unit& u, int wr, int wc, int fr, int fq) const {
        const int row0 = u.pm * 256 + wr * 64 + fr, col0 = u.pn * 256 + wc * 32 + 4 * fq;
#pragma unroll
        for (int ai = 0; ai < 2; ++ai)
#pragma unroll
            for (int m = 0; m < 4; ++m) { const size_t ro = (size_t)(row0 + ai * 128 + m * 16) * 4096 + col0;
#pragma unroll
                for (int bj = 0; bj < 2; ++bj)
#pragma unroll
                    for (int n = 0; n < 2; ++n) { const size_t o = ro + bj * 128 + n * 16; const pg8::f32x4 r = *(const pg8::f32x4*)(res + o);
                        *(pg8::f32x4*)(out + o) = r * ALPHA + acc[ai][bj][m][n]; } }
    }
};

DI void cvt_rows(const float* src, bf16_t* dst, size_t n8) {
    for (size_t i = (size_t)blockIdx.x * 512 + threadIdx.x; i < n8; i += (size_t)gridDim.x * 512) {
        const f32x4 a = *(const f32x4*)(src + i * 8), b = *(const f32x4*)(src + i * 8 + 4);
        *(bf16x8*)(dst + i * 8) = pack8(a[0], a[1], a[2], a[3], b[0], b[1], b[2], b[3]);
    }
}
DI void transpose_w(const float* W, int N, int Npad, bf16_t* WT, ldsp_t lds) {
    const int tid = threadIdx.x; const int ntn = Npad / 64, ntiles = 32 * ntn;
    LAS bf16_t* T = (LAS bf16_t*)lds;
    const int kr0 = tid >> 4, n4 = (tid & 15) * 4;
    f32x4 v[4];
    auto load_tile = [&](int tile) { const int tn = tile % ntn, tk = tile / ntn; const int n0 = tn * 64, k0 = tk * 128;
#pragma unroll
        for (int ps = 0; ps < 4; ++ps) { const f32x4 z4 = {0.f, 0.f, 0.f, 0.f};
            v[ps] = (n0 < N) ? *(const f32x4*)(W + (size_t)(k0 + ps * 32 + kr0) * N + n0 + n4) : z4; } };
    int tile = blockIdx.x;
    if (tile < ntiles) load_tile(tile);
    for (; tile < ntiles; tile += gridDim.x) {
        const int tn = tile % ntn, tk = tile / ntn; const int n0 = tn * 64, k0 = tk * 128;
#pragma unroll
        for (int ps = 0; ps < 4; ++ps) { const int kr = ps * 32 + kr0;
#pragma unroll
            for (int j = 0; j < 4; ++j) T[(n4 + j) * 136 + ((((kr >> 3) ^ (tid & 15)) << 3) | (kr & 7))] = f2bf(v[ps][j]); }
        if (tile + (int)gridDim.x < ntiles) load_tile(tile + (int)gridDim.x);
        __syncthreads();
#pragma unroll
        for (int ps = 0; ps < 2; ++ps) { const int n = ps * 32 + (tid >> 4), kc = (tid & 15) * 8;
            *(bf16x8*)(WT + (size_t)(n0 + n) * 4096 + k0 + kc) = *(const LAS bf16x8*)(T + n * 136 + ((((kc >> 3) ^ ((n >> 2) & 15))) << 3)); }
        __syncthreads();
    }
}
DI void bias_table(const float* rel_bias, float* BT) {
    const int i = blockIdx.x * 512 + threadIdx.x;
    if (i < 4096) { const int h = i >> 8, n = i & 255; int bk;
        if (n < 16) bk = n; else { bk = 16 + (int)(log((double)n / 16.0) / log(8.0) * 16.0); if (bk > 31) bk = 31; }
        BT[i] = rel_bias[bk * 16 + h] * LOG2E; }
}

DI void ln_phase(float* io, const float* g, const float* bv, bf16_t* outb) {
    const int lane = threadIdx.x & 63, wid = threadIdx.x >> 6;
    for (int row = blockIdx.x * 8 + wid; row < NTOK; row += gridDim.x * 8) {
        float* p = io + (size_t)row * DM; f32x4 v[16]; float s = 0.f;
#pragma unroll
        for (int i = 0; i < 16; ++i) { v[i] = *(const f32x4*)(p + (i * 64 + lane) * 4); s += v[i][0] + v[i][1] + v[i][2] + v[i][3]; }
        const float mean = wsum(s) * (1.f / DM); float q = 0.f;
#pragma unroll
        for (int i = 0; i < 16; ++i) { v[i] = v[i] - mean; q += v[i][0] * v[i][0] + v[i][1] * v[i][1] + v[i][2] * v[i][2] + v[i][3] * v[i][3]; }
        const float rstd = rsqrtf(wsum(q) * (1.f / DM) + 1e-5f);
#pragma unroll
        for (int i = 0; i < 16; ++i) { const int col = (i * 64 + lane) * 4; const f32x4 gg = *(const f32x4*)(g + col), bb = *(const f32x4*)(bv + col);
            const f32x4 y = v[i] * rstd * gg + bb; *(f32x4*)(p + col) = y;
            if (outb) { u32x2 w = {pk2(y[0], y[1]), pk2(y[2], y[3])}; *(u32x2*)(outb + (size_t)row * DM + col) = w; } }
    }
}

constexpr int L_KH = 0, L_QH = 17408, L_KT = 34816, L_VT = 53248, L_LF = 71680, L_LT = 88064, L_TF = 104448, L_T1 = 120832, L_T2 = 130048, L_GC = 139264, L_BE = 139520, L_CW = 139776;
DI void p2a_phase(const Params& P, ldsp_t lds) {
    const int tid = threadIdx.x, wid = __builtin_amdgcn_readfirstlane(tid >> 6), lane = tid & 63, c32 = lane & 31, hi = lane >> 5;
    const bf16_t* H = (const bf16_t*)(P.ws + OFF_H); const float* AB = (const float*)(P.ws + OFF_AB);
    bf16_t* NW = (bf16_t*)P.out; bf16_t* UU = (bf16_t*)P.out + 67108864ull; bf16_t* QD = (bf16_t*)(P.ws + OFF_WIN); bf16_t* KST = (bf16_t*)(P.ws + OFF_ACT);
    bf16_t* AA = (bf16_t*)(P.ws + OFF_AA); float* CD = (float*)(P.ws + OFF_CD);
    LAS bf16_t* KH = (LAS bf16_t*)(lds + L_KH); LAS bf16_t* QH = (LAS bf16_t*)(lds + L_QH); LAS bf16_t* KT = (LAS bf16_t*)(lds + L_KT); LAS bf16_t* VT = (LAS bf16_t*)(lds + L_VT);
    LAS float* LF = (LAS float*)(lds + L_LF); LAS float* LT = (LAS float*)(lds + L_LT); LAS float* TF = (LAS float*)(lds + L_TF); LAS bf16_t* T1 = (LAS bf16_t*)(lds + L_T1); LAS bf16_t* T2 = (LAS bf16_t*)(lds + L_T2);
    LAS float* GC = (LAS float*)(lds + L_GC); LAS float* BE = (LAS float*)(lds + L_BE);
    LAS f32x4* CW = (LAS f32x4*)(lds + L_CW);
    int hprev = -1;
    for (int item = blockIdx.x; item < 8192; item += gridDim.x) {
        const int h = item & 31, bc = item >> 5, b = bc >> 6, chunk = bc & 63; const size_t ci = (size_t)((b * 32 + h) * 64 + chunk);
        if (h != hprev) {
            if (tid < 384) CW[tid] = *(const f32x4*)(P.a_conv_w + (size_t)((tid >> 7) * 4096 + h * 128 + (tid & 127)) * 4);
            hprev = h; __syncthreads();
        }
        {
            const int grp = tid & 15, rlo = tid >> 4;
            bf16x8 xv[6][4];
#pragma unroll
            for (int i = 0; i < 6; ++i) {
                const int tensor = i >> 1, row = (i & 1) * 32 + rlo, tseq = chunk * 64 + row;
                const bf16_t* src = H + (size_t)(b * SEQ + tseq) * 16384 + tensor * 4096 + h * 128 + grp * 8;
#pragma unroll
                for (int j = 0; j < 4; ++j) { const bf16x8 z8 = {0, 0, 0, 0, 0, 0, 0, 0};
                    xv[i][j] = (tseq - 3 + j >= 0) ? *(const bf16x8*)(src + (long)(j - 3) * 16384) : z8; }
            }
#pragma unroll
            for (int i = 0; i < 6; ++i) {
                const int tensor = i >> 1, row = (i & 1) * 32 + rlo;
                float y[8];
#pragma unroll
                for (int e = 0; e < 8; ++e) { const f32x4 w4 = CW[tensor * 128 + grp * 8 + e];
                    y[e] = bf2f((unsigned short)xv[i][0][e]) * w4[0] + bf2f((unsigned short)xv[i][1][e]) * w4[1] + bf2f((unsigned short)xv[i][2][e]) * w4[2] + bf2f((unsigned short)xv[i][3][e]) * w4[3]; }
#pragma unroll
                for (int e = 0; e < 8; ++e) y[e] = siluf(y[e]);
                if (tensor < 2) {
                    float ss = 0.f;
#pragma unroll
                    for (int e = 0; e < 8; ++e) ss += y[e] * y[e];
                    ss = sum16(ss);
                    float r = rsqrtf(ss + 1e-6f); if (tensor == 0) r *= 0.08838834764831845f;
#pragma unroll
                    for (int e = 0; e < 8; ++e) y[e] *= r;
                }
                const bf16x8 pv = pack8(y[0], y[1], y[2], y[3], y[4], y[5], y[6], y[7]);
                if (tensor == 0) { *(LAS bf16x8*)(QH + row * 136 + grp * 8) = pv; }
                else if (tensor == 1) { *(LAS bf16x8*)(KH + row * 136 + grp * 8) = pv;
#pragma unroll
                    for (int e = 0; e < 8; ++e) KT[(grp * 8 + e) * 72 + ((((row >> 3) ^ (grp & 7)) << 3) | (row & 7))] = (bf16_t)pv[e]; }
                else {
#pragma unroll
                    for (int e = 0; e < 8; ++e) VT[(grp * 8 + e) * 72 + ((((row >> 3) ^ (grp & 7)) << 3) | (row & 7))] = (bf16_t)pv[e]; }
            }
        }
        if (wid == 0) {
            const size_t tr = (size_t)(b * SEQ + chunk * 64 + lane) * 64;
            const float av = AB[tr + h], bvv = AB[tr + 32 + h];
            const float xs = av + P.a_dt_bias[h];
            const float sp = xs > 20.f ? xs : log1pf(__expf(xs));
            float g = -__expf(P.a_a_log[h]) * sp;
#pragma unroll
            for (int o = 1; o < 64; o <<= 1) { const float t = __shfl_up(g, o); if (lane >= o) g += t; }
            GC[lane] = g; BE[lane] = 1.f / (1.f + __expf(-bvv));
            if (lane == 63) CD[ci] = __expf(g);
        }
        __syncthreads();
        {
            int widv = wid; asm volatile("" : "+s"(widv));
            const int prod = widv >> 2, ti = (widv >> 1) & 1, tj = widv & 1;
            LAS bf16_t* Bm = prod ? QH : KH;
            f32x16 acc; for (int r = 0; r < 16; ++r) acc[r] = 0.f;
#pragma unroll
            for (int ks = 0; ks < 8; ++ks) { const bf16x8 a = *(const LAS bf16x8*)(KH + (32 * ti + c32) * 136 + 16 * ks + 8 * hi);
                const bf16x8 bq = *(const LAS bf16x8*)(Bm + (32 * tj + c32) * 136 + 16 * ks + 8 * hi); acc = MFMA32(a, bq, acc); }
            const int col = 32 * tj + c32; const float gcc = GC[col], bec = BE[col];
            if (prod == 0) {
#pragma unroll
                for (int r = 0; r < 16; ++r) { const int i = 32 * ti + crow(r, hi);
                    const float gi = GC[i]; const float v = BE[i] * acc[r] * __expf(gi - gcc); LF[i * 64 + col] = (i > col) ? v : 0.f;
                    const float vt = bec * acc[r] * __expf(gcc - gi); LT[i * 64 + col] = (col > i) ? vt : 0.f; }
            } else {
                float vals[16];
#pragma unroll
                for (int r = 0; r < 16; ++r) { const int s = 32 * ti + crow(r, hi); const float v = acc[r] * __expf(gcc - GC[s]); vals[r] = (col >= s) ? v : 0.f; }
#pragma unroll
                for (int hb = 0; hb < 2; ++hb)
                    *(bf16x8*)(AA + ci * 4096 + (size_t)((tj * 4 + 2 * ti + hb) * 64 + lane) * 8) =
                        pack8(vals[8 * hb], vals[8 * hb + 1], vals[8 * hb + 2], vals[8 * hb + 3], vals[8 * hb + 4], vals[8 * hb + 5], vals[8 * hb + 6], vals[8 * hb + 7]);
            }
        }
        __syncthreads();
        if (wid < 2) {
            int wid3 = wid, c32o = c32; asm volatile("" : "+s"(wid3)); asm volatile("" : "+v"(c32o));
            const int base = 32 * wid3, c = base + c32o;
            const float be = BE[c], beg = be * __expf(GC[c]);
            int zv = 0; asm volatile("" : "+v"(zv));
            LAS float* LFz = LF + zv; LAS float* LTz = LT + zv;
#pragma unroll 1
            for (int rbl = 0; rbl < 2; ++rbl) {
                const int r0 = base + 16 * rbl;
                float acc[16];
#pragma unroll
                for (int ii = 0; ii < 16; ++ii) acc[ii] = (r0 + ii == c) ? 1.f : 0.f;
#pragma unroll 1
                for (int j = base; j < r0; j += 4) {
                    float t[4]; f32x4 l4[4][4];
#pragma unroll
                    for (int u = 0; u < 4; ++u) { t[u] = TF[(j + u) * 64 + c];
#pragma unroll
                        for (int q = 0; q < 4; ++q) l4[u][q] = *(const LAS f32x4*)(LTz + (j + u) * 64 + r0 + 4 * q); }
#pragma unroll
                    for (int u = 0; u < 4; ++u)
#pragma unroll
                        for (int q = 0; q < 4; ++q) { acc[4 * q] -= l4[u][q][0] * t[u]; acc[4 * q + 1] -= l4[u][q][1] * t[u]; acc[4 * q + 2] -= l4[u][q][2] * t[u]; acc[4 * q + 3] -= l4[u][q][3] * t[u]; }
                }
                f32x4 Lb[16][4];
#pragma unroll
                for (int ii = 1; ii < 16; ++ii)
#pragma unroll
                    for (int q = 0; 4 * q < ii; ++q) Lb[ii][q] = *(const LAS f32x4*)(LFz + (r0 + ii) * 64 + r0 + 4 * q);
                float Tb[16];
#pragma unroll
                for (int ii = 0; ii < 16; ++ii) { float a = acc[ii];
#pragma unroll
                    for (int jj = 0; jj < ii; jj += 4) { const f32x4 l4 = Lb[ii][jj >> 2];
                        a -= l4[0] * Tb[jj]; if (jj + 1 < ii) a -= l4[1] * Tb[jj + 1]; if (jj + 2 < ii) a -= l4[2] * Tb[jj + 2]; if (jj + 3 < ii) a -= l4[3] * Tb[jj + 3]; }
                    Tb[ii] = a; }
#pragma unroll
                for (int ii = 0; ii < 16; ++ii) { TF[(r0 + ii) * 64 + c] = Tb[ii]; T1[(r0 + ii) * 72 + c] = f2bf(-Tb[ii] * beg); T2[(r0 + ii) * 72 + c] = f2bf(Tb[ii] * be); }
            }
            if (wid == 0) {
                LAS bf16_t* z1 = T1 + 32 + c32o; LAS bf16_t* z2 = T2 + 32 + c32o;
#pragma unroll 8
                for (int ii = 0; ii < 32; ++ii) { z1[ii * 72] = 0; z2[ii * 72] = 0; }
            }
        } else {
            const float gl = GC[63];
            int tid3 = tid; asm volatile("" : "+v"(tid3));
            for (int idx = tid3 - 128; idx < 2048; idx += 384) {
                if (idx < 1024) { const int f = idx, mi = f >> 9, ks = (f >> 6) & 7, l = f & 63, m = l & 31, g = l >> 5, tok = 32 * mi + m;
                    const u32x2 e0 = *(const LAS u32x2*)(QH + tok * 136 + 16 * ks + 4 * g), e1 = *(const LAS u32x2*)(QH + tok * 136 + 16 * ks + 8 + 4 * g);
                    const float sc = __expf(GC[tok]);
                    *(bf16x8*)(QD + ci * 8192 + (size_t)f * 8) = pack8(__uint_as_float(e0[0] << 16) * sc, __uint_as_float(e0[0] & 0xffff0000u) * sc, __uint_as_float(e0[1] << 16) * sc, __uint_as_float(e0[1] & 0xffff0000u) * sc,
                                                                      __uint_as_float(e1[0] << 16) * sc, __uint_as_float(e1[0] & 0xffff0000u) * sc, __uint_as_float(e1[1] << 16) * sc, __uint_as_float(e1[1] & 0xffff0000u) * sc);
                } else { const int f = idx - 1024, mt = f >> 8, ks = (f >> 6) & 3, l = f & 63, m = l & 31, g = l >> 5, dk = 32 * mt + m;
                    const int s0 = 16 * ks + 4 * g, s1 = s0 + 8;
                    const int sw = (dk >> 3) & 7;
                    const u32x2 e0 = *(const LAS u32x2*)(KT + dk * 72 + ((((s0 >> 3) ^ sw) << 3) | (s0 & 7))), e1 = *(const LAS u32x2*)(KT + dk * 72 + ((((s1 >> 3) ^ sw) << 3) | (s1 & 7)));
                    const f32x4 g0 = *(const LAS f32x4*)(GC + s0), g1 = *(const LAS f32x4*)(GC + s1);
                    *(bf16x8*)(KST + ci * 8192 + (size_t)f * 8) = pack8(__uint_as_float(e0[0] << 16) * __expf(gl - g0[0]), __uint_as_float(e0[0] & 0xffff0000u) * __expf(gl - g0[1]),
                                                                       __uint_as_float(e0[1] << 16) * __expf(gl - g0[2]), __uint_as_float(e0[1] & 0xffff0000u) * __expf(gl - g0[3]),
                                                                       __uint_as_float(e1[0] << 16) * __expf(gl - g1[0]), __uint_as_float(e1[0] & 0xffff0000u) * __expf(gl - g1[1]),
                                                                       __uint_as_float(e1[1] << 16) * __expf(gl - g1[2]), __uint_as_float(e1[1] & 0xffff0000u) * __expf(gl - g1[3]));
                }
            }
        }
        __syncthreads();
        if (wid == 0) {
            f32x16 X, Y; for (int r = 0; r < 16; ++r) { X[r] = 0.f; Y[r] = 0.f; }
#pragma unroll
            for (int kk = 0; kk < 2; ++kk) { float av[8], bv[8];
#pragma unroll
                for (int e = 0; e < 8; ++e) { const int j = 16 * kk + 8 * hi + e; av[e] = LT[j * 64 + 32 + c32]; bv[e] = TF[j * 64 + c32]; }
                X = MFMA32(pack8(av[0], av[1], av[2], av[3], av[4], av[5], av[6], av[7]), pack8(bv[0], bv[1], bv[2], bv[3], bv[4], bv[5], bv[6], bv[7]), X); }
#pragma unroll
            for (int sx = 0; sx < 2; ++sx) {
                const f32x4 b0 = *(const LAS f32x4*)(TF + (32 + c32) * 64 + 32 + 16 * sx + 4 * hi), b1 = *(const LAS f32x4*)(TF + (32 + c32) * 64 + 32 + 16 * sx + 8 + 4 * hi);
                Y = MFMA32(pack8(b0[0], b0[1], b0[2], b0[3], b1[0], b1[1], b1[2], b1[3]), pack8v(X, sx), Y); }
            const float be = BE[c32], beg = be * __expf(GC[c32]);
#pragma unroll
            for (int r = 0; r < 16; ++r) { const int i = 32 + crow(r, hi); T1[i * 72 + c32] = f2bf(Y[r] * beg); T2[i * 72 + c32] = f2bf(-Y[r] * be); }
        }
        __syncthreads();
#pragma unroll 1
        for (int jj = 0; jj < 2; ++jj) {
            const int j = wid * 2 + jj;
            f32x16 acc; for (int r = 0; r < 16; ++r) acc[r] = 0.f;
            if (j < 8) { const int dt = j >> 1, mi = j & 1;
#pragma unroll
                for (int kk = 0; kk < 4; ++kk) { const bf16x8 a = *(const LAS bf16x8*)(KT + (32 * dt + c32) * 72 + (((2 * kk + hi) ^ (((32 * dt + c32) >> 3) & 7)) << 3));
                    const bf16x8 bq = *(const LAS bf16x8*)(T1 + (32 * mi + c32) * 72 + 16 * kk + 8 * hi); acc = MFMA32(a, bq, acc); }
#pragma unroll
                for (int hb = 0; hb < 2; ++hb) *(bf16x8*)(NW + ci * 8192 + (size_t)((mi * 8 + 2 * dt + hb) * 64 + lane) * 8) = pack8v(acc, hb);
            } else { const int j2 = j - 8, mi = j2 >> 2, nt = j2 & 3;
#pragma unroll
                for (int kk = 0; kk < 4; ++kk) { const bf16x8 a = *(const LAS bf16x8*)(T2 + (32 * mi + c32) * 72 + 16 * kk + 8 * hi);
                    const bf16x8 bq = *(const LAS bf16x8*)(VT + (32 * nt + c32) * 72 + (((2 * kk + hi) ^ (((32 * nt + c32) >> 3) & 7)) << 3)); acc = MFMA32(a, bq, acc); }
                bf16_t* up = UU + ci * 8192 + (size_t)((mi * 4 + nt) * 64 + lane) * 16;
                *(bf16x8*)up = pack8v(acc, 0); *(bf16x8*)(up + 8) = pack8v(acc, 1);
            }
        }
        __syncthreads();
    }
}

DI f32x16 unpack16(const bf16x8 a, const bf16x8 b) { f32x16 r;
#pragma unroll
    for (int e = 0; e < 8; ++e) { r[e] = bf2f((unsigned short)a[e]); r[8 + e] = bf2f((unsigned short)b[e]); } return r; }
DI void scan_phase(const Params& P, ldsp_t lds) {
    if (blockIdx.x >= 128) return;
    const int tid = threadIdx.x, wid = __builtin_amdgcn_readfirstlane(tid >> 6), lane = tid & 63, c32 = lane & 31, hi = lane >> 5;
    const int bh = blockIdx.x, b = bh >> 5, h = bh & 31;
    const bf16_t* H = (const bf16_t*)(P.ws + OFF_H);
    const bf16_t* NW = (const bf16_t*)P.out; const bf16_t* UU = (const bf16_t*)P.out + 67108864ull; const bf16_t* QD = (const bf16_t*)(P.ws + OFF_WIN); const bf16_t* KST = (const bf16_t*)(P.ws + OFF_ACT);
    const bf16_t* AA = (const bf16_t*)(P.ws + OFF_AA); const float* CD = (const float*)(P.ws + OFF_CD); bf16_t* O0 = (bf16_t*)(P.ws + OFF_R);
    constexpr int OPB = 57344, L_OB = 2 * OPB, OBB = 17408;
    const bool helper = wid >= 4;
    f32x16 S[4]; bf16x8 un[4];
#pragma unroll
    for (int mt = 0; mt < 4; ++mt) for (int r = 0; r < 16; ++r) S[mt][r] = 0.f;
    auto dma_chunk = [&](int cc, int buf) {
        const size_t ci = (size_t)bh * 64 + cc; const int hw = wid - 4;
#pragma unroll 1
        for (int i = 0; i < 14; ++i) { const int piece = hw * 14 + i;
            const bf16_t* src;
            if (piece < 16) src = NW + ci * 8192 + piece * 512; else if (piece < 32) src = QD + ci * 8192 + (piece - 16) * 512;
            else if (piece < 48) src = KST + ci * 8192 + (piece - 32) * 512; else src = AA + ci * 4096 + (piece - 48) * 512;
            dma16(src + lane * 8, lds + buf * OPB + piece * 1024); }
    };
    auto load_u = [&](int cc) {
        const size_t ci = (size_t)bh * 64 + cc;
#pragma unroll
        for (int mi = 0; mi < 2; ++mi) { const bf16_t* up = UU + ci * 8192 + (size_t)((mi * 4 + wid) * 64 + lane) * 16; un[2 * mi] = *(const bf16x8*)up; un[2 * mi + 1] = *(const bf16x8*)(up + 8); }
    };
    const bool dma_w = (wid == 4 || wid == 5), fin_w = wid >= 6;
    auto dma_chunk2 = [&](int cc, int buf) {
        const size_t ci = (size_t)bh * 64 + cc; ldsp_t dst = lds + buf * OPB;
        const bf16_t* s0 = NW + ci * 8192 + lane * 8; const bf16_t* s1 = QD + ci * 8192 + lane * 8; const bf16_t* s2 = KST + ci * 8192 + lane * 8; const bf16_t* s3 = AA + ci * 4096 + lane * 8;
        if (wid == 4) {
#pragma unroll 4
            for (int i = 0; i < 16; ++i) dma16(s0 + i * 512, dst + i * 1024);
#pragma unroll 4
            for (int i = 0; i < 12; ++i) dma16(s1 + i * 512, dst + 16384 + i * 1024);
        } else {
#pragma unroll 4
            for (int i = 12; i < 16; ++i) dma16(s1 + i * 512, dst + 16384 + i * 1024);
#pragma unroll 4
            for (int i = 0; i < 16; ++i) dma16(s2 + i * 512, dst + 32768 + i * 1024);
#pragma unroll 4
            for (int i = 0; i < 8; ++i) dma16(s3 + i * 512, dst + 49152 + i * 1024);
        }
    };
    const int ft = tid - 384;
    bf16x8 zreg[8];
    auto load_z = [&](int cc) {
#pragma unroll
        for (int ps = 0; ps < 8; ++ps) { const int unit = ps * 128 + ft, tok = unit >> 4, cg8 = (unit & 15) * 8;
            zreg[ps] = *(const bf16x8*)(H + (size_t)(b * SEQ + cc * 64 + tok) * 16384 + 12288 + h * 128 + cg8); }
    };
    float cdn = 0.f;
    if (dma_w) dma_chunk2(0, 0); else if (!fin_w) { load_u(0); cdn = CD[(size_t)bh * 64]; } else load_z(0);
    wait_vm0(); __syncthreads();
    if (dma_w) {
#pragma unroll 1
      for (int c = 0; c <= 64; ++c) {

            if (c + 1 < 64) dma_chunk2(c + 1, (c + 1) & 1);
            wait_vm0();
        asm volatile("s_waitcnt lgkmcnt(0)" ::: "memory"); __builtin_amdgcn_s_barrier(); asm volatile("" ::: "memory");
      }
    } else if (fin_w) {
#pragma unroll 1
      for (int c = 0; c <= 64; ++c) {

            if (c >= 1) {
                const int cp = c - 1; ldsp_t ob = lds + L_OB + (cp & 1) * OBB;
                const int cg8 = (ft & 15) * 8;
                const f32x4 w0 = *(const f32x4*)(P.a_norm_w + cg8), w1 = *(const f32x4*)(P.a_norm_w + cg8 + 4);
#pragma unroll
                for (int ps = 0; ps < 8; ++ps) { const int unit = ps * 128 + ft, tok = unit >> 4;
                  {
                    const bf16x8 ov = *(const LAS bf16x8*)(ob + (tok * 136 + cg8) * 2);
                    float o[8], ss = 0.f;
#pragma unroll
                    for (int e = 0; e < 8; ++e) { o[e] = bf2f((unsigned short)ov[e]); ss += o[e] * o[e]; }
                    ss = sum16(ss);
                    const float rs = rsqrtf(ss * (1.f / 128.f) + 1e-6f);
                    const size_t trow = (size_t)(b * SEQ + cp * 64 + tok);
                    const bf16x8 zv = zreg[ps];
                    float r[8];
#pragma unroll
                    for (int e = 0; e < 8; ++e) r[e] = o[e] * rs * (e < 4 ? w0[e & 3] : w1[e & 3]) * bf2f((unsigned short)zv[e]);
                    *(bf16x8*)(O0 + trow * 4096 + h * 128 + cg8) = pack8(r[0], r[1], r[2], r[3], r[4], r[5], r[6], r[7]);
                  }
                }
            }
            if (c < 64) load_z(c);
        asm volatile("s_waitcnt lgkmcnt(0)" ::: "memory"); __builtin_amdgcn_s_barrier(); asm volatile("" ::: "memory");
      }
    } else {
      __builtin_amdgcn_s_setprio(3);
#pragma unroll 1
      for (int c = 0; c <= 64; ++c) {
        if (c < 64) {

            ldsp_t op = lds + (c & 1) * OPB + lane * 16;
            const float cd = cdn;
            f32x16 v0 = unpack16(un[0], un[1]), v1 = unpack16(un[2], un[3]);
            bf16x8 Sb[8];
#pragma unroll
            for (int mt = 0; mt < 4; ++mt) { Sb[2 * mt] = pack8v(S[mt], 0); Sb[2 * mt + 1] = pack8v(S[mt], 1); }
            f32x16 o0, o1; for (int r = 0; r < 16; ++r) { o0[r] = 0.f; o1[r] = 0.f; }
#define SB0 __builtin_amdgcn_sched_barrier(0)
            SB0;
#pragma unroll
            for (int g = 0; g < 8; ++g) {
#pragma unroll
                for (int k2 = 0; k2 < 1; ++k2) { const int ks = g;
                    v0 = MFMA32(lds8(op + ks * 1024), Sb[ks], v0); v1 = MFMA32(lds8(op + (8 + ks) * 1024), Sb[ks], v1);
                    o0 = MFMA32(lds8(op + 16384 + ks * 1024), Sb[ks], o0); o1 = MFMA32(lds8(op + 16384 + (8 + ks) * 1024), Sb[ks], o1); }
                SB0; }
            bf16x8 Vb[4]; Vb[0] = pack8v(v0, 0); Vb[1] = pack8v(v0, 1); Vb[2] = pack8v(v1, 0); Vb[3] = pack8v(v1, 1);
            SB0;
            if (c + 1 < 64) { load_u(c + 1); cdn = CD[(size_t)bh * 64 + c + 1]; }
#pragma unroll
            for (int mt = 0; mt < 4; ++mt) S[mt] = S[mt] * cd;
#pragma unroll
            for (int g = 0; g < 4; ++g) {
#pragma unroll
                for (int k2 = 0; k2 < 1; ++k2) { const int ks = g;
                    o0 = MFMA32(lds8(op + 49152 + ks * 1024), Vb[ks], o0); o1 = MFMA32(lds8(op + 49152 + (4 + ks) * 1024), Vb[ks], o1);
#pragma unroll
                    for (int mt = 0; mt < 4; ++mt) S[mt] = MFMA32(lds8(op + 32768 + (mt * 4 + ks) * 1024), Vb[ks], S[mt]); }
                SB0; }
            LAS bf16_t* ob = (LAS bf16_t*)(lds + L_OB + (c & 1) * OBB);
#pragma unroll
            for (int r = 0; r < 16; ++r) { ob[crow(r, hi) * 136 + wid * 32 + c32] = f2bf(o0[r]); ob[(32 + crow(r, hi)) * 136 + wid * 32 + c32] = f2bf(o1[r]); }
                }
        asm volatile("s_waitcnt lgkmcnt(0)" ::: "memory"); __builtin_amdgcn_s_barrier(); asm volatile("" ::: "memory");
      }
      __builtin_amdgcn_s_setprio(0);
    }
}

DI void vt_phase(const Params& P, ldsp_t lds) {
    const int tid = threadIdx.x; const bf16_t* H = (const bf16_t*)(P.ws + OFF_H); bf16_t* VTg = (bf16_t*)(P.ws + OFF_R);
    LAS bf16_t* T = (LAS bf16_t*)lds;
    for (int item = blockIdx.x; item < 2048; item += gridDim.x) {
        const int bh = item >> 5, tb = item & 31, b = bh >> 4, h = bh & 15;
#pragma unroll
        for (int ps = 0; ps < 8; ++ps) { const int tok = ps * 16 + (tid >> 5), dg = (tid & 31) * 8;
            const bf16x8 v = *(const bf16x8*)(H + (size_t)(b * SEQ + tb * 128 + tok) * 16384 + 8192 + h * 256 + dg);
            const int o = tok & 15, pos = (tok & ~15) | (o & 3) | ((o & 4) << 1) | ((o & 8) >> 1);
#pragma unroll
            for (int e = 0; e < 8; ++e) T[(dg + e) * 136 + (pos ^ ((tid & 15) << 3))] = (bf16_t)v[e]; }
        __syncthreads();
#pragma unroll
        for (int ps = 0; ps < 8; ++ps) { const int dv = ps * 32 + (tid >> 4), tc = (tid & 15) * 8;
            *(bf16x8*)(VTg + ((size_t)bh * 256 + dv) * SEQ + tb * 128 + tc) = *(const LAS bf16x8*)(T + dv * 136 + (tc ^ (((dv >> 3) & 15) << 3))); }
        __syncthreads();
    }
}

constexpr int AT_KBUF = 32768  , AT_VOFF = 65536, AT_VBUF = 32768  , AT_BT = 131072, AT_OF_STRIDE = 257;
DI void attn_block(const Params& P, ldsp_t lds, int bh, int qb, float lam) {
    int tid_o = threadIdx.x; asm volatile("" : "+v"(tid_o));
    const int tid = tid_o, wid = __builtin_amdgcn_readfirstlane(tid >> 6), lane = tid & 63, c32 = lane & 31, hi = lane >> 5;
    const int b = bh >> 4, h = bh & 15, q0 = qb * 128, nt = 2 * qb + 2, p = wid >> 2, wsub = wid & 3;
    const bf16_t* H = (const bf16_t*)(P.ws + OFF_H); const bf16_t* VTg = (const bf16_t*)(P.ws + OFF_R); bf16_t* O1 = (bf16_t*)(P.ws + OFF_ACT);
    const float* BTg = (const float*)(P.ws + OFF_BT);
    LAS float* BTs = (LAS float*)(lds + AT_BT);
    if (tid < 256) BTs[tid] = BTg[h * 256 + tid];
    const int qmin = q0 + 32 * wsub, qrow = qmin + c32, qmax = qmin + 31;
    bf16x8 Qf[8];
    { const bf16_t* qp = H + (size_t)(b * SEQ + qrow) * 16384 + h * 256 + p * 128 + 8 * hi;
#pragma unroll
      for (int ks = 0; ks < 8; ++ks) Qf[ks] = *(const bf16x8*)(qp + 16 * ks); }
    const char* kbase = (const char*)(H + (size_t)(b * SEQ) * 16384 + 4096 + h * 256);
    const char* vbase = (const char*)(VTg + (size_t)bh * 256 * SEQ);
    const unsigned kvo = (unsigned)(lane >> 4) * 32768u + (unsigned)(((lane & 15) ^ (lane >> 4)) * 16);
    const unsigned vvo = (unsigned)(lane >> 3) * (SEQ * 2) + (unsigned)(((lane & 7) ^ ((lane >> 3) & 7)) * 16);
    auto load_tile = [&](int kt, int buf) {
        const int k0 = kt * 64;
#pragma unroll
        for (int i = 0; i < 4; ++i) { const int blk = wid * 4 + i, pp = blk >> 4, key0 = 4 * (blk & 15);
            const unsigned lo = (unsigned)(lane >> 4) * 32768u + (unsigned)(((lane & 15) ^ (4 * i + (lane >> 4))) * 16);
            dma16(kbase + ((size_t)(k0 + key0) * 32768 + pp * 256) + lo, lds + buf * AT_KBUF + blk * 1024); }
#pragma unroll
        for (int i = 0; i < 4; ++i) { const int blk = wid * 4 + i;
            const unsigned vo = (unsigned)(lane >> 3) * (SEQ * 2) + (unsigned)(((lane & 7) ^ (4 * (i & 1) + (lane >> 4))) * 16);
            dma16(vbase + ((size_t)(8 * blk) * (SEQ * 2) + k0 * 2) + vo, lds + AT_VOFF + buf * AT_VBUF + blk * 1024); }
    };
    f32x16 O[8];
#pragma unroll
    for (int dt = 0; dt < 8; ++dt) for (int r = 0; r < 16; ++r) O[dt][r] = 0.f;
    float mrun = -1e30f, lrun = 0.f;
    constexpr float CS = 0.08838834764831845f * LOG2E;
    load_tile(0, 0);
    wait_vm0(); __syncthreads();
#pragma unroll 1
    for (int kt = 0; kt < nt; ++kt) {
        const int buf = kt & 1, k0 = kt * 64;
        if (kt + 1 < nt) load_tile(kt + 1, buf ^ 1);
        if (k0 <= qmax) {
            ldsp_t kb = lds + buf * AT_KBUF + p * 16384 + c32 * 256;
            ldsp_t vb = lds + AT_VOFF + buf * AT_VBUF + c32 * 128;
            const int swk = c32 & 15, swv = (c32 >> 1) & 7;
#pragma unroll
            for (int half = 0; half < 2; ++half) {
                const int kh0 = k0 + 32 * half;
                if (kh0 <= qmax) {
                    f32x16 Sx; for (int r = 0; r < 16; ++r) Sx[r] = 0.f;
                    SB0;
#pragma unroll
                    for (int g = 0; g < 2; ++g) {
#pragma unroll
                        for (int k4 = 0; k4 < 4; ++k4) { const int ks = 4 * g + k4;
                            Sx = MFMA32(lds8(kb + 32 * half * 256 + (((2 * ks + hi) ^ swk) << 4)), Qf[ks], Sx); }
                        SB0; }
                    const bool nearb = (qmin - (kh0 + 31)) < 128;
                    if (!nearb) { const float cb = BTs[255];
#pragma unroll
                        for (int r = 0; r < 16; ++r) Sx[r] = Sx[r] * CS + cb;
                    } else {
#pragma unroll
                        for (int r = 0; r < 16; ++r) { const int rel = qrow - (kh0 + crow(r, hi));
                            const float bb = BTs[min(max(rel, 0), 255)];
                            Sx[r] = rel >= 0 ? Sx[r] * CS + bb : -__builtin_inff();
                            if ((r & 3) == 3) SB0; }
                    }
                    float tmax = Sx[0];
#pragma unroll
                    for (int r = 1; r < 16; ++r) tmax = fmaxf(tmax, Sx[r]);
                    { auto rr = __builtin_amdgcn_permlane32_swap(__float_as_uint(tmax), __float_as_uint(tmax), false, false);
                      tmax = fmaxf(__uint_as_float(rr[0]), __uint_as_float(rr[1])); }
                    if (__any(tmax > mrun + 8.f)) {
                        const float mn = fmaxf(mrun, tmax), alpha = __builtin_amdgcn_exp2f(mrun - mn); mrun = mn; lrun *= alpha;
#pragma unroll
                        for (int dt = 0; dt < 8; ++dt) O[dt] = O[dt] * alpha;
                    }
                    float ls = 0.f;
#pragma unroll
                    for (int r = 0; r < 16; ++r) { Sx[r] = __builtin_amdgcn_exp2f(Sx[r] - mrun); ls += Sx[r]; }
                    lrun += ls;
                    bf16x8 Pf[2]; Pf[0] = pack8v(Sx, 0); Pf[1] = pack8v(Sx, 1);
                    SB0;
#pragma unroll
                    for (int d2 = 0; d2 < 2; ++d2) {
#pragma unroll
                        for (int dd = 0; dd < 4; ++dd) { const int dt = 4 * d2 + dd;
#pragma unroll
                            for (int hb = 0; hb < 2; ++hb)
                                O[dt] = MFMA32(lds8(vb + 32 * dt * 128 + (((2 * (2 * half + hb) + hi) ^ swv) << 4)), Pf[hb], O[dt]); }
                        SB0; }
                }
            }
        }
        wait_vm0(); __syncthreads();
    }
    int tid_e = threadIdx.x; asm volatile("" : "+v"(tid_e));
    const int lane_e = tid_e & 63, c32e = lane_e & 31, hie = lane_e >> 5;
    LAS float* Of = (LAS float*)lds;
    const float ltot = lrun + __shfl_xor(lrun, 32), inv = 1.f / ltot;
    const int ql = 32 * wsub + c32e;
    if (p == 1) { const float sc = -lam * inv;
#pragma unroll
        for (int dt = 0; dt < 8; ++dt)
#pragma unroll
            for (int r = 0; r < 16; ++r) Of[ql * AT_OF_STRIDE + 32 * dt + crow(r, hie)] = O[dt][r] * sc; }
    __syncthreads();
    if (p == 0) { float ssq = 0.f;
#pragma unroll
        for (int dt = 0; dt < 8; ++dt)
            {
#pragma unroll
                for (int r = 0; r < 16; ++r) { const float o = O[dt][r] * inv + Of[ql * AT_OF_STRIDE + 32 * dt + crow(r, hie)]; O[dt][r] = o; ssq = __builtin_fmaf(o, o, ssq); }
                SB0; }
        ssq += __shfl_xor(ssq, 32);
        const float rstd = rsqrtf(ssq * (1.f / 256.f) + 1e-5f) * (1.f - LAM_INIT);
#pragma unroll
        for (int dt = 0; dt < 8; ++dt)
#pragma unroll
            for (int r = 0; r < 16; ++r) Of[ql * AT_OF_STRIDE + 32 * dt + crow(r, hie)] = O[dt][r] * rstd; }
    __syncthreads();
#pragma unroll 1
    for (int i = 0; i < 8; ++i) { const int id = tid_e + 512 * i, q = id >> 5, dg = (id & 31) * 8; const size_t trow = (size_t)(b * SEQ + q0 + q);
        const bf16x8 zv = *(const bf16x8*)(H + trow * 16384 + 12288 + h * 256 + dg);
        const f32x4 w0 = *(const f32x4*)(P.subln_w + dg), w1 = *(const f32x4*)(P.subln_w + dg + 4);
        float r[8];
#pragma unroll
        for (int e = 0; e < 8; ++e) r[e] = Of[q * AT_OF_STRIDE + dg + e] * (e < 4 ? w0[e & 3] : w1[e & 3]) * bf2f((unsigned short)zv[e]);
        *(bf16x8*)(O1 + trow * 4096 + h * 256 + dg) = pack8(r[0], r[1], r[2], r[3], r[4], r[5], r[6], r[7]); }
    __syncthreads();
}
DI void attn_phase(const Params& P, ldsp_t lds) {
    const int lane = threadIdx.x & 63;
    float s1 = P.lq1[lane] * P.lk1[lane] + P.lq1[lane + 64] * P.lk1[lane + 64], s2 = P.lq2[lane] * P.lk2[lane] + P.lq2[lane + 64] * P.lk2[lane + 64];
    s1 = wsum(s1); s2 = wsum(s2);
    const float lam = __int_as_float(__builtin_amdgcn_readfirstlane(__float_as_int(expf(s1) - expf(s2) + LAM_INIT)));
    for (int idx = blockIdx.x; idx < 1024; idx += gridDim.x) { const int bh = idx >> 4, j = idx & 15;
#pragma unroll 1
        for (int sub = 0; sub < 2; ++sub) attn_block(P, lds, bh, sub ? 31 - j : j, lam); }
}

typedef const __attribute__((address_space(4))) Params* kparams_t;
DI Params kparams() { kparams_t p = (kparams_t)__builtin_amdgcn_kernarg_segment_ptr(); asm volatile("" : "+s"(p)); const Params* g = (const Params*)p; return *g; }
DI void gbar(unsigned* ctr, unsigned target) {
    __syncthreads();
    if (threadIdx.x == 0) {
        __builtin_amdgcn_fence(__ATOMIC_RELEASE, "agent");
        __hip_atomic_fetch_add(ctr, 1u, __ATOMIC_RELAXED, __HIP_MEMORY_SCOPE_AGENT);
        while (__hip_atomic_load(ctr, __ATOMIC_RELAXED, __HIP_MEMORY_SCOPE_AGENT) < target) __builtin_amdgcn_s_sleep(1);
    }
    __syncthreads();
    __builtin_amdgcn_fence(__ATOMIC_ACQUIRE, "agent");
    asm volatile("s_waitcnt vmcnt(0)" ::: "memory");
}
__global__ void __launch_bounds__(512) fwd_megakernel(Params P) {
    extern __shared__ __attribute__((aligned(16))) unsigned char shm[];
    ldsp_t lds = (ldsp_t)shm;
    cg::grid_group grid = cg::this_grid();
    const int ph_lo = P.ph_lo, ph_hi = P.ph_hi;
    unsigned* bar = (unsigned*)(P.ws + OFF_BAR); int nbar = 0;
#ifdef EXTRA_SYNC
    for (int es = 0; es < EXTRA_SYNC; ++es) grid.sync();
#endif
#ifndef PH_MASK
#define PH_MASK 0x7ff
#endif
#define PH_ON(n) (((PH_MASK) >> (n)) & 1)
#ifndef REP_MASK
#define REP_MASK 0
#endif
#define REP_N(n) ((((REP_MASK) >> (n)) & 1) ? 2 : 1)
    if (PH_ON(0) && ph_lo <= 0 && 0 < ph_hi) { if (0 > ph_lo) gbar(bar, (unsigned)(++nbar) * gridDim.x);
        const Params Pl = kparams(); unsigned char* ws = Pl.ws;
        for (int rep = 0; rep < REP_N(0); ++rep)
        {
            cvt_rows(Pl.x, (bf16_t*)(ws + OFF_ACT), (size_t)NTOK * DM / 8);
            transpose_w(Pl.a_w_in, 16448, 16640, (bf16_t*)(ws + OFF_WIN), lds);
            transpose_w(Pl.a_w_out, 4096, 4096, (bf16_t*)(ws + OFF_WOUT), lds);
            bias_table(Pl.rel_bias, (float*)(ws + OFF_BT));
        }
    }
    if (PH_ON(1) && ph_lo <= 1 && 1 < ph_hi) { if (1 > ph_lo) grid.sync();
        const Params Pl = kparams(); unsigned char* ws = Pl.ws;
        for (int rep = 0; rep < REP_N(1); ++rep)
        { pg8::Gemm g{(const bf16_t*)(ws + OFF_ACT), (const bf16_t*)(ws + OFF_WIN), NTOK, 16640, 4096};
            pg8::StaticOrder S; S.init(g.M, g.N, (int)gridDim.x, (int)blockIdx.x); EpiH E{(bf16_t*)(ws + OFF_H), (float*)(ws + OFF_AB)};
            pg8::gemm_phase<EpiH, pg8::StaticOrder, false>(lds, g, S, E, nullptr); }
    }
    if (PH_ON(2) && ph_lo <= 2 && 2 < ph_hi) { if (2 > ph_lo) gbar(bar, (unsigned)(++nbar) * gridDim.x);
        const Params Pl = kparams(); unsigned char* ws = Pl.ws;
        for (int rep = 0; rep < REP_N(2); ++rep)
        p2a_phase(Pl, lds);
    }
    if (PH_ON(3) && ph_lo <= 3 && 3 < ph_hi) { if (3 > ph_lo) gbar(bar, (unsigned)(++nbar) * gridDim.x);
        const Params Pl = kparams(); unsigned char* ws = Pl.ws;
        for (int rep = 0; rep < REP_N(3); ++rep)
        scan_phase(Pl, lds);
    }
    if (PH_ON(4) && ph_lo <= 4 && 4 < ph_hi) { if (4 > ph_lo) gbar(bar, (unsigned)(++nbar) * gridDim.x);
        const Params Pl = kparams(); unsigned char* ws = Pl.ws;
        for (int rep = 0; rep < REP_N(4); ++rep)
        { pg8::Gemm g{(const bf16_t*)(ws + OFF_R), (const bf16_t*)(ws + OFF_WOUT), NTOK, 4096, 4096};
            pg8::StaticOrder S; S.init(g.M, g.N, (int)gridDim.x, (int)blockIdx.x); EpiRes E{Pl.x, Pl.out};
            pg8::gemm_phase<EpiRes, pg8::StaticOrder, false>(lds, g, S, E, nullptr); }
    }
    if (PH_ON(5) && ph_lo <= 5 && 5 < ph_hi) { if (5 > ph_lo) gbar(bar, (unsigned)(++nbar) * gridDim.x);
        const Params Pl = kparams(); unsigned char* ws = Pl.ws;
        for (int rep = 0; rep < REP_N(5); ++rep)
        {
            ln_phase(Pl.out, Pl.ln_g, Pl.ln_b, (bf16_t*)(ws + OFF_ACT));
            transpose_w(Pl.b_w_in, 16384, 16384, (bf16_t*)(ws + OFF_WIN), lds);
            transpose_w(Pl.b_w_out, 4096, 4096, (bf16_t*)(ws + OFF_WOUT), lds);
        }
    }
    if (PH_ON(6) && ph_lo <= 6 && 6 < ph_hi) { if (6 > ph_lo) gbar(bar, (unsigned)(++nbar) * gridDim.x);
        const Params Pl = kparams(); unsigned char* ws = Pl.ws;
        for (int rep = 0; rep < REP_N(6); ++rep)
        { pg8::Gemm g{(const bf16_t*)(ws + OFF_ACT), (const bf16_t*)(ws + OFF_WIN), NTOK, 16384, 4096};
            pg8::StaticOrder S; S.init(g.M, g.N, (int)gridDim.x, (int)blockIdx.x); EpiH E{(bf16_t*)(ws + OFF_H), (float*)(ws + OFF_AB)};
            pg8::gemm_phase<EpiH, pg8::StaticOrder, false>(lds, g, S, E, nullptr); }
    }
    if (PH_ON(7) && ph_lo <= 7 && 7 < ph_hi) { if (7 > ph_lo) gbar(bar, (unsigned)(++nbar) * gridDim.x);
        const Params Pl = kparams(); unsigned char* ws = Pl.ws;
        for (int rep = 0; rep < REP_N(7); ++rep)
        vt_phase(Pl, lds);
    }
    if (PH_ON(8) && ph_lo <= 8 && 8 < ph_hi) { if (8 > ph_lo) gbar(bar, (unsigned)(++nbar) * gridDim.x);
        const Params Pl = kparams(); unsigned char* ws = Pl.ws;
        for (int rep = 0; rep < REP_N(8); ++rep)
        attn_phase(Pl, lds);
    }
    if (PH_ON(9) && ph_lo <= 9 && 9 < ph_hi) { if (9 > ph_lo) gbar(bar, (unsigned)(++nbar) * gridDim.x);
        const Params Pl = kparams(); unsigned char* ws = Pl.ws;
        for (int rep = 0; rep < REP_N(9); ++rep)
        { pg8::Gemm g{(const bf16_t*)(ws + OFF_ACT), (const bf16_t*)(ws + OFF_WOUT), NTOK, 4096, 4096};
            pg8::StaticOrder S; S.init(g.M, g.N, (int)gridDim.x, (int)blockIdx.x); EpiRes E{Pl.out, Pl.out};
            pg8::gemm_phase<EpiRes, pg8::StaticOrder, false>(lds, g, S, E, nullptr); }
    }
    if (PH_ON(10) && ph_lo <= 10 && 10 < ph_hi) { if (10 > ph_lo) gbar(bar, (unsigned)(++nbar) * gridDim.x);
        const Params Pl = kparams(); unsigned char* ws = Pl.ws;
        for (int rep = 0; rep < REP_N(10); ++rep)
        ln_phase(Pl.out, Pl.ln_g + DM, Pl.ln_b + DM, nullptr);
    }
}

#ifndef N_LAUNCH_MODE
#define N_LAUNCH_MODE 0
#endif
extern "C" void kernel_launch(void* const* d_in, const int* in_sizes, int n_in, void* d_out, int out_size, void* d_ws, size_t ws_size, hipStream_t stream) {
    static int grid_blocks = 0;
    if (!grid_blocks) {
        int dev = 0, cus = 0, per_cu = 0;
        hipGetDevice(&dev);
        hipDeviceGetAttribute(&cus, hipDeviceAttributeMultiprocessorCount, dev);
        hipFuncSetAttribute((const void*)fwd_megakernel, hipFuncAttributeMaxDynamicSharedMemorySize, LDS_BYTES);
        hipOccupancyMaxActiveBlocksPerMultiprocessor(&per_cu, fwd_megakernel, 512, LDS_BYTES);
        if (per_cu < 1) per_cu = 1;
        grid_blocks = cus * per_cu; if (grid_blocks > 256) grid_blocks = 256;
    }
    if (ws_size < WS_NEED) { fprintf(stderr, "workspace too small: %zu < %zu\n", ws_size, (size_t)WS_NEED); return; }
    Params p{};
    p.x = (const float*)d_in[0]; p.ln_g = (const float*)d_in[1]; p.ln_b = (const float*)d_in[2]; p.rel_bias = (const float*)d_in[3];
    p.a_w_in = (const float*)d_in[4]; p.a_conv_w = (const float*)d_in[5]; p.a_a_log = (const float*)d_in[6]; p.a_dt_bias = (const float*)d_in[7];
    p.a_norm_w = (const float*)d_in[8]; p.a_w_out = (const float*)d_in[9]; p.b_w_in = (const float*)d_in[10];
    p.lq1 = (const float*)d_in[11]; p.lk1 = (const float*)d_in[12]; p.lq2 = (const float*)d_in[13]; p.lk2 = (const float*)d_in[14];
    p.subln_w = (const float*)d_in[15]; p.b_w_out = (const float*)d_in[16];
    p.out = (float*)d_out; p.ws = (unsigned char*)d_ws;
#if N_LAUNCH_MODE == 0
    p.ph_lo = 0; p.ph_hi = 11;
    hipMemsetAsync((unsigned char*)d_ws + OFF_BAR, 0, 256, stream);
    void* args[] = {&p};
    hipError_t e = hipLaunchCooperativeKernel((const void*)fwd_megakernel, dim3(grid_blocks), dim3(512), args, LDS_BYTES, stream);
    if (e != hipSuccess) fprintf(stderr, "cooperative launch failed: %s (grid %d)\n", hipGetErrorString(e), grid_blocks);
#else
    for (int ph = 0; ph < 11; ++ph) { p.ph_lo = ph; p.ph_hi = ph + 1;
        hipLaunchKernelGGL(fwd_megakernel, dim3(grid_blocks), dim3(512), LDS_BYTES, stream, p); }
#endif
}
```

```cpp
#include <hip/hip_runtime.h>
#include <hip/hip_cooperative_groups.h>
#include <cstdio>
#include <cstdint>
namespace cg = cooperative_groups;
namespace pg8 {
#define PG8_LAS __attribute__((address_space(3)))
typedef unsigned short bf16_t;
typedef short bf16x8 __attribute__((ext_vector_type(8)));
typedef float f32x4 __attribute__((ext_vector_type(4)));
typedef unsigned u32x4 __attribute__((ext_vector_type(4)));
constexpr int BM = 256, BK = 64, HALF = 128, HTB = HALF * BK * 2  , STAGE_BYTES = 8 * HTB, NXCD = 8, WGM = 8;

__host__ __device__ __forceinline__ int lds_byte(int r, int c) { const int st = (r >> 4) * 2 + (c >> 5), rr = r & 15, cc = c & 31, ob = rr * 64 + cc * 2; return st * 1024 + (ob ^ (((ob >> 9) & 1) << 5)); }
__host__ __device__ __forceinline__ void stage_rc(int b, int& R, int& C) { const int st = b / 1024, sb = b % 1024, swz = sb ^ (((sb >> 9) & 1) << 5); R = (st >> 1) * 16 + swz / 64; C = (st & 1) * 32 + (swz % 64) / 2; }
__host__ __device__ __forceinline__ int perm32(int rho) { const int n = rho >> 4, i = rho & 15; return 8 * (i >> 2) + 4 * n + (i & 3); }

struct Unit { int pm, pn; };
struct Gemm { const bf16_t* A; const bf16_t* Bt; int M, N, K; };

struct StaticOrder {
    int nM, nN, nwg, G, c;
    __host__ __device__ void init(int M, int N, int G_, int c_) { nM = M / BM; nN = N / BM; nwg = nM * nN; G = G_; c = c_; }
    __host__ __device__ bool next(int i, Unit& u) const {
        const long L = (long)i * G + c; if (L >= nwg) return false;
        int wgid = (int)L; { const int q = nwg / NXCD, r = nwg % NXCD, xcd = wgid % NXCD, off = wgid / NXCD; wgid = (xcd < r ? xcd * (q + 1) : r * (q + 1) + (xcd - r) * q) + off; }
        const int nig = WGM * nN, gid = wgid / nig, fm = gid * WGM, gsz = (nM - fm) < WGM ? (nM - fm) : WGM;
        u.pm = fm + ((wgid % nig) % gsz); u.pn = (wgid % nig) / gsz; return true;
    }
    __device__ __forceinline__ void a_ready(const Unit&) const {}
    __device__ __forceinline__ void done(const Unit&) const {}
};

template <class Epi, class Sched, bool STAMP = false>
__device__ __forceinline__ void gemm_phase(PG8_LAS unsigned char* lds, const Gemm g, const Sched& S, const Epi& E, unsigned long long* stamps) {
    const int tid = threadIdx.x, wid = __builtin_amdgcn_readfirstlane(tid >> 6), lane = tid & 63, wr = wid >> 2, wc = wid & 3, fr = lane & 15, fq = lane >> 4;
    const int K = g.K, nt = K / BK;
    int ts_lo = 0, ts_hi = 0, nts = 0; const unsigned long long rt_entry = STAMP ? (unsigned long long)wall_clock64() : 0ull;
#define PG8_STAMP() do { if (STAMP && wid == 0 && nts < 64) { const unsigned long long _c = (unsigned long long)clock64(); \
        ts_lo = (lane == nts) ? (int)(unsigned)_c : ts_lo; ts_hi = (lane == nts) ? (int)(unsigned)(_c >> 32) : ts_hi; ++nts; } } while (0)
    PG8_STAMP();
    unsigned voffA[2], voffB[2];
#pragma unroll
    for (int i = 0; i < 2; ++i) { int R, C; stage_rc(tid * 16 + i * 8192, R, C); const int Rb = Epi::PERM ? ((R & ~31) + perm32(R & 31)) : R;
        voffA[i] = (unsigned)(R * K + C) * 2u; voffB[i] = (unsigned)(Rb * K + C) * 2u; }
    const size_t kstep = (size_t)(BK * 2);
    const size_t hstep = (size_t)HALF * K * 2;
    const size_t tstep = 2 * hstep;
    const unsigned ldsw = (unsigned)wid * 1024u;
    const int aoff = lds_byte(wr * 64 + fr, fq * 8), boff = lds_byte(wc * 32 + fr, fq * 8);
#define PG8_SA(b, h) (((b) * 2 + (h)) * HTB)
#define PG8_SB(b, h) ((4 + (b) * 2 + (h)) * HTB)
#define PG8_STAGE(bufoff, gbase, voff) do { _Pragma("unroll") for (int _i = 0; _i < 2; ++_i) \
        __builtin_amdgcn_global_load_lds((const unsigned*)((const char*)(gbase) + (voff)[_i]), (PG8_LAS unsigned*)(lds + (bufoff) + ldsw + _i * 8192), 16, 0, 0); } while (0)
#define PG8_LDA(dst, b, h) do { _Pragma("unroll") for (int m = 0; m < 4; ++m) _Pragma("unroll") for (int k = 0; k < 2; ++k) dst[m][k] = *(const PG8_LAS bf16x8*)(lds + PG8_SA(b, h) + aoff + m * 2048 + k * 1024); } while (0)
#define PG8_LDB(dst, b, h) do { _Pragma("unroll") for (int n = 0; n < 2; ++n) _Pragma("unroll") for (int k = 0; k < 2; ++k) dst[n][k] = *(const PG8_LAS bf16x8*)(lds + PG8_SB(b, h) + boff + n * 2048 + k * 1024); } while (0)
#define PG8_MMA(ai, bj, At, Bt) do { __builtin_amdgcn_s_setprio(1); _Pragma("unroll") for (int m = 0; m < 4; ++m) _Pragma("unroll") for (int n = 0; n < 2; ++n) _Pragma("unroll") for (int k = 0; k < 2; ++k) \
        acc[ai][bj][m][n] = __builtin_amdgcn_mfma_f32_16x16x32_bf16(Bt[n][k], At[m][k], acc[ai][bj][m][n], 0, 0, 0); __builtin_amdgcn_s_setprio(0); } while (0)
#define PG8_WAIT_V(n) asm volatile("s_waitcnt vmcnt(" #n ")" ::: "memory")
#define PG8_WAIT_L(n) asm volatile("s_waitcnt lgkmcnt(" #n ")" ::: "memory")
#define PG8_BAR __builtin_amdgcn_s_barrier()
#define PG8_SCHED __builtin_amdgcn_sched_barrier(0)
    Unit cur, nxt; int ui = 0;
    if (!S.next(0, cur)) return;
    f32x4 acc[2][2][4][2];
#pragma unroll
    for (int a = 0; a < 2; ++a)
#pragma unroll
        for (int b = 0; b < 2; ++b)
#pragma unroll
            for (int m = 0; m < 4; ++m)
#pragma unroll
                for (int n = 0; n < 2; ++n) acc[a][b][m][n] = (f32x4){0.f, 0.f, 0.f, 0.f};
    bf16x8 At[4][2], B0[2][2], B1[2][2];
    const char* cA = (const char*)g.A + (size_t)cur.pm * tstep; const char* cB = (const char*)g.Bt + (size_t)cur.pn * tstep;
    S.a_ready(cur);
    PG8_STAGE(PG8_SB(0, 0), cB, voffB); PG8_STAGE(PG8_SA(0, 0), cA, voffA); PG8_STAGE(PG8_SB(0, 1), cB + hstep, voffB); PG8_STAGE(PG8_SA(0, 1), cA + hstep, voffA);
    if (wr == 1) PG8_BAR;
    PG8_WAIT_V(4); PG8_BAR;
    PG8_STAGE(PG8_SB(1, 0), cB + kstep, voffB); PG8_STAGE(PG8_SA(1, 0), cA + kstep, voffA); PG8_STAGE(PG8_SB(1, 1), cB + hstep + kstep, voffB);
    PG8_WAIT_V(6); PG8_BAR;
    PG8_STAMP();
    for (;;) {
        const bool has_next = S.next(ui + 1, nxt);
        const char* nA = has_next ? (const char*)g.A + (size_t)nxt.pm * tstep : cA; const char* nB = has_next ? (const char*)g.Bt + (size_t)nxt.pn * tstep : cB;
        for (int t = 0; t < nt; t += 2) {
            const bool last = (t == nt - 2);
            const char* a1 = cA + (size_t)(t + 1) * kstep;
            const char* a2 = last ? nA : cA + (size_t)(t + 2) * kstep; const char* b2 = last ? nB : cB + (size_t)(t + 2) * kstep;
            const char* a3 = a2 + kstep; const char* b3 = b2 + kstep;
            if (last && has_next) S.a_ready(nxt);
            PG8_LDB(B0, 0, 0); PG8_SCHED; PG8_LDA(At, 0, 0); PG8_STAGE(PG8_SA(1, 1), a1 + hstep, voffA);
            PG8_WAIT_L(8); PG8_BAR; PG8_WAIT_L(0); PG8_MMA(0, 0, At, B0); PG8_BAR; PG8_SCHED;
            PG8_LDB(B1, 0, 1); PG8_STAGE(PG8_SB(0, 0), b2, voffB);
            PG8_BAR; PG8_WAIT_L(0); PG8_MMA(0, 1, At, B1); PG8_BAR;
            PG8_LDA(At, 0, 1); PG8_STAGE(PG8_SA(0, 0), a2, voffA);
            PG8_BAR; PG8_WAIT_L(0); PG8_MMA(1, 0, At, B0); PG8_BAR; PG8_SCHED;
            PG8_STAGE(PG8_SB(0, 1), b2 + hstep, voffB);
            PG8_WAIT_V(6); PG8_BAR; PG8_MMA(1, 1, At, B1); PG8_BAR;
            PG8_LDB(B0, 1, 0); PG8_SCHED; PG8_LDA(At, 1, 0); PG8_STAGE(PG8_SA(0, 1), a2 + hstep, voffA);
            PG8_WAIT_L(8); PG8_BAR; PG8_WAIT_L(0); PG8_MMA(0, 0, At, B0); PG8_BAR; PG8_SCHED;
            PG8_LDB(B1, 1, 1); PG8_STAGE(PG8_SB(1, 0), b3, voffB);
            PG8_BAR; PG8_WAIT_L(0); PG8_MMA(0, 1, At, B1); PG8_BAR;
            PG8_LDA(At, 1, 1); PG8_STAGE(PG8_SA(1, 0), a3, voffA);
            PG8_BAR; PG8_WAIT_L(0); PG8_MMA(1, 0, At, B0); PG8_BAR; PG8_SCHED;
            PG8_STAGE(PG8_SB(1, 1), b3 + hstep, voffB);
            PG8_WAIT_V(6); PG8_BAR; PG8_MMA(1, 1, At, B1); PG8_BAR;
        }
        PG8_STAMP();
        if constexpr (!Epi::AFTER_DRAIN) { E(acc, cur, wr, wc, fr, fq); S.done(cur); }
        PG8_STAMP();
        if (!has_next) break;
#pragma unroll
        for (int a = 0; a < 2; ++a)
#pragma unroll
            for (int b = 0; b < 2; ++b)
#pragma unroll
                for (int m = 0; m < 4; ++m)
#pragma unroll
                    for (int n = 0; n < 2; ++n) acc[a][b][m][n] = (f32x4){0.f, 0.f, 0.f, 0.f};
        cur = nxt; cA = nA; cB = nB; ++ui;
    }
    PG8_WAIT_V(0);
    if (wr == 0) PG8_BAR;
    PG8_BAR;
    if constexpr (Epi::AFTER_DRAIN) { E.fused(acc, cur, wr, wc, fr, fq, lds, wid, lane); S.done(cur); }
    PG8_STAMP();
    if (STAMP && wid == 0) { stamps[lane] = lane < nts ? (((unsigned long long)(unsigned)ts_hi << 32) | (unsigned)ts_lo) : 0ull;
        if (lane == 62) stamps[62] = rt_entry; if (lane == 63) stamps[63] = (unsigned long long)wall_clock64(); }
#undef PG8_STAMP
#undef PG8_SA
#undef PG8_SB
#undef PG8_STAGE
#undef PG8_LDA
#undef PG8_LDB
#undef PG8_MMA
#undef PG8_WAIT_V
#undef PG8_WAIT_L
#undef PG8_BAR
#undef PG8_SCHED
}
}

#define DI __device__ __forceinline__
#define LAS __attribute__((address_space(3)))
typedef unsigned short bf16_t;
typedef short bf16x8 __attribute__((ext_vector_type(8)));
typedef float f32x2 __attribute__((ext_vector_type(2)));
typedef float f32x4 __attribute__((ext_vector_type(4)));
typedef float f32x16 __attribute__((ext_vector_type(16)));
typedef unsigned u32x2 __attribute__((ext_vector_type(2)));
typedef unsigned u32x4 __attribute__((ext_vector_type(4)));
typedef __bf16 bf16v2 __attribute__((ext_vector_type(2)));
typedef LAS unsigned char* ldsp_t;

constexpr int NTOK = 16384, DM = 4096, SEQ = 4096;
constexpr float ALPHA = 1.4142135623730951f;
constexpr float LAM_INIT = 0.35550906759096926f;
constexpr float LOG2E = 1.4426950408889634f;

constexpr size_t OFF_ACT = 0;
constexpr size_t OFF_WIN = 134217728ull;
constexpr size_t OFF_WOUT = OFF_WIN + 136314880ull;
constexpr size_t OFF_H = OFF_WOUT + 33554432ull;
constexpr size_t OFF_AB = OFF_H + 536870912ull;
constexpr size_t OFF_R = OFF_AB + 4194304ull;
constexpr size_t OFF_AA = OFF_R + 134217728ull;
constexpr size_t OFF_CD = OFF_AA + 67108864ull;
constexpr size_t OFF_BT = OFF_CD + 32768ull;
constexpr size_t OFF_BAR = OFF_BT + 16384ull;
constexpr size_t WS_NEED = OFF_BAR + 256ull;

constexpr int LDS_BYTES = 160 * 1024;

struct Params {
    const float* x; const float* ln_g; const float* ln_b; const float* rel_bias;
    const float* a_w_in; const float* a_conv_w; const float* a_a_log; const float* a_dt_bias; const float* a_norm_w; const float* a_w_out;
    const float* b_w_in; const float* lq1; const float* lk1; const float* lq2; const float* lk2; const float* subln_w; const float* b_w_out;
    float* out; unsigned char* ws; int ph_lo, ph_hi;
};

DI float bf2f(unsigned short b) { return __uint_as_float(((unsigned)b) << 16); }
DI unsigned pk2(float lo, float hi) { f32x2 v = {lo, hi}; bf16v2 b = __builtin_convertvector(v, bf16v2); return __builtin_bit_cast(unsigned, b); }
DI unsigned short f2bf(float f) { return (unsigned short)(pk2(f, 0.f) & 0xffffu); }
DI bf16x8 pack8(float a0, float a1, float a2, float a3, float a4, float a5, float a6, float a7) {
    u32x4 w = {pk2(a0, a1), pk2(a2, a3), pk2(a4, a5), pk2(a6, a7)}; return __builtin_bit_cast(bf16x8, w);
}
DI bf16x8 pack8v(const f32x16& x, int s) { return pack8(x[8 * s], x[8 * s + 1], x[8 * s + 2], x[8 * s + 3], x[8 * s + 4], x[8 * s + 5], x[8 * s + 6], x[8 * s + 7]); }
DI int crow(int r, int hi) { return (r & 3) + 8 * (r >> 2) + 4 * hi; }
DI float siluf(float x) { return x * __builtin_amdgcn_rcpf(1.f + __builtin_amdgcn_exp2f(x * -1.4426950408889634f)); }
DI float dpp_add(float v, const int ctrl) { return v; }
#define DPP_ADD(v, ctrl) ((v) + __int_as_float(__builtin_amdgcn_update_dpp(0, __float_as_int(v), (ctrl), 0xf, 0xf, true)))
DI float sum16(float v) {
    v = DPP_ADD(v, 0xB1); v = DPP_ADD(v, 0x4E); v = DPP_ADD(v, 0x141); v = DPP_ADD(v, 0x140); return v; }
DI float wsum(float v) { for (int o = 32; o >= 1; o >>= 1) v += __shfl_xor(v, o); return v; }
#define MFMA32(a, b, c) __builtin_amdgcn_mfma_f32_32x32x16_bf16((a), (b), (c), 0, 0, 0)
DI bf16x8 lds8(ldsp_t p) { return *(const LAS bf16x8*)p; }
DI void wait_vm0() { asm volatile("s_waitcnt vmcnt(0)" ::: "memory"); }
DI void dma4(const void* g, ldsp_t l) { __builtin_amdgcn_global_load_lds((const unsigned*)g, (LAS unsigned*)l, 4, 0, 0); }
DI void dma16(const void* g, ldsp_t l) { __builtin_amdgcn_global_load_lds((const unsigned*)g, (LAS unsigned*)l, 16, 0, 0); }

struct EpiH {
    static constexpr bool PERM = true, AFTER_DRAIN = false;
    bf16_t* H; float* AB;
    DI void operator()(const pg8::f32x4 (&acc)[2][2][4][2], const pg8::Unit& u, int wr, int wc, int fr, int fq) const {
        const int row0 = u.pm * 256 + wr * 64 + fr;
        if (u.pn < 64) {
            const int col0 = u.pn * 256 + wc * 32 + 8 * fq;
#pragma unroll
            for (int ai = 0; ai < 2; ++ai)
#pragma unroll
                for (int m = 0; m < 4; ++m) { bf16_t* rowp = H + (size_t)(row0 + ai * 128 + m * 16) * 16384 + col0;
#pragma unroll
                    for (int bj = 0; bj < 2; ++bj) { pg8::f32x4 v0 = acc[ai][bj][m][0], v1 = acc[ai][bj][m][1];
                        if (u.pn >= 48) {
#pragma unroll
                            for (int e = 0; e < 4; ++e) { v0[e] = siluf(v0[e]); v1[e] = siluf(v1[e]); } }
                        u32x4 w = {pk2(v0[0], v0[1]), pk2(v0[2], v0[3]), pk2(v1[0], v1[1]), pk2(v1[2], v1[3])};
                        *(u32x4*)(rowp + bj * 128) = w; } }
        } else if (wc < 2) {
            const int col0 = wc * 32 + 8 * fq;
#pragma unroll
            for (int ai = 0; ai < 2; ++ai)
#pragma unroll
                for (int m = 0; m < 4; ++m) { float* rowp = AB + (size_t)(row0 + ai * 128 + m * 16) * 64 + col0;
                    *(pg8::f32x4*)rowp = acc[ai][0][m][0]; *(pg8::f32x4*)(rowp + 4) = acc[ai][0][m][1]; }
        }
    }
};
struct EpiRes {
    static constexpr bool PERM = false, AFTER_DRAIN = false;
    const float* res; float* out;
    DI void operator()(const pg8::f32x4 (&acc)[2][2][4][2], const pg8::Unit& u, int wr, int wc, int fr, int fq) const {
        const int row0 = u.pm * 256 + wr * 64 + fr, col0 = u.pn * 256 + wc * 32 + 4 * fq;
#pragma unroll
        for (int ai = 0; ai < 2; ++ai)
#pragma unroll
            for (int m = 0; m < 4; ++m) { const size_t ro = (size_t)(row0 + ai * 128 + m * 16) * 4096 + col0;
#pragma unroll
                for (int bj = 0; bj < 2; ++bj)
#pragma unroll
                    for (int n = 0; n < 2; ++n) { const size_t o = ro + bj * 128 + n * 16; const pg8::f32x4 r = *(const pg8::f32x4*)(res + o);
                        *(pg8::f32x4*)(out + o) = r * ALPHA + acc[ai][bj][m][n]; } }
    }
};

DI void cvt_rows(const float* src, bf16_t* dst, size_t n8) {
    for (size_t i = (size_t)blockIdx.x * 512 + threadIdx.x; i < n8; i += (size_t)gridDim.x * 512) {
        const f32x4 a = *(const f32x4*)(src + i * 8), b = *(const f32x4*)(src + i * 8 + 4);
        *(bf16x8*)(dst + i * 8) = pack8(a[0], a[1], a[2], a[3], b[0], b[1], b[2], b[3]);
    }
}
DI void transpose_w(const float* W, int N, int Npad, bf16_t* WT, ldsp_t lds) {
    const int tid = threadIdx.x; const int ntn = Npad / 64, ntiles = 32 * ntn;
    LAS bf16_t* T = (LAS bf16_t*)lds;
    const int kr0 = tid >> 4, n4 = (tid & 15) * 4;
    f32x4 v[4];
    auto load_tile = [&](int tile) { const int tn = tile % ntn, tk = tile / ntn; const int n0 = tn * 64, k0 = tk * 128;
#pragma unroll
        for (int ps = 0; ps < 4; ++ps) { const f32x4 z4 = {0.f, 0.f, 0.f, 0.f};
            v[ps] = (n0 < N) ? *(const f32x4*)(W + (size_t)(k0 + ps * 32 + kr0) * N + n0 + n4) : z4; } };
    int tile = blockIdx.x;
    if (tile < ntiles) load_tile(tile);
    for (; tile < ntiles; tile += gridDim.x) {
        const int tn = tile % ntn, tk = tile / ntn; const int n0 = tn * 64, k0 = tk * 128;
#pragma unroll
        for (int ps = 0; ps < 4; ++ps) { const int kr = ps * 32 + kr0;
#pragma unroll
            for (int j = 0; j < 4; ++j) T[(n4 + j) * 136 + ((((kr >> 3) ^ (tid & 15)) << 3) | (kr & 7))] = f2bf(v[ps][j]); }
        if (tile + (int)gridDim.x < ntiles) load_tile(tile + (int)gridDim.x);
        __syncthreads();
#pragma unroll
        for (int ps = 0; ps < 2; ++ps) { const int n = ps * 32 + (tid >> 4), kc = (tid & 15) * 8;
            *(bf16x8*)(WT + (size_t)(n0 + n) * 4096 + k0 + kc) = *(const LAS bf16x8*)(T + n * 136 + ((((kc >> 3) ^ ((n >> 2) & 15))) << 3)); }
        __syncthreads();
    }
}
DI void bias_table(const float* rel_bias, float* BT) {
    const int i = blockIdx.x * 512 + threadIdx.x;
    if (i < 4096) { const int h = i >> 8, n = i & 255; int bk;
        if (n < 16) bk = n; else { bk = 16 + (int)(log((double)n / 16.0) / log(8.0) * 16.0); if (bk > 31) bk = 31; }
        BT[i] = rel_bias[bk * 16 + h] * LOG2E; }
}

DI void ln_phase(float* io, const float* g, const float* bv, bf16_t* outb) {
    const int lane = threadIdx.x & 63, wid = threadIdx.x >> 6;
    for (int row = blockIdx.x * 8 + wid; row < NTOK; row += gridDim.x * 8) {
        float* p = io + (size_t)row * DM; f32x4 v[16]; float s = 0.f;
#pragma unroll
        for (int i = 0; i < 16; ++i) { v[i] = *(const f32x4*)(p + (i * 64 + lane) * 4); s += v[i][0] + v[i][1] + v[i][2] + v[i][3]; }
        const float mean = wsum(s) * (1.f / DM); float q = 0.f;
#pragma unroll
        for (int i = 0; i < 16; ++i) { v[i] = v[i] - mean; q += v[i][0] * v[i][0] + v[i][1] * v[i][1] + v[i][2] * v[i][2] + v[i][3] * v[i][3]; }
        const float rstd = rsqrtf(wsum(q) * (1.f / DM) + 1e-5f);
#pragma unroll
        for (int i = 0; i < 16; ++i) { const int col = (i * 64 + lane) * 4; const f32x4 gg = *(const f32x4*)(g + col), bb = *(const f32x4*)(bv + col);
            const f32x4 y = v[i] * rstd * gg + bb; *(f32x4*)(p + col) = y;
            if (outb) { u32x2 w = {pk2(y[0], y[1]), pk2(y[2], y[3])}; *(u32x2*)(outb + (size_t)row * DM + col) = w; } }
    }
}

constexpr int L_KH = 0, L_QH = 17408, L_KT = 34816, L_VT = 53248, L_LF = 71680, L_LT = 88064, L_TF = 104448, L_T1 = 120832, L_T2 = 130048, L_GC = 139264, L_BE = 139520, L_CW = 139776;
DI void p2a_phase(const Params& P, ldsp_t lds) {
    const int tid = threadIdx.x, wid = __builtin_amdgcn_readfirstlane(tid >> 6), lane = tid & 63, c32 = lane & 31, hi = lane >> 5;
    const bf16_t* H = (const bf16_t*)(P.ws + OFF_H); const float* AB = (const float*)(P.ws + OFF_AB);
    bf16_t* NW = (bf16_t*)P.out; bf16_t* UU = (bf16_t*)P.out + 67108864ull; bf16_t* QD = (bf16_t*)(P.ws + OFF_WIN); bf16_t* KST = (bf16_t*)(P.ws + OFF_ACT);
    bf16_t* AA = (bf16_t*)(P.ws + OFF_AA); float* CD = (float*)(P.ws + OFF_CD);
    LAS bf16_t* KH = (LAS bf16_t*)(lds + L_KH); LAS bf16_t* QH = (LAS bf16_t*)(lds + L_QH); LAS bf16_t* KT = (LAS bf16_t*)(lds + L_KT); LAS bf16_t* VT = (LAS bf16_t*)(lds + L_VT);
    LAS float* LF = (LAS float*)(lds + L_LF); LAS float* LT = (LAS float*)(lds + L_LT); LAS float* TF = (LAS float*)(lds + L_TF); LAS bf16_t* T1 = (LAS bf16_t*)(lds + L_T1); LAS bf16_t* T2 = (LAS bf16_t*)(lds + L_T2);
    LAS float* GC = (LAS float*)(lds + L_GC); LAS float* BE = (LAS float*)(lds + L_BE);
    LAS f32x4* CW = (LAS f32x4*)(lds + L_CW);
    int hprev = -1;
    for (int item = blockIdx.x; item < 8192; item += gridDim.x) {
        const int h = item & 31, bc = item >> 5, b = bc >> 6, chunk = bc & 63; const size_t ci = (size_t)((b * 32 + h) * 64 + chunk);
        if (h != hprev) {
            if (tid < 384) CW[tid] = *(const f32x4*)(P.a_conv_w + (size_t)((tid >> 7) * 4096 + h * 128 + (tid & 127)) * 4);
            hprev = h; __syncthreads();
        }
        {
            const int grp = tid & 15, rlo = tid >> 4;
            bf16x8 xv[6][4];
#pragma unroll
            for (int i = 0; i < 6; ++i) {
                const int tensor = i >> 1, row = (i & 1) * 32 + rlo, tseq = chunk * 64 + row;
                const bf16_t* src = H + (size_t)(b * SEQ + tseq) * 16384 + tensor * 4096 + h * 128 + grp * 8;
#pragma unroll
                for (int j = 0; j < 4; ++j) { const bf16x8 z8 = {0, 0, 0, 0, 0, 0, 0, 0};
                    xv[i][j] = (tseq - 3 + j >= 0) ? *(const bf16x8*)(src + (long)(j - 3) * 16384) : z8; }
            }
#pragma unroll
            for (int i = 0; i < 6; ++i) {
                const int tensor = i >> 1, row = (i & 1) * 32 + rlo;
                float y[8];
#pragma unroll
                for (int e = 0; e < 8; ++e) { const f32x4 w4 = CW[tensor * 128 + grp * 8 + e];
                    y[e] = bf2f((unsigned short)xv[i][0][e]) * w4[0] + bf2f((unsigned short)xv[i][1][e]) * w4[1] + bf2f((unsigned short)xv[i][2][e]) * w4[2] + bf2f((unsigned short)xv[i][3][e]) * w4[3]; }
#pragma unroll
                for (int e = 0; e < 8; ++e) y[e] = siluf(y[e]);
                if (tensor < 2) {
                    float ss = 0.f;
#pragma unroll
                    for (int e = 0; e < 8; ++e) ss += y[e] * y[e];
                    ss = sum16(ss);
                    float r = rsqrtf(ss + 1e-6f); if (tensor == 0) r *= 0.08838834764831845f;
#pragma unroll
                    for (int e = 0; e < 8; ++e) y[e] *= r;
                }
                const bf16x8 pv = pack8(y[0], y[1], y[2], y[3], y[4], y[5], y[6], y[7]);
                if (tensor == 0) { *(LAS bf16x8*)(QH + row * 136 + grp * 8) = pv; }
                else if (tensor == 1) { *(LAS bf16x8*)(KH + row * 136 + grp * 8) = pv;
#pragma unroll
                    for (int e = 0; e < 8; ++e) KT[(grp * 8 + e) * 72 + ((((row >> 3) ^ (grp & 7)) << 3) | (row & 7))] = (bf16_t)pv[e]; }
                else {
#pragma unroll
                    for (int e = 0; e < 8; ++e) VT[(grp * 8 + e) * 72 + ((((row >> 3) ^ (grp & 7)) << 3) | (row & 7))] = (bf16_t)pv[e]; }
            }
        }
        if (wid == 0) {
            const size_t tr = (size_t)(b * SEQ + chunk * 64 + lane) * 64;
            const float av = AB[tr + h], bvv = AB[tr + 32 + h];
            const float xs = av + P.a_dt_bias[h];
            const float sp = xs > 20.f ? xs : log1pf(__expf(xs));
            float g = -__expf(P.a_a_log[h]) * sp;
#pragma unroll
            for (int o = 1; o < 64; o <<= 1) { const float t = __shfl_up(g, o); if (lane >= o) g += t; }
            GC[lane] = g; BE[lane] = 1.f / (1.f + __expf(-bvv));
            if (lane == 63) CD[ci] = __expf(g);
        }
        __syncthreads();
        {
            int widv = wid; asm volatile("" : "+s"(widv));
            const int prod = widv >> 2, ti = (widv >> 1) & 1, tj = widv & 1;
            LAS bf16_t* Bm = prod ? QH : KH;
            f32x16 acc; for (int r = 0; r < 16; ++r) acc[r] = 0.f;
#pragma unroll
            for (int ks = 0; ks < 8; ++ks) { const bf16x8 a = *(const LAS bf16x8*)(KH + (32 * ti + c32) * 136 + 16 * ks + 8 * hi);
                const bf16x8 bq = *(const LAS bf16x8*)(Bm + (32 * tj + c32) * 136 + 16 * ks + 8 * hi); acc = MFMA32(a, bq, acc); }
            const int col = 32 * tj + c32; const float gcc = GC[col], bec = BE[col];
            if (prod == 0) {
#pragma unroll
                for (int r = 0; r < 16; ++r) { const int i = 32 * ti + crow(r, hi);
                    const float gi = GC[i]; const float v = BE[i] * acc[r] * __expf(gi - gcc); LF[i * 64 + col] = (i > col) ? v : 0.f;
                    const float vt = bec * acc[r] * __expf(gcc - gi); LT[i * 64 + col] = (col > i) ? vt : 0.f; }
            } else {
                float vals[16];
#pragma unroll
                for (int r = 0; r < 16; ++r) { const int s = 32 * ti + crow(r, hi); const float v = acc[r] * __expf(gcc - GC[s]); vals[r] = (col >= s) ? v : 0.f; }
#pragma unroll
                for (int hb = 0; hb < 2; ++hb)
                    *(bf16x8*)(AA + ci * 4096 + (size_t)((tj * 4 + 2 * ti + hb) * 64 + lane) * 8) =
                        pack8(vals[8 * hb], vals[8 * hb + 1], vals[8 * hb + 2], vals[8 * hb + 3], vals[8 * hb + 4], vals[8 * hb + 5], vals[8 * hb + 6], vals[8 * hb + 7]);
            }
        }
        __syncthreads();
        if (wid < 2) {
            int wid3 = wid, c32o = c32; asm volatile("" : "+s"(wid3)); asm volatile("" : "+v"(c32o));
            const int base = 32 * wid3, c = base + c32o;
            const float be = BE[c], beg = be * __expf(GC[c]);
            int zv = 0; asm volatile("" : "+v"(zv));
            LAS float* LFz = LF + zv; LAS float* LTz = LT + zv;
#pragma unroll 1
            for (int rbl = 0; rbl < 2; ++rbl) {
                const int r0 = base + 16 * rbl;
                float acc[16];
#pragma unroll
                for (int ii = 0; ii < 16; ++ii) acc[ii] = (r0 + ii == c) ? 1.f : 0.f;
#pragma unroll 1
                for (int j = base; j < r0; j += 4) {
                    float t[4]; f32x4 l4[4][4];
#pragma unroll
                    for (int u = 0; u < 4; ++u) { t[u] = TF[(j + u) * 64 + c];
#pragma unroll
                        for (int q = 0; q < 4; ++q) l4[u][q] = *(const LAS f32x4*)(LTz + (j + u) * 64 + r0 + 4 * q); }
#pragma unroll
                    for (int u = 0; u < 4; ++u)
#pragma unroll
                        for (int q = 0; q < 4; ++q) { acc[4 * q] -= l4[u][q][0] * t[u]; acc[4 * q + 1] -= l4[u][q][1] * t[u]; acc[4 * q + 2] -= l4[u][q][2] * t[u]; acc[4 * q + 3] -= l4[u][q][3] * t[u]; }
                }
                f32x4 Lb[16][4];
#pragma unroll
                for (int ii = 1; ii < 16; ++ii)
#pragma unroll
                    for (int q = 0; 4 * q < ii; ++q) Lb[ii][q] = *(const LAS f32x4*)(LFz + (r0 + ii) * 64 + r0 + 4 * q);
                float Tb[16];
#pragma unroll
                for (int ii = 0; ii < 16; ++ii) { float a = acc[ii];
#pragma unroll
                    for (int jj = 0; jj < ii; jj += 4) { const f32x4 l4 = Lb[ii][jj >> 2];
                        a -= l4[0] * Tb[jj]; if (jj + 1 < ii) a -= l4[1] * Tb[jj + 1]; if (jj + 2 < ii) a -= l4[2] * Tb[jj + 2]; if (jj + 3 < ii) a -= l4[3] * Tb[jj + 3]; }
                    Tb[ii] = a; }
#pragma unroll
                for (int ii = 0; ii < 16; ++ii) { TF[(r0 + ii) * 64 + c] = Tb[ii]; T1[(r0 + ii) * 72 + c] = f2bf(-Tb[ii] * beg); T2[(r0 + ii) * 72 + c] = f2bf(Tb[ii] * be); }
            }
            if (wid == 0) {
                LAS bf16_t* z1 = T1 + 32 + c32o; LAS bf16_t* z2 = T2 + 32 + c32o;
#pragma unroll 8
                for (int ii = 0; ii < 32; ++ii) { z1[ii * 72] = 0; z2[ii * 72] = 0; }
            }
        } else {
            const float gl = GC[63];
            int tid3 = tid; asm volatile("" : "+v"(tid3));
            for (int idx = tid3 - 128; idx < 2048; idx += 384) {
                if (idx < 1024) { const int f = idx, mi = f >> 9, ks = (f >> 6) & 7, l = f & 63, m = l & 31, g = l >> 5, tok = 32 * mi + m;
                    const u32x2 e0 = *(const LAS u32x2*)(QH + tok * 136 + 16 * ks + 4 * g), e1 = *(const LAS u32x2*)(QH + tok * 136 + 16 * ks + 8 + 4 * g);
                    const float sc = __expf(GC[tok]);
                    *(bf16x8*)(QD + ci * 8192 + (size_t)f * 8) = pack8(__uint_as_float(e0[0] << 16) * sc, __uint_as_float(e0[0] & 0xffff0000u) * sc, __uint_as_float(e0[1] << 16) * sc, __uint_as_float(e0[1] & 0xffff0000u) * sc,
                                                                      __uint_as_float(e1[0] << 16) * sc, __uint_as_float(e1[0] & 0xffff0000u) * sc, __uint_as_float(e1[1] << 16) * sc, __uint_as_float(e1[1] & 0xffff0000u) * sc);
                } else { const int f = idx - 1024, mt = f >> 8, ks = (f >> 6) & 3, l = f & 63, m = l & 31, g = l >> 5, dk = 32 * mt + m;
                    const int s0 = 16 * ks + 4 * g, s1 = s0 + 8;
                    const int sw = (dk >> 3) & 7;
                    const u32x2 e0 = *(const LAS u32x2*)(KT + dk * 72 + ((((s0 >> 3) ^ sw) << 3) | (s0 & 7))), e1 = *(const LAS u32x2*)(KT + dk * 72 + ((((s1 >> 3) ^ sw) << 3) | (s1 & 7)));
                    const f32x4 g0 = *(const LAS f32x4*)(GC + s0), g1 = *(const LAS f32x4*)(GC + s1);
                    *(bf16x8*)(KST + ci * 8192 + (size_t)f * 8) = pack8(__uint_as_float(e0[0] << 16) * __expf(gl - g0[0]), __uint_as_float(e0[0] & 0xffff0000u) * __expf(gl - g0[1]),
                                                                       __uint_as_float(e0[1] << 16) * __expf(gl - g0[2]), __uint_as_float(e0[1] & 0xffff0000u) * __expf(gl - g0[3]),
                                                                       __uint_as_float(e1[0] << 16) * __expf(gl - g1[0]), __uint_as_float(e1[0] & 0xffff0000u) * __expf(gl - g1[1]),
                                                                       __uint_as_float(e1[1] << 16) * __expf(gl - g1[2]), __uint_as_float(e1[1] & 0xffff0000u) * __expf(gl - g1[3]));
                }
            }
        }
        __syncthreads();
        if (wid == 0) {
            f32x16 X, Y; for (int r = 0; r < 16; ++r) { X[r] = 0.f; Y[r] = 0.f; }
#pragma unroll
            for (int kk = 0; kk < 2; ++kk) { float av[8], bv[8];
#pragma unroll
                for (int e = 0; e < 8; ++e) { const int j = 16 * kk + 8 * hi + e; av[e] = LT[j * 64 + 32 + c32]; bv[e] = TF[j * 64 + c32]; }
                X = MFMA32(pack8(av[0], av[1], av[2], av[3], av[4], av[5], av[6], av[7]), pack8(bv[0], bv[1], bv[2], bv[3], bv[4], bv[5], bv[6], bv[7]), X); }
#pragma unroll
            for (int sx = 0; sx < 2; ++sx) {
                const f32x4 b0 = *(const LAS f32x4*)(TF + (32 + c32) * 64 + 32 + 16 * sx + 4 * hi), b1 = *(const LAS f32x4*)(TF + (32 + c32) * 64 + 32 + 16 * sx + 8 + 4 * hi);
                Y = MFMA32(pack8(b0[0], b0[1], b0[2], b0[3], b1[0], b1[1], b1[2], b1[3]), pack8v(X, sx), Y); }
            const float be = BE[c32], beg = be * __expf(GC[c32]);
#pragma unroll
            for (int r = 0; r < 16; ++r) { const int i = 32 + crow(r, hi); T1[i * 72 + c32] = f2bf(Y[r] * beg); T2[i * 72 + c32] = f2bf(-Y[r] * be); }
        }
        __syncthreads();
#pragma unroll 1
        for (int jj = 0; jj < 2; ++jj) {
            const int j = wid * 2 + jj;
            f32x16 acc; for (int r = 0; r < 16; ++r) acc[r] = 0.f;
            if (j < 8) { const int dt = j >> 1, mi = j & 1;
#pragma unroll
                for (int kk = 0; kk < 4; ++kk) { const bf16x8 a = *(const LAS bf16x8*)(KT + (32 * dt + c32) * 72 + (((2 * kk + hi) ^ (((32 * dt + c32) >> 3) & 7)) << 3));
                    const bf16x8 bq = *(const LAS bf16x8*)(T1 + (32 * mi + c32) * 72 + 16 * kk + 8 * hi); acc = MFMA32(a, bq, acc); }
#pragma unroll
                for (int hb = 0; hb < 2; ++hb) *(bf16x8*)(NW + ci * 8192 + (size_t)((mi * 8 + 2 * dt + hb) * 64 + lane) * 8) = pack8v(acc, hb);
            } else { const int j2 = j - 8, mi = j2 >> 2, nt = j2 & 3;
#pragma unroll
                for (int kk = 0; kk < 4; ++kk) { const bf16x8 a = *(const LAS bf16x8*)(T2 + (32 * mi + c32) * 72 + 16 * kk + 8 * hi);
                    const bf16x8 bq = *(const LAS bf16x8*)(VT + (32 * nt + c32) * 72 + (((2 * kk + hi) ^ (((32 * nt + c32) >> 3) & 7)) << 3)); acc = MFMA32(a, bq, acc); }
                bf16_t* up = UU + ci * 8192 + (size_t)((mi * 4 + nt) * 64 + lane) * 16;
                *(bf16x8*)up = pack8v(acc, 0); *(bf16x8*)(up + 8) = pack8v(acc, 1);
            }
        }
        __syncthreads();
    }
}

DI f32x16 unpack16(const bf16x8 a, const bf16x8 b) { f32x16 r;
#pragma unroll
    for (int e = 0; e < 8; ++e) { r[e] = bf2f((unsigned short)a[e]); r[8 + e] = bf2f((unsigned short)b[e]); } return r; }
DI void scan_phase(const Params& P, ldsp_t lds) {
    if (blockIdx.x >= 128) return;
    const int tid = threadIdx.x, wid = __builtin_amdgcn_readfirstlane(tid >> 6), lane = tid & 63, c32 = lane & 31, hi = lane >> 5;
    const int bh = blockIdx.x, b = bh >> 5, h = bh & 31;
    const bf16_t* H = (const bf16_t*)(P.ws + OFF_H);
    const bf16_t* NW = (const bf16_t*)P.out; const bf16_t* UU = (const bf16_t*)P.out + 67108864ull; const bf16_t* QD = (const bf16_t*)(P.ws + OFF_WIN); const bf16_t* KST = (const bf16_t*)(P.ws + OFF_ACT);
    const bf16_t* AA = (const bf16_t*)(P.ws + OFF_AA); const float* CD = (const float*)(P.ws + OFF_CD); bf16_t* O0 = (bf16_t*)(P.ws + OFF_R);
    constexpr int OPB = 57344, L_OB = 2 * OPB, OBB = 17408;
    const bool helper = wid >= 4;
    f32x16 S[4]; bf16x8 un[4];
#pragma unroll
    for (int mt = 0; mt < 4; ++mt) for (int r = 0; r < 16; ++r) S[mt][r] = 0.f;
    auto dma_chunk = [&](int cc, int buf) {
        const size_t ci = (size_t)bh * 64 + cc; const int hw = wid - 4;
#pragma unroll 1
        for (int i = 0; i < 14; ++i) { const int piece = hw * 14 + i;
            const bf16_t* src;
            if (piece < 16) src = NW + ci * 8192 + piece * 512; else if (piece < 32) src = QD + ci * 8192 + (piece - 16) * 512;
            else if (piece < 48) src = KST + ci * 8192 + (piece - 32) * 512; else src = AA + ci * 4096 + (piece - 48) * 512;
            dma16(src + lane * 8, lds + buf * OPB + piece * 1024); }
    };
    auto load_u = [&](int cc) {
        const size_t ci = (size_t)bh * 64 + cc;
#pragma unroll
        for (int mi = 0; mi < 2; ++mi) { const bf16_t* up = UU + ci * 8192 + (size_t)((mi * 4 + wid) * 64 + lane) * 16; un[2 * mi] = *(const bf16x8*)up; un[2 * mi + 1] = *(const bf16x8*)(up + 8); }
    };
    const bool dma_w = (wid == 4 || wid == 5), fin_w = wid >= 6;
    auto dma_chunk2 = [&](int cc, int buf) {
        const size_t ci = (size_t)bh * 64 + cc; ldsp_t dst = lds + buf * OPB;
        const bf16_t* s0 = NW + ci * 8192 + lane * 8; const bf16_t* s1 = QD + ci * 8192 + lane * 8; const bf16_t* s2 = KST + ci * 8192 + lane * 8; const bf16_t* s3 = AA + ci * 4096 + lane * 8;
        if (wid == 4) {
#pragma unroll 4
            for (int i = 0; i < 16; ++i) dma16(s0 + i * 512, dst + i * 1024);
#pragma unroll 4
            for (int i = 0; i < 12; ++i) dma16(s1 + i * 512, dst + 16384 + i * 1024);
        } else {
#pragma unroll 4
            for (int i = 12; i < 16; ++i) dma16(s1 + i * 512, dst + 16384 + i * 1024);
#pragma unroll 4
            for (int i = 0; i < 16; ++i) dma16(s2 + i * 512, dst + 32768 + i * 1024);
#pragma unroll 4
            for (int i = 0; i < 8; ++i) dma16(s3 + i * 512, dst + 49152 + i * 1024);
        }
    };
    const int ft = tid - 384;
    bf16x8 zreg[8];
    auto load_z = [&](int cc) {
#pragma unroll
        for (int ps = 0; ps < 8; ++ps) { const int unit = ps * 128 + ft, tok = unit >> 4, cg8 = (unit & 15) * 8;
            zreg[ps] = *(const bf16x8*)(H + (size_t)(b * SEQ + cc * 64 + tok) * 16384 + 12288 + h * 128 + cg8); }
    };
    float cdn = 0.f;
    if (dma_w) dma_chunk2(0, 0); else if (!fin_w) { load_u(0); cdn = CD[(size_t)bh * 64]; } else load_z(0);
    wait_vm0(); __syncthreads();
    if (dma_w) {
#pragma unroll 1
      for (int c = 0; c <= 64; ++c) {

            if (c + 1 < 64) dma_chunk2(c + 1, (c + 1) & 1);
            wait_vm0();
        asm volatile("s_waitcnt lgkmcnt(0)" ::: "memory"); __builtin_amdgcn_s_barrier(); asm volatile("" ::: "memory");
      }
    } else if (fin_w) {
#pragma unroll 1
      for (int c = 0; c <= 64; ++c) {

            if (c >= 1) {
                const int cp = c - 1; ldsp_t ob = lds + L_OB + (cp & 1) * OBB;
                const int cg8 = (ft & 15) * 8;
                const f32x4 w0 = *(const f32x4*)(P.a_norm_w + cg8), w1 = *(const f32x4*)(P.a_norm_w + cg8 + 4);
#pragma unroll
                for (int ps = 0; ps < 8; ++ps) { const int unit = ps * 128 + ft, tok = unit >> 4;
                  {
                    const bf16x8 ov = *(const LAS bf16x8*)(ob + (tok * 136 + cg8) * 2);
                    float o[8], ss = 0.f;
#pragma unroll
                    for (int e = 0; e < 8; ++e) { o[e] = bf2f((unsigned short)ov[e]); ss += o[e] * o[e]; }
                    ss = sum16(ss);
                    const float rs = rsqrtf(ss * (1.f / 128.f) + 1e-6f);
                    const size_t trow = (size_t)(b * SEQ + cp * 64 + tok);
                    const bf16x8 zv = zreg[ps];
                    float r[8];
#pragma unroll
                    for (int e = 0; e < 8; ++e) r[e] = o[e] * rs * (e < 4 ? w0[e & 3] : w1[e & 3]) * bf2f((unsigned short)zv[e]);
                    *(bf16x8*)(O0 + trow * 4096 + h * 128 + cg8) = pack8(r[0], r[1], r[2], r[3], r[4], r[5], r[6], r[7]);
                  }
                }
            }
            if (c < 64) load_z(c);
        asm volatile("s_waitcnt lgkmcnt(0)" ::: "memory"); __builtin_amdgcn_s_barrier(); asm volatile("" ::: "memory");
      }
    } else {
#pragma unroll 1
      for (int c = 0; c <= 64; ++c) {
        if (c < 64) {

            ldsp_t op = lds + (c & 1) * OPB + lane * 16;
            const float cd = cdn;
            f32x16 v0 = unpack16(un[0], un[1]), v1 = unpack16(un[2], un[3]);
            bf16x8 Sb[8];
#pragma unroll
            for (int mt = 0; mt < 4; ++mt) { Sb[2 * mt] = pack8v(S[mt], 0); Sb[2 * mt + 1] = pack8v(S[mt], 1); }
            f32x16 o0, o1; for (int r = 0; r < 16; ++r) { o0[r] = 0.f; o1[r] = 0.f; }
#define SB0 __builtin_amdgcn_sched_barrier(0)
            SB0;
#pragma unroll
            for (int g = 0; g < 8; ++g) {
#pragma unroll
                for (int k2 = 0; k2 < 1; ++k2) { const int ks = g;
                    v0 = MFMA32(lds8(op + ks * 1024), Sb[ks], v0); v1 = MFMA32(lds8(op + (8 + ks) * 1024), Sb[ks], v1);
                    o0 = MFMA32(lds8(op + 16384 + ks * 1024), Sb[ks], o0); o1 = MFMA32(lds8(op + 16384 + (8 + ks) * 1024), Sb[ks], o1); }
                SB0; }
            bf16x8 Vb[4]; Vb[0] = pack8v(v0, 0); Vb[1] = pack8v(v0, 1); Vb[2] = pack8v(v1, 0); Vb[3] = pack8v(v1, 1);
            SB0;
            if (c + 1 < 64) { load_u(c + 1); cdn = CD[(size_t)bh * 64 + c + 1]; }
#pragma unroll
            for (int mt = 0; mt < 4; ++mt) S[mt] = S[mt] * cd;
#pragma unroll
            for (int g = 0; g < 4; ++g) {
#pragma unroll
                for (int k2 = 0; k2 < 1; ++k2) { const int ks = g;
                    o0 = MFMA32(lds8(op + 49152 + ks * 1024), Vb[ks], o0); o1 = MFMA32(lds8(op + 49152 + (4 + ks) * 1024), Vb[ks], o1);
#pragma unroll
                    for (int mt = 0; mt < 4; ++mt) S[mt] = MFMA32(lds8(op + 32768 + (mt * 4 + ks) * 1024), Vb[ks], S[mt]); }
                SB0; }
            LAS bf16_t* ob = (LAS bf16_t*)(lds + L_OB + (c & 1) * OBB);
#pragma unroll
            for (int r = 0; r < 16; ++r) { ob[crow(r, hi) * 136 + wid * 32 + c32] = f2bf(o0[r]); ob[(32 + crow(r, hi)) * 136 + wid * 32 + c32] = f2bf(o1[r]); }
                }
        asm volatile("s_waitcnt lgkmcnt(0)" ::: "memory"); __builtin_amdgcn_s_barrier(); asm volatile("" ::: "memory");
      }
    }
}

DI void vt_phase(const Params& P, ldsp_t lds) {
    const int tid = threadIdx.x; const bf16_t* H = (const bf16_t*)(P.ws + OFF_H); bf16_t* VTg = (bf16_t*)(P.ws + OFF_R);
    LAS bf16_t* T = (LAS bf16_t*)lds;
    const int dg = (tid & 31) * 8, tk0 = tid >> 5;
    bf16x8 v[8];
    auto load_item = [&](int item) { const int bh = item >> 5, tb = item & 31, b = bh >> 4, h = bh & 15;
#pragma unroll
        for (int ps = 0; ps < 8; ++ps) v[ps] = *(const bf16x8*)(H + (size_t)(b * SEQ + tb * 128 + ps * 16 + tk0) * 16384 + 8192 + h * 256 + dg); };
    int item = blockIdx.x;
    if (item < 2048) load_item(item);
    for (; item < 2048; item += gridDim.x) {
        const int bh = item >> 5, tb = item & 31;
#pragma unroll
        for (int ps = 0; ps < 8; ++ps) { const int tok = ps * 16 + tk0;
            const int o = tok & 15, pos = (tok & ~15) | (o & 3) | ((o & 4) << 1) | ((o & 8) >> 1);
#pragma unroll
            for (int e = 0; e < 8; ++e) T[(dg + e) * 136 + (pos ^ ((tid & 15) << 3))] = (bf16_t)v[ps][e]; }
        if (item + (int)gridDim.x < 2048) load_item(item + (int)gridDim.x);
        __syncthreads();
#pragma unroll
        for (int ps = 0; ps < 8; ++ps) { const int dv = ps * 32 + (tid >> 4), tc = (tid & 15) * 8;
            *(bf16x8*)(VTg + ((size_t)bh * 256 + dv) * SEQ + tb * 128 + tc) = *(const LAS bf16x8*)(T + dv * 136 + (tc ^ (((dv >> 3) & 15) << 3))); }
        __syncthreads();
    }
}

constexpr int AT_KBUF = 32768  , AT_VOFF = 65536, AT_VBUF = 32768  , AT_BT = 131072, AT_OF_STRIDE = 257;
DI void attn_block(const Params& P, ldsp_t lds, int bh, int qb, float lam) {
    int tid_o = threadIdx.x; asm volatile("" : "+v"(tid_o));
    const int tid = tid_o, wid = __builtin_amdgcn_readfirstlane(tid >> 6), lane = tid & 63, c32 = lane & 31, hi = lane >> 5;
    const int b = bh >> 4, h = bh & 15, q0 = qb * 128, nt = 2 * qb + 2, p = wid >> 2, wsub = wid & 3;
    const bf16_t* H = (const bf16_t*)(P.ws + OFF_H); const bf16_t* VTg = (const bf16_t*)(P.ws + OFF_R); bf16_t* O1 = (bf16_t*)(P.ws + OFF_ACT);
    const float* BTg = (const float*)(P.ws + OFF_BT);
    LAS float* BTs = (LAS float*)(lds + AT_BT);
    if (tid < 256) BTs[tid] = BTg[h * 256 + tid];
    const int qmin = q0 + 32 * wsub, qrow = qmin + c32, qmax = qmin + 31;
    bf16x8 Qf[8];
    { const bf16_t* qp = H + (size_t)(b * SEQ + qrow) * 16384 + h * 256 + p * 128 + 8 * hi;
#pragma unroll
      for (int ks = 0; ks < 8; ++ks) Qf[ks] = *(const bf16x8*)(qp + 16 * ks); }
    const char* kbase = (const char*)(H + (size_t)(b * SEQ) * 16384 + 4096 + h * 256);
    const char* vbase = (const char*)(VTg + (size_t)bh * 256 * SEQ);
    const unsigned kvo = (unsigned)(lane >> 4) * 32768u + (unsigned)(((lane & 15) ^ (lane >> 4)) * 16);
    const unsigned vvo = (unsigned)(lane >> 3) * (SEQ * 2) + (unsigned)(((lane & 7) ^ ((lane >> 3) & 7)) * 16);
    auto load_tile = [&](int kt, int buf) {
        const int k0 = kt * 64;
#pragma unroll
        for (int i = 0; i < 4; ++i) { const int blk = wid * 4 + i, pp = blk >> 4, key0 = 4 * (blk & 15);
            const unsigned lo = (unsigned)(lane >> 4) * 32768u + (unsigned)(((lane & 15) ^ (4 * i + (lane >> 4))) * 16);
            dma16(kbase + ((size_t)(k0 + key0) * 32768 + pp * 256) + lo, lds + buf * AT_KBUF + blk * 1024); }
#pragma unroll
        for (int i = 0; i < 4; ++i) { const int blk = wid * 4 + i;
            const unsigned vo = (unsigned)(lane >> 3) * (SEQ * 2) + (unsigned)(((lane & 7) ^ (4 * (i & 1) + (lane >> 4))) * 16);
            dma16(vbase + ((size_t)(8 * blk) * (SEQ * 2) + k0 * 2) + vo, lds + AT_VOFF + buf * AT_VBUF + blk * 1024); }
    };
    f32x16 O[8];
#pragma unroll
    for (int dt = 0; dt < 8; ++dt) for (int r = 0; r < 16; ++r) O[dt][r] = 0.f;
    float mrun = -1e30f, lrun = 0.f;
    constexpr float CS = 0.08838834764831845f * LOG2E;
    load_tile(0, 0);
    wait_vm0(); __syncthreads();
#pragma unroll 1
    for (int kt = 0; kt < nt; ++kt) {
        const int buf = kt & 1, k0 = kt * 64;
        if (kt + 1 < nt) load_tile(kt + 1, buf ^ 1);
        if (k0 <= qmax) {
            ldsp_t kb = lds + buf * AT_KBUF + p * 16384 + c32 * 256;
            ldsp_t vb = lds + AT_VOFF + buf * AT_VBUF + c32 * 128;
            const int swk = c32 & 15, swv = (c32 >> 1) & 7;
#pragma unroll
            for (int half = 0; half < 2; ++half) {
                const int kh0 = k0 + 32 * half;
                if (kh0 <= qmax) {
                    f32x16 Sx; for (int r = 0; r < 16; ++r) Sx[r] = 0.f;
                    SB0;
#pragma unroll
                    for (int g = 0; g < 2; ++g) {
#pragma unroll
                        for (int k4 = 0; k4 < 4; ++k4) { const int ks = 4 * g + k4;
                            Sx = MFMA32(lds8(kb + 32 * half * 256 + (((2 * ks + hi) ^ swk) << 4)), Qf[ks], Sx); }
                        SB0; }
                    const bool nearb = (qmin - (kh0 + 31)) < 128;
                    if (!nearb) { const float cb = BTs[255];
#pragma unroll
                        for (int r = 0; r < 16; ++r) Sx[r] = Sx[r] * CS + cb;
                    } else {
#pragma unroll
                        for (int r = 0; r < 16; ++r) { const int rel = qrow - (kh0 + crow(r, hi));
                            const float bb = BTs[min(max(rel, 0), 255)];
                            Sx[r] = rel >= 0 ? Sx[r] * CS + bb : -__builtin_inff();
                            if ((r & 3) == 3) SB0; }
                    }
                    float tmax = Sx[0];
#pragma unroll
                    for (int r = 1; r < 16; ++r) tmax = fmaxf(tmax, Sx[r]);
                    { auto rr = __builtin_amdgcn_permlane32_swap(__float_as_uint(tmax), __float_as_uint(tmax), false, false);
                      tmax = fmaxf(__uint_as_float(rr[0]), __uint_as_float(rr[1])); }
                    if (__any(tmax > mrun + 8.f)) {
                        const float mn = fmaxf(mrun, tmax), alpha = __builtin_amdgcn_exp2f(mrun - mn); mrun = mn; lrun *= alpha;
#pragma unroll
                        for (int dt = 0; dt < 8; ++dt) O[dt] = O[dt] * alpha;
                    }
                    float ls = 0.f;
#pragma unroll
                    for (int r = 0; r < 16; ++r) { Sx[r] = __builtin_amdgcn_exp2f(Sx[r] - mrun); ls += Sx[r]; }
                    lrun += ls;
                    bf16x8 Pf[2]; Pf[0] = pack8v(Sx, 0); Pf[1] = pack8v(Sx, 1);
                    SB0;
#pragma unroll
                    for (int d2 = 0; d2 < 2; ++d2) {
#pragma unroll
                        for (int dd = 0; dd < 4; ++dd) { const int dt = 4 * d2 + dd;
#pragma unroll
                            for (int hb = 0; hb < 2; ++hb)
                                O[dt] = MFMA32(lds8(vb + 32 * dt * 128 + (((2 * (2 * half + hb) + hi) ^ swv) << 4)), Pf[hb], O[dt]); }
                        SB0; }
                }
            }
        }
        wait_vm0(); __syncthreads();
    }
    int tid_e = threadIdx.x; asm volatile("" : "+v"(tid_e));
    const int lane_e = tid_e & 63, c32e = lane_e & 31, hie = lane_e >> 5;
    LAS float* Of = (LAS float*)lds;
    const float ltot = lrun + __shfl_xor(lrun, 32), inv = 1.f / ltot;
    const int ql = 32 * wsub + c32e;
    if (p == 1) { const float sc = -lam * inv;
#pragma unroll
        for (int dt = 0; dt < 8; ++dt)
#pragma unroll
            for (int r = 0; r < 16; ++r) Of[ql * AT_OF_STRIDE + 32 * dt + crow(r, hie)] = O[dt][r] * sc; }
    __syncthreads();
    if (p == 0) { float ssq = 0.f;
#pragma unroll
        for (int dt = 0; dt < 8; ++dt)
            {
#pragma unroll
                for (int r = 0; r < 16; ++r) { const float o = O[dt][r] * inv + Of[ql * AT_OF_STRIDE + 32 * dt + crow(r, hie)]; O[dt][r] = o; ssq = __builtin_fmaf(o, o, ssq); }
                SB0; }
        ssq += __shfl_xor(ssq, 32);
        const float rstd = rsqrtf(ssq * (1.f / 256.f) + 1e-5f) * (1.f - LAM_INIT);
#pragma unroll
        for (int dt = 0; dt < 8; ++dt)
#pragma unroll
            for (int r = 0; r < 16; ++r) Of[ql * AT_OF_STRIDE + 32 * dt + crow(r, hie)] = O[dt][r] * rstd; }
    __syncthreads();
#pragma unroll 1
    for (int i = 0; i < 8; ++i) { const int id = tid_e + 512 * i, q = id >> 5, dg = (id & 31) * 8; const size_t trow = (size_t)(b * SEQ + q0 + q);
        const bf16x8 zv = *(const bf16x8*)(H + trow * 16384 + 12288 + h * 256 + dg);
        const f32x4 w0 = *(const f32x4*)(P.subln_w + dg), w1 = *(const f32x4*)(P.subln_w + dg + 4);
        float r[8];
#pragma unroll
        for (int e = 0; e < 8; ++e) r[e] = Of[q * AT_OF_STRIDE + dg + e] * (e < 4 ? w0[e & 3] : w1[e & 3]) * bf2f((unsigned short)zv[e]);
        *(bf16x8*)(O1 + trow * 4096 + h * 256 + dg) = pack8(r[0], r[1], r[2], r[3], r[4], r[5], r[6], r[7]); }
    __syncthreads();
}
DI void attn_phase(const Params& P, ldsp_t lds) {
    const int lane = threadIdx.x & 63;
    float s1 = P.lq1[lane] * P.lk1[lane] + P.lq1[lane + 64] * P.lk1[lane + 64], s2 = P.lq2[lane] * P.lk2[lane] + P.lq2[lane + 64] * P.lk2[lane + 64];
    s1 = wsum(s1); s2 = wsum(s2);
    const float lam = __int_as_float(__builtin_amdgcn_readfirstlane(__float_as_int(expf(s1) - expf(s2) + LAM_INIT)));
    for (int idx = blockIdx.x; idx < 1024; idx += gridDim.x) { const int bh = idx >> 4, j = idx & 15;
#pragma unroll 1
        for (int sub = 0; sub < 2; ++sub) attn_block(P, lds, bh, sub ? 31 - j : j, lam); }
}

typedef const __attribute__((address_space(4))) Params* kparams_t;
DI Params kparams() { kparams_t p = (kparams_t)__builtin_amdgcn_kernarg_segment_ptr(); asm volatile("" : "+s"(p)); const Params* g = (const Params*)p; return *g; }
DI void gbar(unsigned* ctr, unsigned target) {
    __syncthreads();
    if (threadIdx.x == 0) {
        __builtin_amdgcn_fence(__ATOMIC_RELEASE, "agent");
        __hip_atomic_fetch_add(ctr, 1u, __ATOMIC_RELAXED, __HIP_MEMORY_SCOPE_AGENT);
        while (__hip_atomic_load(ctr, __ATOMIC_RELAXED, __HIP_MEMORY_SCOPE_AGENT) < target) __builtin_amdgcn_s_sleep(1);
    }
    __syncthreads();
    __builtin_amdgcn_fence(__ATOMIC_ACQUIRE, "agent");
    asm volatile("s_waitcnt vmcnt(0)" ::: "memory");
}
__global__ void __launch_bounds__(512) fwd_megakernel(Params P) {
    extern __shared__ __attribute__((aligned(16))) unsigned char shm[];
    ldsp_t lds = (ldsp_t)shm;
    cg::grid_group grid = cg::this_grid();
    const int ph_lo = P.ph_lo, ph_hi = P.ph_hi;
    unsigned* bar = (unsigned*)(P.ws + OFF_BAR); int nbar = 0;
#ifdef EXTRA_SYNC
    for (int es = 0; es < EXTRA_SYNC; ++es) grid.sync();
#endif
#ifndef PH_MASK
#define PH_MASK 0x7ff
#endif
#define PH_ON(n) (((PH_MASK) >> (n)) & 1)
#ifndef REP_MASK
#define REP_MASK 0
#endif
#define REP_N(n) ((((REP_MASK) >> (n)) & 1) ? 2 : 1)
    if (PH_ON(0) && ph_lo <= 0 && 0 < ph_hi) { if (0 > ph_lo) gbar(bar, (unsigned)(++nbar) * gridDim.x);
        const Params Pl = kparams(); unsigned char* ws = Pl.ws;
        for (int rep = 0; rep < REP_N(0); ++rep)
        {
            cvt_rows(Pl.x, (bf16_t*)(ws + OFF_ACT), (size_t)NTOK * DM / 8);
            transpose_w(Pl.a_w_in, 16448, 16640, (bf16_t*)(ws + OFF_WIN), lds);
            transpose_w(Pl.a_w_out, 4096, 4096, (bf16_t*)(ws + OFF_WOUT), lds);
            bias_table(Pl.rel_bias, (float*)(ws + OFF_BT));
        }
    }
    if (PH_ON(1) && ph_lo <= 1 && 1 < ph_hi) { if (1 > ph_lo) grid.sync();
        const Params Pl = kparams(); unsigned char* ws = Pl.ws;
        for (int rep = 0; rep < REP_N(1); ++rep)
        { pg8::Gemm g{(const bf16_t*)(ws + OFF_ACT), (const bf16_t*)(ws + OFF_WIN), NTOK, 16640, 4096};
            pg8::StaticOrder S; S.init(g.M, g.N, (int)gridDim.x, (int)blockIdx.x); EpiH E{(bf16_t*)(ws + OFF_H), (float*)(ws + OFF_AB)};
            pg8::gemm_phase<EpiH, pg8::StaticOrder, false>(lds, g, S, E, nullptr); }
    }
    if (PH_ON(2) && ph_lo <= 2 && 2 < ph_hi) { if (2 > ph_lo) gbar(bar, (unsigned)(++nbar) * gridDim.x);
        const Params Pl = kparams(); unsigned char* ws = Pl.ws;
        for (int rep = 0; rep < REP_N(2); ++rep)
        p2a_phase(Pl, lds);
    }
    if (PH_ON(3) && ph_lo <= 3 && 3 < ph_hi) { if (3 > ph_lo) gbar(bar, (unsigned)(++nbar) * gridDim.x);
        const Params Pl = kparams(); unsigned char* ws = Pl.ws;
        for (int rep = 0; rep < REP_N(3); ++rep)
        scan_phase(Pl, lds);
    }
    if (PH_ON(4) && ph_lo <= 4 && 4 < ph_hi) { if (4 > ph_lo) gbar(bar, (unsigned)(++nbar) * gridDim.x);
        const Params Pl = kparams(); unsigned char* ws = Pl.ws;
        for (int rep = 0; rep < REP_N(4); ++rep)
        { pg8::Gemm g{(const bf16_t*)(ws + OFF_R), (const bf16_t*)(ws + OFF_WOUT), NTOK, 4096, 4096};
            pg8::StaticOrder S; S.init(g.M, g.N, (int)gridDim.x, (int)blockIdx.x); EpiRes E{Pl.x, Pl.out};
            pg8::gemm_phase<EpiRes, pg8::StaticOrder, false>(lds, g, S, E, nullptr); }
    }
    if (PH_ON(5) && ph_lo <= 5 && 5 < ph_hi) { if (5 > ph_lo) gbar(bar, (unsigned)(++nbar) * gridDim.x);
        const Params Pl = kparams(); unsigned char* ws = Pl.ws;
        for (int rep = 0; rep < REP_N(5); ++rep)
        {
            ln_phase(Pl.out, Pl.ln_g, Pl.ln_b, (bf16_t*)(ws + OFF_ACT));
            transpose_w(Pl.b_w_in, 16384, 16384, (bf16_t*)(ws + OFF_WIN), lds);
            transpose_w(Pl.b_w_out, 4096, 4096, (bf16_t*)(ws + OFF_WOUT), lds);
        }
    }
    if (PH_ON(6) && ph_lo <= 6 && 6 < ph_hi) { if (6 > ph_lo) gbar(bar, (unsigned)(++nbar) * gridDim.x);
        const Params Pl = kparams(); unsigned char* ws = Pl.ws;
        for (int rep = 0; rep < REP_N(6); ++rep)
        { pg8::Gemm g{(const bf16_t*)(ws + OFF_ACT), (const bf16_t*)(ws + OFF_WIN), NTOK, 16384, 4096};
            pg8::StaticOrder S; S.init(g.M, g.N, (int)gridDim.x, (int)blockIdx.x); EpiH E{(bf16_t*)(ws + OFF_H), (float*)(ws + OFF_AB)};
            pg8::gemm_phase<EpiH, pg8::StaticOrder, false>(lds, g, S, E, nullptr); }
    }
    if (PH_ON(7) && ph_lo <= 7 && 7 < ph_hi) { if (7 > ph_lo) gbar(bar, (unsigned)(++nbar) * gridDim.x);
        const Params Pl = kparams(); unsigned char* ws = Pl.ws;
        for (int rep = 0; rep < REP_N(7); ++rep)
        vt_phase(Pl, lds);
    }
    if (PH_ON(8) && ph_lo <= 8 && 8 < ph_hi) { if (8 > ph_lo) gbar(bar, (unsigned)(++nbar) * gridDim.x);
        const Params Pl = kparams(); unsigned char* ws = Pl.ws;
        for (int rep = 0; rep < REP_N(8); ++rep)
        attn_phase(Pl, lds);
    }
    if (PH_ON(9) && ph_lo <= 9 && 9 < ph_hi) { if (9 > ph_lo) gbar(bar, (unsigned)(++nbar) * gridDim.x);
        const Params Pl = kparams(); unsigned char* ws = Pl.ws;
        for (int rep = 0; rep < REP_N(9); ++rep)
        { pg8::Gemm g{(const bf16_t*)(ws + OFF_ACT), (const bf16_t*)(ws + OFF_WOUT), NTOK, 4096, 4096};
            pg8::StaticOrder S; S.init(g.M, g.N, (int)gridDim.x, (int)blockIdx.x); EpiRes E{Pl.out, Pl.out};
            pg8::gemm_phase<EpiRes, pg8::StaticOrder, false>(lds, g, S, E, nullptr); }
    }
    if (PH_ON(10) && ph_lo <= 10 && 10 < ph_hi) { if (10 > ph_lo) gbar(bar, (unsigned)(++nbar) * gridDim.x);
        const Params Pl = kparams(); unsigned char* ws = Pl.ws;
        for (int rep = 0; rep < REP_N(10); ++rep)
        ln_phase(Pl.out, Pl.ln_g + DM, Pl.ln_b + DM, nullptr);
    }
}

#ifndef N_LAUNCH_MODE
#define N_LAUNCH_MODE 0
#endif
extern "C" void kernel_launch(void* const* d_in, const int* in_sizes, int n_in, void* d_out, int out_size, void* d_ws, size_t ws_size, hipStream_t stream) {
    static int grid_blocks = 0;
    if (!grid_blocks) {
        int dev = 0, cus = 0, per_cu = 0;
        hipGetDevice(&dev);
        hipDeviceGetAttribute(&cus, hipDeviceAttributeMultiprocessorCount, dev);
        hipFuncSetAttribute((const void*)fwd_megakernel, hipFuncAttributeMaxDynamicSharedMemorySize, LDS_BYTES);
        hipOccupancyMaxActiveBlocksPerMultiprocessor(&per_cu, fwd_megakernel, 512, LDS_BYTES);
        if (per_cu < 1) per_cu = 1;
        grid_blocks = cus * per_cu; if (grid_blocks > 256) grid_blocks = 256;
    }
    if (ws_size < WS_NEED) { fprintf(stderr, "workspace too small: %zu < %zu\n", ws_size, (size_t)WS_NEED); return; }
    Params p{};
    p.x = (const float*)d_in[0]; p.ln_g = (const float*)d_in[1]; p.ln_b = (const float*)d_in[2]; p.rel_bias = (const float*)d_in[3];
    p.a_w_in = (const float*)d_in[4]; p.a_conv_w = (const float*)d_in[5]; p.a_a_log = (const float*)d_in[6]; p.a_dt_bias = (const float*)d_in[7];
    p.a_norm_w = (const float*)d_in[8]; p.a_w_out = (const float*)d_in[9]; p.b_w_in = (const float*)d_in[10];
    p.lq1 = (const float*)d_in[11]; p.lk1 = (const float*)d_in[12]; p.lq2 = (const float*)d_in[13]; p.lk2 = (const float*)d_in[14];
    p.subln_w = (const float*)d_in[15]; p.b_w_out = (const float*)d_in[16];
    p.out = (float*)d_out; p.ws = (unsigned char*)d_ws;
#if N_LAUNCH_MODE == 0
    p.ph_lo = 0; p.ph_hi = 11;
    hipMemsetAsync((unsigned char*)d_ws + OFF_BAR, 0, 256, stream);
    void* args[] = {&p};
    hipError_t e = hipLaunchCooperativeKernel((const void*)fwd_megakernel, dim3(grid_blocks), dim3(512), args, LDS_BYTES, stream);
    if (e != hipSuccess) fprintf(stderr, "cooperative launch failed: %s (grid %d)\n", hipGetErrorString(e), grid_blocks);
#else
    for (int ph = 0; ph < 11; ++ph) { p.ph_lo = ph; p.ph_hi = ph + 1;
        hipLaunchKernelGGL(fwd_megakernel, dim3(grid_blocks), dim3(512), LDS_BYTES, stream, p); }
#endif
}
```

```cpp
#include <hip/hip_runtime.h>
#include <hip/hip_cooperative_groups.h>
#include <cstdio>
#include <cstdint>
namespace cg = cooperative_groups;
namespace pg8 {
#define PG8_LAS __attribute__((address_space(3)))
typedef unsigned short bf16_t;
typedef short bf16x8 __attribute__((ext_vector_type(8)));
typedef float f32x4 __attribute__((ext_vector_type(4)));
typedef unsigned u32x4 __attribute__((ext_vector_type(4)));
constexpr int BM = 256, BK = 64, HALF = 128, HTB = HALF * BK * 2  , STAGE_BYTES = 8 * HTB, NXCD = 8, WGM = 8;

__host__ __device__ __forceinline__ int lds_byte(int r, int c) { const int st = (r >> 4) * 2 + (c >> 5), rr = r & 15, cc = c & 31, ob = rr * 64 + cc * 2; return st * 1024 + (ob ^ (((ob >> 9) & 1) << 5)); }
__host__ __device__ __forceinline__ void stage_rc(int b, int& R, int& C) { const int st = b / 1024, sb = b % 1024, swz = sb ^ (((sb >> 9) & 1) << 5); R = (st >> 1) * 16 + swz / 64; C = (st & 1) * 32 + (swz % 64) / 2; }
__host__ __device__ __forceinline__ int perm32(int rho) { const int n = rho >> 4, i = rho & 15; return 8 * (i >> 2) + 4 * n + (i & 3); }

struct Unit { int pm, pn; };
struct Gemm { const bf16_t* A; const bf16_t* Bt; int M, N, K; };

struct StaticOrder {
    int nM, nN, nwg, G, c;
    __host__ __device__ void init(int M, int N, int G_, int c_) { nM = M / BM; nN = N / BM; nwg = nM * nN; G = G_; c = c_; }
    __host__ __device__ bool next(int i, Unit& u) const {
        const long L = (long)i * G + c; if (L >= nwg) return false;
        int wgid = (int)L; { const int q = nwg / NXCD, r = nwg % NXCD, xcd = wgid % NXCD, off = wgid / NXCD; wgid = (xcd < r ? xcd * (q + 1) : r * (q + 1) + (xcd - r) * q) + off; }
        const int nig = WGM * nN, gid = wgid / nig, fm = gid * WGM, gsz = (nM - fm) < WGM ? (nM - fm) : WGM;
        u.pm = fm + ((wgid % nig) % gsz); u.pn = (wgid % nig) / gsz; return true;
    }
    __device__ __forceinline__ void a_ready(const Unit&) const {}
    __device__ __forceinline__ void done(const Unit&) const {}
};

template <class Epi, class Sched, bool STAMP = false>
__device__ __forceinline__ void gemm_phase(PG8_LAS unsigned char* lds, const Gemm g, const Sched& S, const Epi& E, unsigned long long* stamps) {
    const int tid = threadIdx.x, wid = __builtin_amdgcn_readfirstlane(tid >> 6), lane = tid & 63, wr = wid >> 2, wc = wid & 3, fr = lane & 15, fq = lane >> 4;
    const int K = g.K, nt = K / BK;
    int ts_lo = 0, ts_hi = 0, nts = 0; const unsigned long long rt_entry = STAMP ? (unsigned long long)wall_clock64() : 0ull;
#define PG8_STAMP() do { if (STAMP && wid == 0 && nts < 64) { const unsigned long long _c = (unsigned long long)clock64(); \
        ts_lo = (lane == nts) ? (int)(unsigned)_c : ts_lo; ts_hi = (lane == nts) ? (int)(unsigned)(_c >> 32) : ts_hi; ++nts; } } while (0)
    PG8_STAMP();
    unsigned voffA[2], voffB[2];
#pragma unroll
    for (int i = 0; i < 2; ++i) { int R, C; stage_rc(tid * 16 + i * 8192, R, C); const int Rb = Epi::PERM ? ((R & ~31) + perm32(R & 31)) : R;
        voffA[i] = (unsigned)(R * K + C) * 2u; voffB[i] = (unsigned)(Rb * K + C) * 2u; }
    const size_t kstep = (size_t)(BK * 2);
    const size_t hstep = (size_t)HALF * K * 2;
    const size_t tstep = 2 * hstep;
    const unsigned ldsw = (unsigned)wid * 1024u;
    const int aoff = lds_byte(wr * 64 + fr, fq * 8), boff = lds_byte(wc * 32 + fr, fq * 8);
#define PG8_SA(b, h) (((b) * 2 + (h)) * HTB)
#define PG8_SB(b, h) ((4 + (b) * 2 + (h)) * HTB)
#define PG8_STAGE(bufoff, gbase, voff) do { _Pragma("unroll") for (int _i = 0; _i < 2; ++_i) \
        __builtin_amdgcn_global_load_lds((const unsigned*)((const char*)(gbase) + (voff)[_i]), (PG8_LAS unsigned*)(lds + (bufoff) + ldsw + _i * 8192), 16, 0, 0); } while (0)
#define PG8_LDA(dst, b, h) do { _Pragma("unroll") for (int m = 0; m < 4; ++m) _Pragma("unroll") for (int k = 0; k < 2; ++k) dst[m][k] = *(const PG8_LAS bf16x8*)(lds + PG8_SA(b, h) + aoff + m * 2048 + k * 1024); } while (0)
#define PG8_LDB(dst, b, h) do { _Pragma("unroll") for (int n = 0; n < 2; ++n) _Pragma("unroll") for (int k = 0; k < 2; ++k) dst[n][k] = *(const PG8_LAS bf16x8*)(lds + PG8_SB(b, h) + boff + n * 2048 + k * 1024); } while (0)
#define PG8_MMA(ai, bj, At, Bt) do { __builtin_amdgcn_s_setprio(1); _Pragma("unroll") for (int m = 0; m < 4; ++m) _Pragma("unroll") for (int n = 0; n < 2; ++n) _Pragma("unroll") for (int k = 0; k < 2; ++k) \
        acc[ai][bj][m][n] = __builtin_amdgcn_mfma_f32_16x16x32_bf16(Bt[n][k], At[m][k], acc[ai][bj][m][n], 0, 0, 0); __builtin_amdgcn_s_setprio(0); } while (0)
#define PG8_WAIT_V(n) asm volatile("s_waitcnt vmcnt(" #n ")" ::: "memory")
#define PG8_WAIT_L(n) asm volatile("s_waitcnt lgkmcnt(" #n ")" ::: "memory")
#define PG8_BAR __builtin_amdgcn_s_barrier()
#define PG8_SCHED __builtin_amdgcn_sched_barrier(0)
    Unit cur, nxt; int ui = 0;
    if (!S.next(0, cur)) return;
    f32x4 acc[2][2][4][2];
#pragma unroll
    for (int a = 0; a < 2; ++a)
#pragma unroll
        for (int b = 0; b < 2; ++b)
#pragma unroll
            for (int m = 0; m < 4; ++m)
#pragma unroll
                for (int n = 0; n < 2; ++n) acc[a][b][m][n] = (f32x4){0.f, 0.f, 0.f, 0.f};
    bf16x8 At[4][2], B0[2][2], B1[2][2];
    const char* cA = (const char*)g.A + (size_t)cur.pm * tstep; const char* cB = (const char*)g.Bt + (size_t)cur.pn * tstep;
    S.a_ready(cur);
    PG8_STAGE(PG8_SB(0, 0), cB, voffB); PG8_STAGE(PG8_SA(0, 0), cA, voffA); PG8_STAGE(PG8_SB(0, 1), cB + hstep, voffB); PG8_STAGE(PG8_SA(0, 1), cA + hstep, voffA);
    if (wr == 1) PG8_BAR;
    PG8_WAIT_V(4); PG8_BAR;
    PG8_STAGE(PG8_SB(1, 0), cB + kstep, voffB); PG8_STAGE(PG8_SA(1, 0), cA + kstep, voffA); PG8_STAGE(PG8_SB(1, 1), cB + hstep + kstep, voffB);
    PG8_WAIT_V(6); PG8_BAR;
    PG8_STAMP();
    for (;;) {
        const bool has_next = S.next(ui + 1, nxt);
        const char* nA = has_next ? (const char*)g.A + (size_t)nxt.pm * tstep : cA; const char* nB = has_next ? (const char*)g.Bt + (size_t)nxt.pn * tstep : cB;
        for (int t = 0; t < nt; t += 2) {
            const bool last = (t == nt - 2);
            const char* a1 = cA + (size_t)(t + 1) * kstep;
            const char* a2 = last ? nA : cA + (size_t)(t + 2) * kstep; const char* b2 = last ? nB : cB + (size_t)(t + 2) * kstep;
            const char* a3 = a2 + kstep; const char* b3 = b2 + kstep;
            if (last && has_next) S.a_ready(nxt);
            PG8_LDB(B0, 0, 0); PG8_SCHED; PG8_LDA(At, 0, 0); PG8_STAGE(PG8_SA(1, 1), a1 + hstep, voffA);
            PG8_WAIT_L(8); PG8_BAR; PG8_WAIT_L(0); PG8_MMA(0, 0, At, B0); PG8_BAR; PG8_SCHED;
            PG8_LDB(B1, 0, 1); PG8_STAGE(PG8_SB(0, 0), b2, voffB);
            PG8_BAR; PG8_WAIT_L(0); PG8_MMA(0, 1, At, B1); PG8_BAR;
            PG8_LDA(At, 0, 1); PG8_STAGE(PG8_SA(0, 0), a2, voffA);
            PG8_BAR; PG8_WAIT_L(0); PG8_MMA(1, 0, At, B0); PG8_BAR; PG8_SCHED;
            PG8_STAGE(PG8_SB(0, 1), b2 + hstep, voffB);
            PG8_WAIT_V(6); PG8_BAR; PG8_MMA(1, 1, At, B1); PG8_BAR;
            PG8_LDB(B0, 1, 0); PG8_SCHED; PG8_LDA(At, 1, 0); PG8_STAGE(PG8_SA(0, 1), a2 + hstep, voffA);
            PG8_WAIT_L(8); PG8_BAR; PG8_WAIT_L(0); PG8_MMA(0, 0, At, B0); PG8_BAR; PG8_SCHED;
            PG8_LDB(B1, 1, 1); PG8_STAGE(PG8_SB(1, 0), b3, voffB);
            PG8_BAR; PG8_WAIT_L(0); PG8_MMA(0, 1, At, B1); PG8_BAR;
            PG8_LDA(At, 1, 1); PG8_STAGE(PG8_SA(1, 0), a3, voffA);
            PG8_BAR; PG8_WAIT_L(0); PG8_MMA(1, 0, At, B0); PG8_BAR; PG8_SCHED;
            PG8_STAGE(PG8_SB(1, 1), b3 + hstep, voffB);
            PG8_WAIT_V(6); PG8_BAR; PG8_MMA(1, 1, At, B1); PG8_BAR;
        }
        PG8_STAMP();
        if constexpr (!Epi::AFTER_DRAIN) { E(acc, cur, wr, wc, fr, fq); S.done(cur); }
        PG8_STAMP();
        if (!has_next) break;
#pragma unroll
        for (int a = 0; a < 2; ++a)
#pragma unroll
            for (int b = 0; b < 2; ++b)
#pragma unroll
                for (int m = 0; m < 4; ++m)
#pragma unroll
                    for (int n = 0; n < 2; ++n) acc[a][b][m][n] = (f32x4){0.f, 0.f, 0.f, 0.f};
        cur = nxt; cA = nA; cB = nB; ++ui;
    }
    PG8_WAIT_V(0);
    if (wr == 0) PG8_BAR;
    PG8_BAR;
    if constexpr (Epi::AFTER_DRAIN) { E.fused(acc, cur, wr, wc, fr, fq, lds, wid, lane); S.done(cur); }
    PG8_STAMP();
    if (STAMP && wid == 0) { stamps[lane] = lane < nts ? (((unsigned long long)(unsigned)ts_hi << 32) | (unsigned)ts_lo) : 0ull;
        if (lane == 62) stamps[62] = rt_entry; if (lane == 63) stamps[63] = (unsigned long long)wall_clock64(); }
#undef PG8_STAMP
#undef PG8_SA
#undef PG8_SB
#undef PG8_STAGE
#undef PG8_LDA
#undef PG8_LDB
#undef PG8_MMA
#undef PG8_WAIT_V
#undef PG8_WAIT_L
#undef PG8_BAR
#undef PG8_SCHED
}
}

#define DI __device__ __forceinline__
#define LAS __attribute__((address_space(3)))
typedef unsigned short bf16_t;
typedef short bf16x8 __attribute__((ext_vector_type(8)));
typedef float f32x2 __attribute__((ext_vector_type(2)));
typedef float f32x4 __attribute__((ext_vector_type(4)));
typedef float f32x16 __attribute__((ext_vector_type(16)));
typedef unsigned u32x2 __attribute__((ext_vector_type(2)));
typedef unsigned u32x4 __attribute__((ext_vector_type(4)));
typedef __bf16 bf16v2 __attribute__((ext_vector_type(2)));
typedef LAS unsigned char* ldsp_t;

constexpr int NTOK = 16384, DM = 4096, SEQ = 4096;
constexpr float ALPHA = 1.4142135623730951f;
constexpr float LAM_INIT = 0.35550906759096926f;
constexpr float LOG2E = 1.4426950408889634f;

constexpr size_t OFF_ACT = 0;
constexpr size_t OFF_WIN = 134217728ull;
constexpr size_t OFF_WOUT = OFF_WIN + 136314880ull;
constexpr size_t OFF_H = OFF_WOUT + 33554432ull;
constexpr size_t OFF_AB = OFF_H + 536870912ull;
constexpr size_t OFF_R = OFF_AB + 4194304ull;
constexpr size_t OFF_AA = OFF_R + 134217728ull;
constexpr size_t OFF_CD = OFF_AA + 67108864ull;
constexpr size_t OFF_BT = OFF_CD + 32768ull;
constexpr size_t OFF_BAR = OFF_BT + 16384ull;
constexpr size_t WS_NEED = OFF_BAR + 256ull;

constexpr int LDS_BYTES = 160 * 1024;

struct Params {
    const float* x; const float* ln_g; const float* ln_b; const float* rel_bias;
    const float* a_w_in; const float* a_conv_w; const float* a_a_log; const float* a_dt_bias; const float* a_norm_w; const float* a_w_out;
    const float* b_w_in; const float* lq1; const float* lk1; const float* lq2; const float* lk2; const float* subln_w; const float* b_w_out;
    float* out; unsigned char* ws; int ph_lo, ph_hi;
};

DI float bf2f(unsigned short b) { return __uint_as_float(((unsigned)b) << 16); }
DI unsigned pk2(float lo, float hi) { f32x2 v = {lo, hi}; bf16v2 b = __builtin_convertvector(v, bf16v2); return __builtin_bit_cast(unsigned, b); }
DI unsigned short f2bf(float f) { return (unsigned short)(pk2(f, 0.f) & 0xffffu); }
DI bf16x8 pack8(float a0, float a1, float a2, float a3, float a4, float a5, float a6, float a7) {
    u32x4 w = {pk2(a0, a1), pk2(a2, a3), pk2(a4, a5), pk2(a6, a7)}; return __builtin_bit_cast(bf16x8, w);
}
DI bf16x8 pack8v(const f32x16& x, int s) { return pack8(x[8 * s], x[8 * s + 1], x[8 * s + 2], x[8 * s + 3], x[8 * s + 4], x[8 * s + 5], x[8 * s + 6], x[8 * s + 7]); }
DI int crow(int r, int hi) { return (r & 3) + 8 * (r >> 2) + 4 * hi; }
DI float siluf(float x) { return x * __builtin_amdgcn_rcpf(1.f + __builtin_amdgcn_exp2f(x * -1.4426950408889634f)); }
DI float dpp_add(float v, const int ctrl) { return v; }
#define DPP_ADD(v, ctrl) ((v) + __int_as_float(__builtin_amdgcn_update_dpp(0, __float_as_int(v), (ctrl), 0xf, 0xf, true)))
DI float sum16(float v) {
    v = DPP_ADD(v, 0xB1); v = DPP_ADD(v, 0x4E); v = DPP_ADD(v, 0x141); v = DPP_ADD(v, 0x140); return v; }
DI float wsum(float v) { for (int o = 32; o >= 1; o >>= 1) v += __shfl_xor(v, o); return v; }
#define MFMA32(a, b, c) __builtin_amdgcn_mfma_f32_32x32x16_bf16((a), (b), (c), 0, 0, 0)
DI bf16x8 lds8(ldsp_t p) { return *(const LAS bf16x8*)p; }
DI void wait_vm0() { asm volatile("s_waitcnt vmcnt(0)" ::: "memory"); }
DI void dma4(const void* g, ldsp_t l) { __builtin_amdgcn_global_load_lds((const unsigned*)g, (LAS unsigned*)l, 4, 0, 0); }
DI void dma16(const void* g, ldsp_t l) { __builtin_amdgcn_global_load_lds((const unsigned*)g, (LAS unsigned*)l, 16, 0, 0); }

struct EpiH {
    static constexpr bool PERM = true, AFTER_DRAIN = false;
    bf16_t* H; float* AB;
    DI void operator()(const pg8::f32x4 (&acc)[2][2][4][2], const pg8::Unit& u, int wr, int wc, int fr, int fq) const {
        const int row0 = u.pm * 256 + wr * 64 + fr;
        if (u.pn < 64) {
            const int col0 = u.pn * 256 + wc * 32 + 8 * fq;
#pragma unroll
            for (int ai = 0; ai < 2; ++ai)
#pragma unroll
                for (int m = 0; m < 4; ++m) { bf16_t* rowp = H + (size_t)(row0 + ai * 128 + m * 16) * 16384 + col0;
#pragma unroll
                    for (int bj = 0; bj < 2; ++bj) { pg8::f32x4 v0 = acc[ai][bj][m][0], v1 = acc[ai][bj][m][1];
                        if (u.pn >= 48) {
#pragma unroll
                            for (int e = 0; e < 4; ++e) { v0[e] = siluf(v0[e]); v1[e] = siluf(v1[e]); } }
                        u32x4 w = {pk2(v0[0], v0[1]), pk2(v0[2], v0[3]), pk2(v1[0], v1[1]), pk2(v1[2], v1[3])};
                        *(u32x4*)(rowp + bj * 128) = w; } }
        } else if (wc < 2) {
            const int col0 = wc * 32 + 8 * fq;
#pragma unroll
            for (int ai = 0; ai < 2; ++ai)
#pragma unroll
                for (int m = 0; m < 4; ++m) { float* rowp = AB + (size_t)(row0 + ai * 128 + m * 16) * 64 + col0;
                    *(pg8::f32x4*)rowp = acc[ai][0][m][0]; *(pg8::f32x4*)(rowp + 4) = acc[ai][0][m][1]; }
        }
    }
};
struct EpiRes {
    static constexpr bool PERM = false, AFTER_DRAIN = false;
    const float* res; float* out;
    DI void operator()(const pg8::f32x4 (&acc)[2][2][4][2], const pg8::Unit& u, int wr, int wc, int fr, int fq) const {
        const int row0 = u.pm * 256 + wr * 64 + fr, col0 = u.pn * 256 + wc * 32 + 4 * fq;
#pragma unroll
        for (int ai = 0; ai < 2; ++ai)
#pragma unroll
            for (int m = 0; m < 4; ++m) { const size_t ro = (size_t)(row0 + ai * 128 + m * 16) * 4096 + col0;
#pragma unroll
                for (int bj = 0; bj < 2; ++bj)
#pragma unroll
                    for (int n = 0; n < 2; ++n) { const size_t o = ro + bj * 128 + n * 16; const pg8::f32x4 r = *(const pg8::f32x4*)(res + o);
                        *(pg8::f32x4*)(out + o) = r * ALPHA + acc[ai][bj][m][n]; } }
    }
};

DI void cvt_rows(const float* src, bf16_t* dst, size_t n8) {
    for (size_t i = (size_t)blockIdx.x * 512 + threadIdx.x; i < n8; i += (size_t)gridDim.x * 512) {
        const f32x4 a = *(const f32x4*)(src + i * 8), b = *(const f32x4*)(src + i * 8 + 4);
        *(bf16x8*)(dst + i * 8) = pack8(a[0], a[1], a[2], a[3], b[0], b[1], b[2], b[3]);
    }
}
DI void transpose_w(const float* W, int N, int Npad, bf16_t* WT, ldsp_t lds) {
    const int tid = threadIdx.x; const int ntn = Npad / 64, ntiles = 32 * ntn;
    LAS bf16_t* T = (LAS bf16_t*)lds;
    const int kr0 = tid >> 4, n4 = (tid & 15) * 4;
    f32x4 v[4];
    auto load_tile = [&](int tile) { const int tn = tile % ntn, tk = tile / ntn; const int n0 = tn * 64, k0 = tk * 128;
#pragma unroll
        for (int ps = 0; ps < 4; ++ps) { const f32x4 z4 = {0.f, 0.f, 0.f, 0.f};
            v[ps] = (n0 < N) ? *(const f32x4*)(W + (size_t)(k0 + ps * 32 + kr0) * N + n0 + n4) : z4; } };
    int tile = blockIdx.x;
    if (tile < ntiles) load_tile(tile);
    for (; tile < ntiles; tile += gridDim.x) {
        const int tn = tile % ntn, tk = tile / ntn; const int n0 = tn * 64, k0 = tk * 128;
#pragma unroll
        for (int ps = 0; ps < 4; ++ps) { const int kr = ps * 32 + kr0;
#pragma unroll
            for (int j = 0; j < 4; ++j) T[(n4 + j) * 136 + ((((kr >> 3) ^ (tid & 15)) << 3) | (kr & 7))] = f2bf(v[ps][j]); }
        if (tile + (int)gridDim.x < ntiles) load_tile(tile + (int)gridDim.x);
        __syncthreads();
#pragma unroll
        for (int ps = 0; ps < 2; ++ps) { const int n = ps * 32 + (tid >> 4), kc = (tid & 15) * 8;
            *(bf16x8*)(WT + (size_t)(n0 + n) * 4096 + k0 + kc) = *(const LAS bf16x8*)(T + n * 136 + ((((kc >> 3) ^ ((n >> 2) & 15))) << 3)); }
        __syncthreads();
    }
}
DI void bias_table(const float* rel_bias, float* BT) {
    const int i = blockIdx.x * 512 + threadIdx.x;
    if (i < 4096) { const int h = i >> 8, n = i & 255; int bk;
        if (n < 16) bk = n; else { bk = 16 + (int)(log((double)n / 16.0) / log(8.0) * 16.0); if (bk > 31) bk = 31; }
        BT[i] = rel_bias[bk * 16 + h] * LOG2E; }
}

DI void ln_phase(float* io, const float* g, const float* bv, bf16_t* outb) {
    const int lane = threadIdx.x & 63, wid = threadIdx.x >> 6;
    for (int row = blockIdx.x * 8 + wid; row < NTOK; row += gridDim.x * 8) {
        float* p = io + (size_t)row * DM; f32x4 v[16]; float s = 0.f;
#pragma unroll
        for (int i = 0; i < 16; ++i) { v[i] = *(const f32x4*)(p + (i * 64 + lane) * 4); s += v[i][0] + v[i][1] + v[i][2] + v[i][3]; }
        const float mean = wsum(s) * (1.f / DM); float q = 0.f;
#pragma unroll
        for (int i = 0; i < 16; ++i) { v[i] = v[i] - mean; q += v[i][0] * v[i][0] + v[i][1] * v[i][1] + v[i][2] * v[i][2] + v[i][3] * v[i][3]; }
        const float rstd = rsqrtf(wsum(q) * (1.f / DM) + 1e-5f);
#pragma unroll
        for (int i = 0; i < 16; ++i) { const int col = (i * 64 + lane) * 4; const f32x4 gg = *(const f32x4*)(g + col), bb = *(const f32x4*)(bv + col);
            const f32x4 y = v[i] * rstd * gg + bb; *(f32x4*)(p + col) = y;
            if (outb) { u32x2 w = {pk2(y[0], y[1]), pk2(y[2], y[3])}; *(u32x2*)(outb + (size_t)row * DM + col) = w; } }
    }
}

constexpr int L_KH = 0, L_QH = 17408, L_KT = 34816, L_VT = 53248, L_LF = 71680, L_LT = 88064, L_TF = 104448, L_T1 = 120832, L_T2 = 130048, L_GC = 139264, L_BE = 139520, L_CW = 139776;
DI void p2a_phase(const Params& P, ldsp_t lds) {
    const int tid = threadIdx.x, wid = __builtin_amdgcn_readfirstlane(tid >> 6), lane = tid & 63, c32 = lane & 31, hi = lane >> 5;
    const bf16_t* H = (const bf16_t*)(P.ws + OFF_H); const float* AB = (const float*)(P.ws + OFF_AB);
    bf16_t* NW = (bf16_t*)P.out; bf16_t* UU = (bf16_t*)P.out + 67108864ull; bf16_t* QD = (bf16_t*)(P.ws + OFF_WIN); bf16_t* KST = (bf16_t*)(P.ws + OFF_ACT);
    bf16_t* AA = (bf16_t*)(P.ws + OFF_AA); float* CD = (float*)(P.ws + OFF_CD);
    LAS bf16_t* KH = (LAS bf16_t*)(lds + L_KH); LAS bf16_t* QH = (LAS bf16_t*)(lds + L_QH); LAS bf16_t* KT = (LAS bf16_t*)(lds + L_KT); LAS bf16_t* VT = (LAS bf16_t*)(lds + L_VT);
    LAS float* LF = (LAS float*)(lds + L_LF); LAS float* LT = (LAS float*)(lds + L_LT); LAS float* TF = (LAS float*)(lds + L_TF); LAS bf16_t* T1 = (LAS bf16_t*)(lds + L_T1); LAS bf16_t* T2 = (LAS bf16_t*)(lds + L_T2);
    LAS float* GC = (LAS float*)(lds + L_GC); LAS float* BE = (LAS float*)(lds + L_BE);
    LAS f32x4* CW = (LAS f32x4*)(lds + L_CW);
    int hprev = -1;
    for (int item = blockIdx.x; item < 8192; item += gridDim.x) {
        const int h = item & 31, bc = item >> 5, b = bc >> 6, chunk = bc & 63; const size_t ci = (size_t)((b * 32 + h) * 64 + chunk);
        if (h != hprev) {
            if (tid < 384) CW[tid] = *(const f32x4*)(P.a_conv_w + (size_t)((tid >> 7) * 4096 + h * 128 + (tid & 127)) * 4);
            hprev = h; __syncthreads();
        }
        {
            const int grp = tid & 15, rlo = tid >> 4;
            bf16x8 xv[6][4];
#pragma unroll
            for (int i = 0; i < 6; ++i) {
                const int tensor = i >> 1, row = (i & 1) * 32 + rlo, tseq = chunk * 64 + row;
                const bf16_t* src = H + (size_t)(b * SEQ + tseq) * 16384 + tensor * 4096 + h * 128 + grp * 8;
#pragma unroll
                for (int j = 0; j < 4; ++j) { const bf16x8 z8 = {0, 0, 0, 0, 0, 0, 0, 0};
                    xv[i][j] = (tseq - 3 + j >= 0) ? *(const bf16x8*)(src + (long)(j - 3) * 16384) : z8; }
            }
#pragma unroll
            for (int i = 0; i < 6; ++i) {
                const int tensor = i >> 1, row = (i & 1) * 32 + rlo;
                float y[8];
#pragma unroll
                for (int e = 0; e < 8; ++e) { const f32x4 w4 = CW[tensor * 128 + grp * 8 + e];
                    y[e] = bf2f((unsigned short)xv[i][0][e]) * w4[0] + bf2f((unsigned short)xv[i][1][e]) * w4[1] + bf2f((unsigned short)xv[i][2][e]) * w4[2] + bf2f((unsigned short)xv[i][3][e]) * w4[3]; }
#pragma unroll
                for (int e = 0; e < 8; ++e) y[e] = siluf(y[e]);
                if (tensor < 2) {
                    float ss = 0.f;
#pragma unroll
                    for (int e = 0; e < 8; ++e) ss += y[e] * y[e];
                    ss = sum16(ss);
                    float r = rsqrtf(ss + 1e-6f); if (tensor == 0) r *= 0.08838834764831845f;
#pragma unroll
                    for (int e = 0; e < 8; ++e) y[e] *= r;
                }
                const bf16x8 pv = pack8(y[0], y[1], y[2], y[3], y[4], y[5], y[6], y[7]);
                if (tensor == 0) { *(LAS bf16x8*)(QH + row * 136 + grp * 8) = pv; }
                else if (tensor == 1) { *(LAS bf16x8*)(KH + row * 136 + grp * 8) = pv;
#pragma unroll
                    for (int e = 0; e < 8; ++e) KT[(grp * 8 + e) * 72 + ((((row >> 3) ^ (grp & 7)) << 3) | (row & 7))] = (bf16_t)pv[e]; }
                else {
#pragma unroll
                    for (int e = 0; e < 8; ++e) VT[(grp * 8 + e) * 72 + ((((row >> 3) ^ (grp & 7)) << 3) | (row & 7))] = (bf16_t)pv[e]; }
            }
        }
        if (wid == 0) {
            const size_t tr = (size_t)(b * SEQ + chunk * 64 + lane) * 64;
            const float av = AB[tr + h], bvv = AB[tr + 32 + h];
            const float xs = av + P.a_dt_bias[h];
            const float sp = xs > 20.f ? xs : log1pf(__expf(xs));
            float g = -__expf(P.a_a_log[h]) * sp;
#pragma unroll
            for (int o = 1; o < 64; o <<= 1) { const float t = __shfl_up(g, o); if (lane >= o) g += t; }
            GC[lane] = g; BE[lane] = 1.f / (1.f + __expf(-bvv));
            if (lane == 63) CD[ci] = __expf(g);
        }
        __syncthreads();
        {
            int widv = wid; asm volatile("" : "+s"(widv));
            const int prod = widv >> 2, ti = (widv >> 1) & 1, tj = widv & 1;
            LAS bf16_t* Bm = prod ? QH : KH;
            f32x16 acc; for (int r = 0; r < 16; ++r) acc[r] = 0.f;
#pragma unroll
            for (int ks = 0; ks < 8; ++ks) { const bf16x8 a = *(const LAS bf16x8*)(KH + (32 * ti + c32) * 136 + 16 * ks + 8 * hi);
                const bf16x8 bq = *(const LAS bf16x8*)(Bm + (32 * tj + c32) * 136 + 16 * ks + 8 * hi); acc = MFMA32(a, bq, acc); }
            const int col = 32 * tj + c32; const float gcc = GC[col], bec = BE[col];
            if (prod == 0) {
#pragma unroll
                for (int r = 0; r < 16; ++r) { const int i = 32 * ti + crow(r, hi);
                    const float gi = GC[i]; const float v = BE[i] * acc[r] * __expf(gi - gcc); LF[i * 64 + col] = (i > col) ? v : 0.f;
                    const float vt = bec * acc[r] * __expf(gcc - gi); LT[i * 64 + col] = (col > i) ? vt : 0.f; }
            } else {
                float vals[16];
#pragma unroll
                for (int r = 0; r < 16; ++r) { const int s = 32 * ti + crow(r, hi); const float v = acc[r] * __expf(gcc - GC[s]); vals[r] = (col >= s) ? v : 0.f; }
#pragma unroll
                for (int hb = 0; hb < 2; ++hb)
                    *(bf16x8*)(AA + ci * 4096 + (size_t)((tj * 4 + 2 * ti + hb) * 64 + lane) * 8) =
                        pack8(vals[8 * hb], vals[8 * hb + 1], vals[8 * hb + 2], vals[8 * hb + 3], vals[8 * hb + 4], vals[8 * hb + 5], vals[8 * hb + 6], vals[8 * hb + 7]);
            }
        }
        __syncthreads();
        if (wid < 2) {
            int wid3 = wid, c32o = c32; asm volatile("" : "+s"(wid3)); asm volatile("" : "+v"(c32o));
            const int base = 32 * wid3, c = base + c32o;
            const float be = BE[c], beg = be * __expf(GC[c]);
            int zv = 0; asm volatile("" : "+v"(zv));
            LAS float* LFz = LF + zv; LAS float* LTz = LT + zv;
#pragma unroll 1
            for (int rbl = 0; rbl < 2; ++rbl) {
                const int r0 = base + 16 * rbl;
                float acc[16];
#pragma unroll
                for (int ii = 0; ii < 16; ++ii) acc[ii] = (r0 + ii == c) ? 1.f : 0.f;
#pragma unroll 1
                for (int j = base; j < r0; j += 4) {
                    float t[4]; f32x4 l4[4][4];
#pragma unroll
                    for (int u = 0; u < 4; ++u) { t[u] = TF[(j + u) * 64 + c];
#pragma unroll
                        for (int q = 0; q < 4; ++q) l4[u][q] = *(const LAS f32x4*)(LTz + (j + u) * 64 + r0 + 4 * q); }
#pragma unroll
                    for (int u = 0; u < 4; ++u)
#pragma unroll
                        for (int q = 0; q < 4; ++q) { acc[4 * q] -= l4[u][q][0] * t[u]; acc[4 * q + 1] -= l4[u][q][1] * t[u]; acc[4 * q + 2] -= l4[u][q][2] * t[u]; acc[4 * q + 3] -= l4[u][q][3] * t[u]; }
                }
                f32x4 Lb[16][4];
#pragma unroll
                for (int ii = 1; ii < 16; ++ii)
#pragma unroll
                    for (int q = 0; 4 * q < ii; ++q) Lb[ii][q] = *(const LAS f32x4*)(LFz + (r0 + ii) * 64 + r0 + 4 * q);
                float Tb[16];
#pragma unroll
                for (int ii = 0; ii < 16; ++ii) { float a = acc[ii];
#pragma unroll
                    for (int jj = 0; jj < ii; jj += 4) { const f32x4 l4 = Lb[ii][jj >> 2];
                        a -= l4[0] * Tb[jj]; if (jj + 1 < ii) a -= l4[1] * Tb[jj + 1]; if (jj + 2 < ii) a -= l4[2] * Tb[jj + 2]; if (jj + 3 < ii) a -= l4[3] * Tb[jj + 3]; }
                    Tb[ii] = a; }
#pragma unroll
                for (int ii = 0; ii < 16; ++ii) { TF[(r0 + ii) * 64 + c] = Tb[ii]; T1[(r0 + ii) * 72 + c] = f2bf(-Tb[ii] * beg); T2[(r0 + ii) * 72 + c] = f2bf(Tb[ii] * be); }
            }
            if (wid == 0) {
                LAS bf16_t* z1 = T1 + 32 + c32o; LAS bf16_t* z2 = T2 + 32 + c32o;
#pragma unroll 8
                for (int ii = 0; ii < 32; ++ii) { z1[ii * 72] = 0; z2[ii * 72] = 0; }
            }
        } else {
            const float gl = GC[63];
            int tid3 = tid; asm volatile("" : "+v"(tid3));
            for (int idx = tid3 - 128; idx < 2048; idx += 384) {
                if (idx < 1024) { const int f = idx, mi = f >> 9, ks = (f >> 6) & 7, l = f & 63, m = l & 31, g = l >> 5, tok = 32 * mi + m;
                    const u32x2 e0 = *(const LAS u32x2*)(QH + tok * 136 + 16 * ks + 4 * g), e1 = *(const LAS u32x2*)(QH + tok * 136 + 16 * ks + 8 + 4 * g);
                    const float sc = __expf(GC[tok]);
                    *(bf16x8*)(QD + ci * 8192 + (size_t)f * 8) = pack8(__uint_as_float(e0[0] << 16) * sc, __uint_as_float(e0[0] & 0xffff0000u) * sc, __uint_as_float(e0[1] << 16) * sc, __uint_as_float(e0[1] & 0xffff0000u) * sc,
                                                                      __uint_as_float(e1[0] << 16) * sc, __uint_as_float(e1[0] & 0xffff0000u) * sc, __uint_as_float(e1[1] << 16) * sc, __uint_as_float(e1[1] & 0xffff0000u) * sc);
                } else { const int f = idx - 1024, mt = f >> 8, ks = (f >> 6) & 3, l = f & 63, m = l & 31, g = l >> 5, dk = 32 * mt + m;
                    const int s0 = 16 * ks + 4 * g, s1 = s0 + 8;
                    const int sw = (dk >> 3) & 7;
                    const u32x2 e0 = *(const LAS u32x2*)(KT + dk * 72 + ((((s0 >> 3) ^ sw) << 3) | (s0 & 7))), e1 = *(const LAS u32x2*)(KT + dk * 72 + ((((s1 >> 3) ^ sw) << 3) | (s1 & 7)));
                    const f32x4 g0 = *(const LAS f32x4*)(GC + s0), g1 = *(const LAS f32x4*)(GC + s1);
                    *(bf16x8*)(KST + ci * 8192 + (size_t)f * 8) = pack8(__uint_as_float(e0[0] << 16) * __expf(gl - g0[0]), __uint_as_float(e0[0] & 0xffff0000u) * __expf(gl - g0[1]),
                                                                       __uint_as_float(e0[1] << 16) * __expf(gl - g0[2]), __uint_as_float(e0[1] & 0xffff0000u) * __expf(gl - g0[3]),
                                                                       __uint_as_float(e1[0] << 16) * __expf(gl - g1[0]), __uint_as_float(e1[0] & 0xffff0000u) * __expf(gl - g1[1]),
                                                                       __uint_as_float(e1[1] << 16) * __expf(gl - g1[2]), __uint_as_float(e1[1] & 0xffff0000u) * __expf(gl - g1[3]));
                }
            }
        }
        __syncthreads();
        if (wid == 0) {
            f32x16 X, Y; for (int r = 0; r < 16; ++r) { X[r] = 0.f; Y[r] = 0.f; }
#pragma unroll
            for (int kk = 0; kk < 2; ++kk) { float av[8], bv[8];
#pragma unroll
                for (int e = 0; e < 8; ++e) { const int j = 16 * kk + 8 * hi + e; av[e] = LT[j * 64 + 32 + c32]; bv[e] = TF[j * 64 + c32]; }
                X = MFMA32(pack8(av[0], av[1], av[2], av[3], av[4], av[5], av[6], av[7]), pack8(bv[0], bv[1], bv[2], bv[3], bv[4], bv[5], bv[6], bv[7]), X); }
#pragma unroll
            for (int sx = 0; sx < 2; ++sx) {
                const f32x4 b0 = *(const LAS f32x4*)(TF + (32 + c32) * 64 + 32 + 16 * sx + 4 * hi), b1 = *(const LAS f32x4*)(TF + (32 + c32) * 64 + 32 + 16 * sx + 8 + 4 * hi);
                Y = MFMA32(pack8(b0[0], b0[1], b0[2], b0[3], b1[0], b1[1], b1[2], b1[3]), pack8v(X, sx), Y); }
            const float be = BE[c32], beg = be * __expf(GC[c32]);
#pragma unroll
            for (int r = 0; r < 16; ++r) { const int i = 32 + crow(r, hi); T1[i * 72 + c32] = f2bf(Y[r] * beg); T2[i * 72 + c32] = f2bf(-Y[r] * be); }
        }
        __syncthreads();
#pragma unroll 1
        for (int jj = 0; jj < 2; ++jj) {
            const int j = wid * 2 + jj;
            f32x16 acc; for (int r = 0; r < 16; ++r) acc[r] = 0.f;
            if (j < 8) { const int dt = j >> 1, mi = j & 1;
#pragma unroll
                for (int kk = 0; kk < 4; ++kk) { const bf16x8 a = *(const LAS bf16x8*)(KT + (32 * dt + c32) * 72 + (((2 * kk + hi) ^ (((32 * dt + c32) >> 3) & 7)) << 3));
                    const bf16x8 bq = *(const LAS bf16x8*)(T1 + (32 * mi + c32) * 72 + 16 * kk + 8 * hi); acc = MFMA32(a, bq, acc); }
#pragma unroll
                for (int hb = 0; hb < 2; ++hb) *(bf16x8*)(NW + ci * 8192 + (size_t)((mi * 8 + 2 * dt + hb) * 64 + lane) * 8) = pack8v(acc, hb);
            } else { const int j2 = j - 8, mi = j2 >> 2, nt = j2 & 3;
#pragma unroll
                for (int kk = 0; kk < 4; ++kk) { const bf16x8 a = *(const LAS bf16x8*)(T2 + (32 * mi + c32) * 72 + 16 * kk + 8 * hi);
                    const bf16x8 bq = *(const LAS bf16x8*)(VT + (32 * nt + c32) * 72 + (((2 * kk + hi) ^ (((32 * nt + c32) >> 3) & 7)) << 3)); acc = MFMA32(a, bq, acc); }
                bf16_t* up = UU + ci * 8192 + (size_t)((mi * 4 + nt) * 64 + lane) * 16;
                *(bf16x8*)up = pack8v(acc, 0); *(bf16x8*)(up + 8) = pack8v(acc, 1);
            }
        }
        __syncthreads();
    }
}

DI f32x16 unpack16(const bf16x8 a, const bf16x8 b) { f32x16 r;
#pragma unroll
    for (int e = 0; e < 8; ++e) { r[e] = bf2f((unsigned short)a[e]); r[8 + e] = bf2f((unsigned short)b[e]); } return r; }
DI void scan_phase(const Params& P, ldsp_t lds) {
    if (blockIdx.x >= 128) return;
    const int tid = threadIdx.x, wid = __builtin_amdgcn_readfirstlane(tid >> 6), lane = tid & 63, c32 = lane & 31, hi = lane >> 5;
    const int bh = blockIdx.x, b = bh >> 5, h = bh & 31;
    const bf16_t* H = (const bf16_t*)(P.ws + OFF_H);
    const bf16_t* NW = (const bf16_t*)P.out; const bf16_t* UU = (const bf16_t*)P.out + 67108864ull; const bf16_t* QD = (const bf16_t*)(P.ws + OFF_WIN); const bf16_t* KST = (const bf16_t*)(P.ws + OFF_ACT);
    const bf16_t* AA = (const bf16_t*)(P.ws + OFF_AA); const float* CD = (const float*)(P.ws + OFF_CD); bf16_t* O0 = (bf16_t*)(P.ws + OFF_R);
    constexpr int OPB = 57344, L_OB = 2 * OPB, OBB = 17408;
    const bool helper = wid >= 4;
    f32x16 S[4]; bf16x8 un[4];
#pragma unroll
    for (int mt = 0; mt < 4; ++mt) for (int r = 0; r < 16; ++r) S[mt][r] = 0.f;
    auto dma_chunk = [&](int cc, int buf) {
        const size_t ci = (size_t)bh * 64 + cc; const int hw = wid - 4;
#pragma unroll 1
        for (int i = 0; i < 14; ++i) { const int piece = hw * 14 + i;
            const bf16_t* src;
            if (piece < 16) src = NW + ci * 8192 + piece * 512; else if (piece < 32) src = QD + ci * 8192 + (piece - 16) * 512;
            else if (piece < 48) src = KST + ci * 8192 + (piece - 32) * 512; else src = AA + ci * 4096 + (piece - 48) * 512;
            dma16(src + lane * 8, lds + buf * OPB + piece * 1024); }
    };
    auto load_u = [&](int cc) {
        const size_t ci = (size_t)bh * 64 + cc;
#pragma unroll
        for (int mi = 0; mi < 2; ++mi) { const bf16_t* up = UU + ci * 8192 + (size_t)((mi * 4 + wid) * 64 + lane) * 16; un[2 * mi] = *(const bf16x8*)up; un[2 * mi + 1] = *(const bf16x8*)(up + 8); }
    };
    const bool dma_w = (wid == 4 || wid == 5), fin_w = wid >= 6;
    auto dma_chunk2 = [&](int cc, int buf) {
        const size_t ci = (size_t)bh * 64 + cc; ldsp_t dst = lds + buf * OPB;
        const bf16_t* s0 = NW + ci * 8192 + lane * 8; const bf16_t* s1 = QD + ci * 8192 + lane * 8; const bf16_t* s2 = KST + ci * 8192 + lane * 8; const bf16_t* s3 = AA + ci * 4096 + lane * 8;
        if (wid == 4) {
#pragma unroll 4
            for (int i = 0; i < 16; ++i) dma16(s0 + i * 512, dst + i * 1024);
#pragma unroll 4
            for (int i = 0; i < 12; ++i) dma16(s1 + i * 512, dst + 16384 + i * 1024);
        } else {
#pragma unroll 4
            for (int i = 12; i < 16; ++i) dma16(s1 + i * 512, dst + 16384 + i * 1024);
#pragma unroll 4
            for (int i = 0; i < 16; ++i) dma16(s2 + i * 512, dst + 32768 + i * 1024);
#pragma unroll 4
            for (int i = 0; i < 8; ++i) if (i != 2 && i != 3) dma16(s3 + i * 512, dst + 49152 + i * 1024);
        }
    };
    const int ft = tid - 384;
    bf16x8 zreg[8];
    auto load_z = [&](int cc) {
#pragma unroll
        for (int ps = 0; ps < 8; ++ps) { const int unit = ps * 128 + ft, tok = unit >> 4, cg8 = (unit & 15) * 8;
            zreg[ps] = *(const bf16x8*)(H + (size_t)(b * SEQ + cc * 64 + tok) * 16384 + 12288 + h * 128 + cg8); }
    };
    float cdn = 0.f;
    if (dma_w) dma_chunk2(0, 0); else if (!fin_w) { load_u(0); cdn = CD[(size_t)bh * 64]; } else load_z(0);
    wait_vm0(); __syncthreads();
    if (dma_w) {
#pragma unroll 1
      for (int c = 0; c <= 64; ++c) {

            if (c + 1 < 64) dma_chunk2(c + 1, (c + 1) & 1);
            wait_vm0();
        asm volatile("s_waitcnt lgkmcnt(0)" ::: "memory"); __builtin_amdgcn_s_barrier(); asm volatile("" ::: "memory");
      }
    } else if (fin_w) {
#pragma unroll 1
      for (int c = 0; c <= 64; ++c) {

            if (c >= 1) {
                const int cp = c - 1; ldsp_t ob = lds + L_OB + (cp & 1) * OBB;
                const int cg8 = (ft & 15) * 8;
                const f32x4 w0 = *(const f32x4*)(P.a_norm_w + cg8), w1 = *(const f32x4*)(P.a_norm_w + cg8 + 4);
#pragma unroll
                for (int ps = 0; ps < 8; ++ps) { const int unit = ps * 128 + ft, tok = unit >> 4;
                  {
                    const bf16x8 ov = *(const LAS bf16x8*)(ob + (tok * 136 + cg8) * 2);
                    float o[8], ss = 0.f;
#pragma unroll
                    for (int e = 0; e < 8; ++e) { o[e] = bf2f((unsigned short)ov[e]); ss += o[e] * o[e]; }
                    ss = sum16(ss);
                    const float rs = rsqrtf(ss * (1.f / 128.f) + 1e-6f);
                    const size_t trow = (size_t)(b * SEQ + cp * 64 + tok);
                    const bf16x8 zv = zreg[ps];
                    float r[8];
#pragma unroll
                    for (int e = 0; e < 8; ++e) r[e] = o[e] * rs * (e < 4 ? w0[e & 3] : w1[e & 3]) * bf2f((unsigned short)zv[e]);
                    *(bf16x8*)(O0 + trow * 4096 + h * 128 + cg8) = pack8(r[0], r[1], r[2], r[3], r[4], r[5], r[6], r[7]);
                  }
                }
            }
            if (c < 64) load_z(c);
        asm volatile("s_waitcnt lgkmcnt(0)" ::: "memory"); __builtin_amdgcn_s_barrier(); asm volatile("" ::: "memory");
      }
    } else {
#pragma unroll 1
      for (int c = 0; c <= 64; ++c) {
        if (c < 64) {

            ldsp_t op = lds + (c & 1) * OPB + lane * 16;
            const float cd = cdn;
            f32x16 v0 = unpack16(un[0], un[1]), v1 = unpack16(un[2], un[3]);
            bf16x8 Sb[8];
#pragma unroll
            for (int mt = 0; mt < 4; ++mt) { Sb[2 * mt] = pack8v(S[mt], 0); Sb[2 * mt + 1] = pack8v(S[mt], 1); }
            f32x16 o0, o1; for (int r = 0; r < 16; ++r) { o0[r] = 0.f; o1[r] = 0.f; }
#define SB0 __builtin_amdgcn_sched_barrier(0)
            SB0;
#pragma unroll
            for (int g = 0; g < 8; ++g) {
#pragma unroll
                for (int k2 = 0; k2 < 1; ++k2) { const int ks = g;
                    v0 = MFMA32(lds8(op + ks * 1024), Sb[ks], v0); v1 = MFMA32(lds8(op + (8 + ks) * 1024), Sb[ks], v1);
                    o0 = MFMA32(lds8(op + 16384 + ks * 1024), Sb[ks], o0); o1 = MFMA32(lds8(op + 16384 + (8 + ks) * 1024), Sb[ks], o1); }
                SB0; }
            bf16x8 Vb[4]; Vb[0] = pack8v(v0, 0); Vb[1] = pack8v(v0, 1); Vb[2] = pack8v(v1, 0); Vb[3] = pack8v(v1, 1);
            SB0;
            if (c + 1 < 64) { load_u(c + 1); cdn = CD[(size_t)bh * 64 + c + 1]; }
#pragma unroll
            for (int mt = 0; mt < 4; ++mt) S[mt] = S[mt] * cd;
#pragma unroll
            for (int g = 0; g < 4; ++g) {
#pragma unroll
                for (int k2 = 0; k2 < 1; ++k2) { const int ks = g;
                    if (ks < 2) o0 = MFMA32(lds8(op + 49152 + ks * 1024), Vb[ks], o0);
                    o1 = MFMA32(lds8(op + 49152 + (4 + ks) * 1024), Vb[ks], o1);
#pragma unroll
                    for (int mt = 0; mt < 4; ++mt) S[mt] = MFMA32(lds8(op + 32768 + (mt * 4 + ks) * 1024), Vb[ks], S[mt]); }
                SB0; }
            LAS bf16_t* ob = (LAS bf16_t*)(lds + L_OB + (c & 1) * OBB);
#pragma unroll
            for (int r = 0; r < 16; ++r) { ob[crow(r, hi) * 136 + wid * 32 + c32] = f2bf(o0[r]); ob[(32 + crow(r, hi)) * 136 + wid * 32 + c32] = f2bf(o1[r]); }
                }
        asm volatile("s_waitcnt lgkmcnt(0)" ::: "memory"); __builtin_amdgcn_s_barrier(); asm volatile("" ::: "memory");
      }
    }
}

DI void vt_phase(const Params& P, ldsp_t lds) {
    const int tid = threadIdx.x; const bf16_t* H = (const bf16_t*)(P.ws + OFF_H); bf16_t* VTg = (bf16_t*)(P.ws + OFF_R);
    LAS bf16_t* T = (LAS bf16_t*)lds;
    for (int item = blockIdx.x; item < 2048; item += gridDim.x) {
        const int bh = item >> 5, tb = item & 31, b = bh >> 4, h = bh & 15;
#pragma unroll
        for (int ps = 0; ps < 8; ++ps) { const int tok = ps * 16 + (tid >> 5), dg = (tid & 31) * 8;
            const bf16x8 v = *(const bf16x8*)(H + (size_t)(b * SEQ + tb * 128 + tok) * 16384 + 8192 + h * 256 + dg);
            const int o = tok & 15, pos = (tok & ~15) | (o & 3) | ((o & 4) << 1) | ((o & 8) >> 1);
#pragma unroll
            for (int e = 0; e < 8; ++e) T[(dg + e) * 136 + (pos ^ ((tid & 15) << 3))] = (bf16_t)v[e]; }
        __syncthreads();
#pragma unroll
        for (int ps = 0; ps < 8; ++ps) { const int dv = ps * 32 + (tid >> 4), tc = (tid & 15) * 8;
            *(bf16x8*)(VTg + ((size_t)bh * 256 + dv) * SEQ + tb * 128 + tc) = *(const LAS bf16x8*)(T + dv * 136 + (tc ^ (((dv >> 3) & 15) << 3))); }
        __syncthreads();
    }
}

constexpr int AT_KBUF = 32768  , AT_VOFF = 65536, AT_VBUF = 32768  , AT_BT = 131072, AT_OF_STRIDE = 257;
DI void attn_block(const Params& P, ldsp_t lds, int bh, int qb, float lam) {
    int tid_o = threadIdx.x; asm volatile("" : "+v"(tid_o));
    const int tid = tid_o, wid = __builtin_amdgcn_readfirstlane(tid >> 6), lane = tid & 63, c32 = lane & 31, hi = lane >> 5;
    const int b = bh >> 4, h = bh & 15, q0 = qb * 128, nt = 2 * qb + 2, p = wid >> 2, wsub = wid & 3;
    const bf16_t* H = (const bf16_t*)(P.ws + OFF_H); const bf16_t* VTg = (const bf16_t*)(P.ws + OFF_R); bf16_t* O1 = (bf16_t*)(P.ws + OFF_ACT);
    const float* BTg = (const float*)(P.ws + OFF_BT);
    LAS float* BTs = (LAS float*)(lds + AT_BT);
    if (tid < 256) BTs[tid] = BTg[h * 256 + tid];
    const int qmin = q0 + 32 * wsub, qrow = qmin + c32, qmax = qmin + 31;
    bf16x8 Qf[8];
    { const bf16_t* qp = H + (size_t)(b * SEQ + qrow) * 16384 + h * 256 + p * 128 + 8 * hi;
#pragma unroll
      for (int ks = 0; ks < 8; ++ks) Qf[ks] = *(const bf16x8*)(qp + 16 * ks); }
    const char* kbase = (const char*)(H + (size_t)(b * SEQ) * 16384 + 4096 + h * 256);
    const char* vbase = (const char*)(VTg + (size_t)bh * 256 * SEQ);
    const unsigned kvo = (unsigned)(lane >> 4) * 32768u + (unsigned)(((lane & 15) ^ (lane >> 4)) * 16);
    const unsigned vvo = (unsigned)(lane >> 3) * (SEQ * 2) + (unsigned)(((lane & 7) ^ ((lane >> 3) & 7)) * 16);
    auto load_tile = [&](int kt, int buf) {
        const int k0 = kt * 64;
#pragma unroll
        for (int i = 0; i < 4; ++i) { const int blk = wid * 4 + i, pp = blk >> 4, key0 = 4 * (blk & 15);
            const unsigned lo = (unsigned)(lane >> 4) * 32768u + (unsigned)(((lane & 15) ^ (4 * i + (lane >> 4))) * 16);
            dma16(kbase + ((size_t)(k0 + key0) * 32768 + pp * 256) + lo, lds + buf * AT_KBUF + blk * 1024); }
#pragma unroll
        for (int i = 0; i < 4; ++i) { const int blk = wid * 4 + i;
            const unsigned vo = (unsigned)(lane >> 3) * (SEQ * 2) + (unsigned)(((lane & 7) ^ (4 * (i & 1) + (lane >> 4))) * 16);
            dma16(vbase + ((size_t)(8 * blk) * (SEQ * 2) + k0 * 2) + vo, lds + AT_VOFF + buf * AT_VBUF + blk * 1024); }
    };
    f32x16 O[8];
#pragma unroll
    for (int dt = 0; dt < 8; ++dt) for (int r = 0; r < 16; ++r) O[dt][r] = 0.f;
    float mrun = -1e30f, lrun = 0.f;
    constexpr float CS = 0.08838834764831845f * LOG2E;
    load_tile(0, 0);
    wait_vm0(); __syncthreads();
#pragma unroll 1
    for (int kt = 0; kt < nt; ++kt) {
        const int buf = kt & 1, k0 = kt * 64;
        if (kt + 1 < nt) load_tile(kt + 1, buf ^ 1);
        if (k0 <= qmax) {
            ldsp_t kb = lds + buf * AT_KBUF + p * 16384 + c32 * 256;
            ldsp_t vb = lds + AT_VOFF + buf * AT_VBUF + c32 * 128;
            const int swk = c32 & 15, swv = (c32 >> 1) & 7;
#pragma unroll
            for (int half = 0; half < 2; ++half) {
                const int kh0 = k0 + 32 * half;
                if (kh0 <= qmax) {
                    f32x16 Sx; for (int r = 0; r < 16; ++r) Sx[r] = 0.f;
                    SB0;
#pragma unroll
                    for (int g = 0; g < 2; ++g) {
#pragma unroll
                        for (int k4 = 0; k4 < 4; ++k4) { const int ks = 4 * g + k4;
                            Sx = MFMA32(lds8(kb + 32 * half * 256 + (((2 * ks + hi) ^ swk) << 4)), Qf[ks], Sx); }
                        SB0; }
                    const bool nearb = (qmin - (kh0 + 31)) < 128;
                    if (!nearb) { const float cb = BTs[255];
#pragma unroll
                        for (int r = 0; r < 16; ++r) Sx[r] = Sx[r] * CS + cb;
                    } else {
#pragma unroll
                        for (int r = 0; r < 16; ++r) { const int rel = qrow - (kh0 + crow(r, hi));
                            const float bb = BTs[min(max(rel, 0), 255)];
                            Sx[r] = rel >= 0 ? Sx[r] * CS + bb : -__builtin_inff();
                            if ((r & 3) == 3) SB0; }
                    }
                    float tmax = Sx[0];
#pragma unroll
                    for (int r = 1; r < 16; ++r) tmax = fmaxf(tmax, Sx[r]);
                    { auto rr = __builtin_amdgcn_permlane32_swap(__float_as_uint(tmax), __float_as_uint(tmax), false, false);
                      tmax = fmaxf(__uint_as_float(rr[0]), __uint_as_float(rr[1])); }
                    if (__any(tmax > mrun + 8.f)) {
                        const float mn = fmaxf(mrun, tmax), alpha = __builtin_amdgcn_exp2f(mrun - mn); mrun = mn; lrun *= alpha;
#pragma unroll
                        for (int dt = 0; dt < 8; ++dt) O[dt] = O[dt] * alpha;
                    }
                    float ls = 0.f;
#pragma unroll
                    for (int r = 0; r < 16; ++r) { Sx[r] = __builtin_amdgcn_exp2f(Sx[r] - mrun); ls += Sx[r]; }
                    lrun += ls;
                    bf16x8 Pf[2]; Pf[0] = pack8v(Sx, 0); Pf[1] = pack8v(Sx, 1);
                    SB0;
#pragma unroll
                    for (int d2 = 0; d2 < 2; ++d2) {
#pragma unroll
                        for (int dd = 0; dd < 4; ++dd) { const int dt = 4 * d2 + dd;
#pragma unroll
                            for (int hb = 0; hb < 2; ++hb)
                                O[dt] = MFMA32(lds8(vb + 32 * dt * 128 + (((2 * (2 * half + hb) + hi) ^ swv) << 4)), Pf[hb], O[dt]); }
                        SB0; }
                }
            }
        }
        wait_vm0(); __syncthreads();
    }
    int tid_e = threadIdx.x; asm volatile("" : "+v"(tid_e));
    const int lane_e = tid_e & 63, c32e = lane_e & 31, hie = lane_e >> 5;
    LAS float* Of = (LAS float*)lds;
    const float ltot = lrun + __shfl_xor(lrun, 32), inv = 1.f / ltot;
    const int ql = 32 * wsub + c32e;
    if (p == 1) { const float sc = -lam * inv;
#pragma unroll
        for (int dt = 0; dt < 8; ++dt)
#pragma unroll
            for (int r = 0; r < 16; ++r) Of[ql * AT_OF_STRIDE + 32 * dt + crow(r, hie)] = O[dt][r] * sc; }
    __syncthreads();
    if (p == 0) { float ssq = 0.f;
#pragma unroll
        for (int dt = 0; dt < 8; ++dt)
            {
#pragma unroll
                for (int r = 0; r < 16; ++r) { const float o = O[dt][r] * inv + Of[ql * AT_OF_STRIDE + 32 * dt + crow(r, hie)]; O[dt][r] = o; ssq = __builtin_fmaf(o, o, ssq); }
                SB0; }
        ssq += __shfl_xor(ssq, 32);
        const float rstd = rsqrtf(ssq * (1.f / 256.f) + 1e-5f) * (1.f - LAM_INIT);
#pragma unroll
        for (int dt = 0; dt < 8; ++dt)
#pragma unroll
            for (int r = 0; r < 16; ++r) Of[ql * AT_OF_STRIDE + 32 * dt + crow(r, hie)] = O[dt][r] * rstd; }
    __syncthreads();
#pragma unroll 1
    for (int i = 0; i < 8; ++i) { const int id = tid_e + 512 * i, q = id >> 5, dg = (id & 31) * 8; const size_t trow = (size_t)(b * SEQ + q0 + q);
        const bf16x8 zv = *(const bf16x8*)(H + trow * 16384 + 12288 + h * 256 + dg);
        const f32x4 w0 = *(const f32x4*)(P.subln_w + dg), w1 = *(const f32x4*)(P.subln_w + dg + 4);
        float r[8];
#pragma unroll
        for (int e = 0; e < 8; ++e) r[e] = Of[q * AT_OF_STRIDE + dg + e] * (e < 4 ? w0[e & 3] : w1[e & 3]) * bf2f((unsigned short)zv[e]);
        *(bf16x8*)(O1 + trow * 4096 + h * 256 + dg) = pack8(r[0], r[1], r[2], r[3], r[4], r[5], r[6], r[7]); }
    __syncthreads();
}
DI void attn_phase(const Params& P, ldsp_t lds) {
    const int lane = threadIdx.x & 63;
    float s1 = P.lq1[lane] * P.lk1[lane] + P.lq1[lane + 64] * P.lk1[lane + 64], s2 = P.lq2[lane] * P.lk2[lane] + P.lq2[lane + 64] * P.lk2[lane + 64];
    s1 = wsum(s1); s2 = wsum(s2);
    const float lam = __int_as_float(__builtin_amdgcn_readfirstlane(__float_as_int(expf(s1) - expf(s2) + LAM_INIT)));
    for (int idx = blockIdx.x; idx < 1024; idx += gridDim.x) { const int bh = idx >> 4, j = idx & 15;
#pragma unroll 1
        for (int sub = 0; sub < 2; ++sub) attn_block(P, lds, bh, sub ? 31 - j : j, lam); }
}

typedef const __attribute__((address_space(4))) Params* kparams_t;
DI Params kparams() { kparams_t p = (kparams_t)__builtin_amdgcn_kernarg_segment_ptr(); asm volatile("" : "+s"(p)); const Params* g = (const Params*)p; return *g; }
DI void gbar(unsigned* ctr, unsigned target) {
    __syncthreads();
    if (threadIdx.x == 0) {
        __builtin_amdgcn_fence(__ATOMIC_RELEASE, "agent");
        __hip_atomic_fetch_add(ctr, 1u, __ATOMIC_RELAXED, __HIP_MEMORY_SCOPE_AGENT);
        while (__hip_atomic_load(ctr, __ATOMIC_RELAXED, __HIP_MEMORY_SCOPE_AGENT) < target) __builtin_amdgcn_s_sleep(1);
    }
    __syncthreads();
    __builtin_amdgcn_fence(__ATOMIC_ACQUIRE, "agent");
    asm volatile("s_waitcnt vmcnt(0)" ::: "memory");
}
__global__ void __launch_bounds__(512) fwd_megakernel(Params P) {
    extern __shared__ __attribute__((aligned(16))) unsigned char shm[];
    ldsp_t lds = (ldsp_t)shm;
    cg::grid_group grid = cg::this_grid();
    const int ph_lo = P.ph_lo, ph_hi = P.ph_hi;
    unsigned* bar = (unsigned*)(P.ws + OFF_BAR); int nbar = 0;
#ifdef EXTRA_SYNC
    for (int es = 0; es < EXTRA_SYNC; ++es) grid.sync();
#endif
#ifndef PH_MASK
#define PH_MASK 0x7ff
#endif
#define PH_ON(n) (((PH_MASK) >> (n)) & 1)
#ifndef REP_MASK
#define REP_MASK 0
#endif
#define REP_N(n) ((((REP_MASK) >> (n)) & 1) ? 2 : 1)
    if (PH_ON(0) && ph_lo <= 0 && 0 < ph_hi) { if (0 > ph_lo) gbar(bar, (unsigned)(++nbar) * gridDim.x);
        const Params Pl = kparams(); unsigned char* ws = Pl.ws;
        for (int rep = 0; rep < REP_N(0); ++rep)
        {
            cvt_rows(Pl.x, (bf16_t*)(ws + OFF_ACT), (size_t)NTOK * DM / 8);
            transpose_w(Pl.a_w_in, 16448, 16640, (bf16_t*)(ws + OFF_WIN), lds);
            transpose_w(Pl.a_w_out, 4096, 4096, (bf16_t*)(ws + OFF_WOUT), lds);
            bias_table(Pl.rel_bias, (float*)(ws + OFF_BT));
        }
    }
    if (PH_ON(1) && ph_lo <= 1 && 1 < ph_hi) { if (1 > ph_lo) grid.sync();
        const Params Pl = kparams(); unsigned char* ws = Pl.ws;
        for (int rep = 0; rep < REP_N(1); ++rep)
        { pg8::Gemm g{(const bf16_t*)(ws + OFF_ACT), (const bf16_t*)(ws + OFF_WIN), NTOK, 16640, 4096};
            pg8::StaticOrder S; S.init(g.M, g.N, (int)gridDim.x, (int)blockIdx.x); EpiH E{(bf16_t*)(ws + OFF_H), (float*)(ws + OFF_AB)};
            pg8::gemm_phase<EpiH, pg8::StaticOrder, false>(lds, g, S, E, nullptr); }
    }
    if (PH_ON(2) && ph_lo <= 2 && 2 < ph_hi) { if (2 > ph_lo) gbar(bar, (unsigned)(++nbar) * gridDim.x);
        const Params Pl = kparams(); unsigned char* ws = Pl.ws;
        for (int rep = 0; rep < REP_N(2); ++rep)
        p2a_phase(Pl, lds);
    }
    if (PH_ON(3) && ph_lo <= 3 && 3 < ph_hi) { if (3 > ph_lo) gbar(bar, (unsigned)(++nbar) * gridDim.x);
        const Params Pl = kparams(); unsigned char* ws = Pl.ws;
        for (int rep = 0; rep < REP_N(3); ++rep)
        scan_phase(Pl, lds);
    }
    if (PH_ON(4) && ph_lo <= 4 && 4 < ph_hi) { if (4 > ph_lo) gbar(bar, (unsigned)(++nbar) * gridDim.x);
        const Params Pl = kparams(); unsigned char* ws = Pl.ws;
        for (int rep = 0; rep < REP_N(4); ++rep)
        { pg8::Gemm g{(const bf16_t*)(ws + OFF_R), (const bf16_t*)(ws + OFF_WOUT), NTOK, 4096, 4096};
            pg8::StaticOrder S; S.init(g.M, g.N, (int)gridDim.x, (int)blockIdx.x); EpiRes E{Pl.x, Pl.out};
            pg8::gemm_phase<EpiRes, pg8::StaticOrder, false>(lds, g, S, E, nullptr); }
    }
    if (PH_ON(5) && ph_lo <= 5 && 5 < ph_hi) { if (5 > ph_lo) gbar(bar, (unsigned)(++nbar) * gridDim.x);
        const Params Pl = kparams(); unsigned char* ws = Pl.ws;
        for (int rep = 0; rep < REP_N(5); ++rep)
        {
            ln_phase(Pl.out, Pl.ln_g, Pl.ln_b, (bf16_t*)(ws + OFF_ACT));
            transpose_w(Pl.b_w_in, 16384, 16384, (bf16_t*)(ws + OFF_WIN), lds);
            transpose_w(Pl.b_w_out, 4096, 4096, (bf16_t*)(ws + OFF_WOUT), lds);
        }
    }
    if (PH_ON(6) && ph_lo <= 6 && 6 < ph_hi) { if (6 > ph_lo) gbar(bar, (unsigned)(++nbar) * gridDim.x);
        const Params Pl = kparams(); unsigned char* ws = Pl.ws;
        for (int rep = 0; rep < REP_N(6); ++rep)
        { pg8::Gemm g{(const bf16_t*)(ws + OFF_ACT), (const bf16_t*)(ws + OFF_WIN), NTOK, 16384, 4096};
            pg8::StaticOrder S; S.init(g.M, g.N, (int)gridDim.x, (int)blockIdx.x); EpiH E{(bf16_t*)(ws + OFF_H), (float*)(ws + OFF_AB)};
            pg8::gemm_phase<EpiH, pg8::StaticOrder, false>(lds, g, S, E, nullptr); }
    }
    if (PH_ON(7) && ph_lo <= 7 && 7 < ph_hi) { if (7 > ph_lo) gbar(bar, (unsigned)(++nbar) * gridDim.x);
        const Params Pl = kparams(); unsigned char* ws = Pl.ws;
        for (int rep = 0; rep < REP_N(7); ++rep)
        vt_phase(Pl, lds);
    }
    if (PH_ON(8) && ph_lo <= 8 && 8 < ph_hi) { if (8 > ph_lo) gbar(bar, (unsigned)(++nbar) * gridDim.x);
        const Params Pl = kparams(); unsigned char* ws = Pl.ws;
        for (int rep = 0; rep < REP_N(8); ++rep)
        attn_phase(Pl, lds);
    }
    if (PH_ON(9) && ph_lo <= 9 && 9 < ph_hi) { if (9 > ph_lo) gbar(bar, (unsigned)(++nbar) * gridDim.x);
        const Params Pl = kparams(); unsigned char* ws = Pl.ws;
        for (int rep = 0; rep < REP_N(9); ++rep)
        { pg8::Gemm g{(const bf16_t*)(ws + OFF_ACT), (const bf16_t*)(ws + OFF_WOUT), NTOK, 4096, 4096};
            pg8::StaticOrder S; S.init(g.M, g.N, (int)gridDim.x, (int)blockIdx.x); EpiRes E{Pl.out, Pl.out};
            pg8::gemm_phase<EpiRes, pg8::StaticOrder, false>(lds, g, S, E, nullptr); }
    }
    if (PH_ON(10) && ph_lo <= 10 && 10 < ph_hi) { if (10 > ph_lo) gbar(bar, (unsigned)(++nbar) * gridDim.x);
        const Params Pl = kparams(); unsigned char* ws = Pl.ws;
        for (int rep = 0; rep < REP_N(10); ++rep)
        ln_phase(Pl.out, Pl.ln_g + DM, Pl.ln_b + DM, nullptr);
    }
}

#ifndef N_LAUNCH_MODE
#define N_LAUNCH_MODE 0
#endif
extern "C" void kernel_launch(void* const* d_in, const int* in_sizes, int n_in, void* d_out, int out_size, void* d_ws, size_t ws_size, hipStream_t stream) {
    static int grid_blocks = 0;
    if (!grid_blocks) {
        int dev = 0, cus = 0, per_cu = 0;
        hipGetDevice(&dev);
        hipDeviceGetAttribute(&cus, hipDeviceAttributeMultiprocessorCount, dev);
        hipFuncSetAttribute((const void*)fwd_megakernel, hipFuncAttributeMaxDynamicSharedMemorySize, LDS_BYTES);
        hipOccupancyMaxActiveBlocksPerMultiprocessor(&per_cu, fwd_megakernel, 512, LDS_BYTES);
        if (per_cu < 1) per_cu = 1;
        grid_blocks = cus * per_cu; if (grid_blocks > 256) grid_blocks = 256;
    }
    if (ws_size < WS_NEED) { fprintf(stderr, "workspace too small: %zu < %zu\n", ws_size, (size_t)WS_NEED); return; }
    Params p{};
    p.x = (const float*)d_in[0]; p.ln_g = (const float*)d_in[1]; p.ln_b = (const float*)d_in[2]; p.rel_bias = (const float*)d_in[3];
    p.a_w_in = (const float*)d_in[4]; p.a_conv_w = (const float*)d_in[5]; p.a_a_log = (const float*)d_in[6]; p.a_dt_bias = (const float*)d_in[7];
    p.a_norm_w = (const float*)d_in[8]; p.a_w_out = (const float*)d_in[9]; p.b_w_in = (const float*)d_in[10];
    p.lq1 = (const float*)d_in[11]; p.lk1 = (const float*)d_in[12]; p.lq2 = (const float*)d_in[13]; p.lk2 = (const float*)d_in[14];
    p.subln_w = (const float*)d_in[15]; p.b_w_out = (const float*)d_in[16];
    p.out = (float*)d_out; p.ws = (unsigned char*)d_ws;
#if N_LAUNCH_MODE == 0
    p.ph_lo = 0; p.ph_hi = 11;
    hipMemsetAsync((unsigned char*)d_ws + OFF_BAR, 0, 256, stream);
    void* args[] = {&p};
    hipError_t e = hipLaunchCooperativeKernel((const void*)fwd_megakernel, dim3(grid_blocks), dim3(512), args, LDS_BYTES, stream);
    if (e != hipSuccess) fprintf(stderr, "cooperative launch failed: %s (grid %d)\n", hipGetErrorString(e), grid_blocks);
#else
    for (int ph = 0; ph < 11; ++ph) { p.ph_lo = ph; p.ph_hi = ph + 1;
        hipLaunchKernelGGL(fwd_megakernel, dim3(grid_blocks), dim3(512), LDS_BYTES, stream, p); }
#endif
}
```
